# Optimizing an MI355X kernel written in HIP

```python
import math
import jax, jax.numpy as jnp
from jax import lax
import numpy as np

D_MODEL = 1024
BATCH = 32
SEQ = 2048
DEPTH = 2

HEAD_DIM = 64
N_HEADS = D_MODEL // HEAD_DIM
D_FF = 4 * D_MODEL
N_MIXERS = 2
MOBA_BLOCK = 256
MOBA_TOPK = 3
MOBA_Q_CHUNK = 8
SB_Q_BLOCK = 128
REL_BUCKETS = 32
REL_MAX_DIST = 128
LN_EPS = 1e-5
DEEPNORM_ALPHA = (2.0 * DEPTH) ** 0.25
DEEPNORM_BETA = (8.0 * DEPTH) ** -0.25

kernel_name = "moba_stickbreaking_deepnorm_hybrid"


def layer_norm(x, g, b):
    xf = x.astype(jnp.float32)
    mu = jnp.mean(xf, axis=-1, keepdims=True)
    var = jnp.mean(jnp.square(xf - mu), axis=-1, keepdims=True)
    y = (xf - mu) * lax.rsqrt(var + LN_EPS)
    return (y * g.astype(jnp.float32) + b.astype(jnp.float32)).astype(x.dtype)


def t5_bucket(dist):
    n = jnp.maximum(dist, 0)
    max_exact = REL_BUCKETS // 2
    nf = jnp.maximum(n, 1).astype(jnp.float32)
    large = max_exact + (jnp.log(nf / max_exact) / math.log(REL_MAX_DIST / max_exact)
                         * (REL_BUCKETS - max_exact)).astype(jnp.int32)
    large = jnp.minimum(large, REL_BUCKETS - 1)
    return jnp.where(n < max_exact, n, large)


def moba_attention(q, k, v, rel_bias):
    B, H, S, dh = q.shape
    nb = -(-S // MOBA_BLOCK)
    s_pad = nb * MOBA_BLOCK
    topk = min(MOBA_TOPK, nb)
    pad = ((0, 0), (0, 0), (0, s_pad - S), (0, 0))
    k_pad = jnp.pad(k, pad)
    v_pad = jnp.pad(v, pad)
    k_blk = k_pad.reshape(B, H, nb, MOBA_BLOCK, dh)
    v_blk = v_pad.reshape(B, H, nb, MOBA_BLOCK, dh)
    k_mean = jnp.mean(k_blk.astype(jnp.float32), axis=3)

    q_blk_id = jnp.arange(S) // MOBA_BLOCK
    gate = jnp.einsum('bhsd,bhnd->bhsn', q.astype(jnp.float32), k_mean)
    past = jnp.arange(nb)[None, :] < q_blk_id[:, None]
    gate = jnp.where(past, gate, -jnp.inf)
    _, sel = lax.top_k(gate, topk)
    sel_valid = sel < q_blk_id[:, None]

    nc = S // MOBA_Q_CHUNK

    def to_chunks(a):
        a = a.reshape((B, H, nc, MOBA_Q_CHUNK) + a.shape[3:])
        return jnp.moveaxis(a, 2, 0)

    table_t = rel_bias.T.astype(jnp.float32)
    head_ix = jnp.arange(H)[None, :, None, None, None]
    gather_blocks = jax.vmap(jax.vmap(lambda blk, ix: blk[ix]))
    scale = dh ** -0.5
    w_ar = jnp.arange(MOBA_BLOCK)

    def chunk_fn(args):
        qc, selc, validc, c = args
        t = c * MOBA_Q_CHUNK + jnp.arange(MOBA_Q_CHUNK)
        kg = gather_blocks(k_blk, selc)
        vg = gather_blocks(v_blk, selc)
        key_pos_g = selc[..., None] * MOBA_BLOCK + w_ar
        bias_g = table_t[head_ix, t5_bucket(t[:, None, None] - key_pos_g)]
        s_g = jnp.einsum('bhqd,bhqkwd->bhqkw', qc, kg).astype(jnp.float32) * scale + bias_g
        s_g = jnp.where(validc[..., None], s_g, -jnp.inf)
        start = ((c * MOBA_Q_CHUNK) // MOBA_BLOCK) * MOBA_BLOCK
        ko = lax.dynamic_slice_in_dim(k_pad, start, MOBA_BLOCK, axis=2)
        vo = lax.dynamic_slice_in_dim(v_pad, start, MOBA_BLOCK, axis=2)
        rel_o = t[:, None] - (start + w_ar)[None, :]
        bias_o = table_t[:, t5_bucket(rel_o)]
        s_o = jnp.einsum('bhqd,bhwd->bhqw', qc, ko).astype(jnp.float32) * scale + bias_o
        s_o = jnp.where(rel_o >= 0, s_o, -jnp.inf)
        logits = jnp.concatenate(
            [s_g.reshape(B, H, MOBA_Q_CHUNK, topk * MOBA_BLOCK), s_o], axis=-1)
        p = jax.nn.softmax(logits, axis=-1).astype(v.dtype)
        p_g = p[..., :topk * MOBA_BLOCK].reshape(B, H, MOBA_Q_CHUNK, topk, MOBA_BLOCK)
        p_o = p[..., topk * MOBA_BLOCK:]
        return (jnp.einsum('bhqkw,bhqkwd->bhqd', p_g, vg)
                + jnp.einsum('bhqw,bhwd->bhqd', p_o, vo))

    out = lax.map(chunk_fn, (to_chunks(q), to_chunks(sel), to_chunks(sel_valid),
                             jnp.arange(nc)))
    return jnp.moveaxis(out, 0, 2).reshape(B, H, S, dh)


def stick_breaking_attention(q, k, v):
    B, H, S, dh = q.shape
    scale = dh ** -0.5
    outs = []
    for t0 in range(0, S, SB_Q_BLOCK):
        end = t0 + SB_Q_BLOCK
        qb = q[:, :, t0:end]
        kk = k[:, :, :end]
        vv = v[:, :, :end]
        z = jnp.einsum('bhqd,bhsd->bhqs', qb, kk).astype(jnp.float32) * scale
        t = t0 + jnp.arange(SB_Q_BLOCK)[:, None]
        s = jnp.arange(end)[None, :]
        causal = s < t
        log_keep = jnp.where(causal, jax.nn.log_sigmoid(-z), 0.0)
        after = lax.cumsum(log_keep, axis=3, reverse=True) - log_keep
        a = jnp.where(causal, jnp.exp(jax.nn.log_sigmoid(z) + after), 0.0)
        outs.append(jnp.einsum('bhqs,bhsd->bhqd', a.astype(v.dtype), vv))
    return jnp.concatenate(outs, axis=2)


def setup_inputs(seed: int = 0) -> dict:
    key = jax.random.key(seed)
    ks = jax.random.split(key, 10)
    D = D_MODEL
    x = jax.random.normal(ks[0], (BATCH, SEQ, D), jnp.float32)
    rel_bias = 0.5 * jax.random.normal(ks[1], (REL_BUCKETS, N_HEADS), jnp.float32)
    col_scale = jnp.concatenate([jnp.ones((2 * D,), jnp.float32),
                                 jnp.full((D,), DEEPNORM_BETA, jnp.float32)])
    w_qkv = jax.random.normal(ks[2], (DEPTH, D, 3 * D), jnp.float32) * (D ** -0.5) * col_scale
    w_o = jax.random.normal(ks[3], (DEPTH, D, D), jnp.float32) * (D ** -0.5) * DEEPNORM_BETA
    ln_mix_g = 1.0 + 0.02 * jax.random.normal(ks[4], (DEPTH, D), jnp.float32)
    ln_mix_b = 0.02 * jax.random.normal(ks[5], (DEPTH, D), jnp.float32)
    w_up = jax.random.normal(ks[6], (DEPTH, D, D_FF), jnp.float32) * (D ** -0.5) * DEEPNORM_BETA
    w_down = jax.random.normal(ks[7], (DEPTH, D_FF, D), jnp.float32) * (D_FF ** -0.5) * DEEPNORM_BETA
    ln_ffn_g = 1.0 + 0.02 * jax.random.normal(ks[8], (DEPTH, D), jnp.float32)
    ln_ffn_b = 0.02 * jax.random.normal(ks[9], (DEPTH, D), jnp.float32)
    return {"x": x, "rel_bias": rel_bias, "w_qkv": w_qkv, "w_o": w_o,
            "ln_mix_g": ln_mix_g, "ln_mix_b": ln_mix_b, "w_up": w_up, "w_down": w_down,
            "ln_ffn_g": ln_ffn_g, "ln_ffn_b": ln_ffn_b}


def reference(x, rel_bias, w_qkv, w_o, ln_mix_g, ln_mix_b, w_up, w_down, ln_ffn_g, ln_ffn_b):
    B, S, D = x.shape
    h = x
    for i in range(DEPTH):
        qkv = (h @ w_qkv[i]).reshape(B, S, 3, N_HEADS, HEAD_DIM)
        qkv = jnp.transpose(qkv, (2, 0, 3, 1, 4))
        q, k, v = qkv[0], qkv[1], qkv[2]
        if i % N_MIXERS == 0:
            o = moba_attention(q, k, v, rel_bias)
        else:
            o = stick_breaking_attention(q, k, v)
        o = jnp.transpose(o, (0, 2, 1, 3)).reshape(B, S, D) @ w_o[i]
        h = layer_norm(DEEPNORM_ALPHA * h + o, ln_mix_g[i], ln_mix_b[i])
        u = jnp.square(jax.nn.relu(h @ w_up[i]))
        h = layer_norm(DEEPNORM_ALPHA * h + u @ w_down[i], ln_ffn_g[i], ln_ffn_b[i])
    return h
```

```cpp
#include <hip/hip_runtime.h>
#include <hip/hip_cooperative_groups.h>
#include <cstdio>
#include <cstdint>
namespace cg = cooperative_groups;
constexpr unsigned MK_WTAB = 131072u + 20480u;
__device__ __forceinline__ int mk_tid() {
    const unsigned hw = (unsigned)__builtin_amdgcn_s_getreg((5 << 11) | 4) & 63u;
    const int wave = ((const __attribute__((address_space(3))) int*)(uintptr_t)MK_WTAB)[hw];
    int lane; asm volatile("v_mbcnt_lo_u32_b32 %0, -1, 0\n\tv_mbcnt_hi_u32_b32 %0, -1, %0" : "=v"(lane));
    return __builtin_amdgcn_readfirstlane(wave) * 64 + lane;
}
namespace pg8 {
#define PG8_LAS __attribute__((address_space(3)))
typedef _Float16 bf16_t;
typedef _Float16 bf16x8 __attribute__((ext_vector_type(8)));
typedef float f32x4 __attribute__((ext_vector_type(4)));
typedef unsigned u32x4 __attribute__((ext_vector_type(4)));
constexpr int BM = 256, BK = 64, HALF = 128, HTB = HALF * BK * 2  , STAGE_BYTES = 8 * HTB, NXCD = 8, WGM = 8;

__host__ __device__ __forceinline__ int lds_byte(int r, int c) { const int st = (r >> 4) * 2 + (c >> 5), rr = r & 15, cc = c & 31, ob = rr * 64 + cc * 2; return st * 1024 + (ob ^ (((ob >> 9) & 1) << 5)); }
__host__ __device__ __forceinline__ void stage_rc(int b, int& R, int& C) { const int st = b / 1024, sb = b % 1024, swz = sb ^ (((sb >> 9) & 1) << 5); R = (st >> 1) * 16 + swz / 64; C = (st & 1) * 32 + (swz % 64) / 2; }
__host__ __device__ __forceinline__ int perm32(int rho) { const int n = rho >> 4, i = rho & 15; return 8 * (i >> 2) + 4 * n + (i & 3); }

struct Unit { int pm, pn; };
struct Gemm { const bf16_t* A; const bf16_t* Bt; int M, N, K; };

struct StaticOrder {
    int nM, nN, nwg, G, c;
    __host__ __device__ void init(int M, int N, int G_, int c_) { nM = M / BM; nN = N / BM; nwg = nM * nN; G = G_; c = c_; }
    __host__ __device__ bool next(int i, Unit& u) const {
        const long L = (long)i * G + c; if (L >= nwg) return false;
        int wgid = (int)L; { const int q = nwg / NXCD, r = nwg % NXCD, xcd = wgid % NXCD, off = wgid / NXCD; wgid = (xcd < r ? xcd * (q + 1) : r * (q + 1) + (xcd - r) * q) + off; }
        const int nig = WGM * nN, gid = wgid / nig, fm = gid * WGM, gsz = (nM - fm) < WGM ? (nM - fm) : WGM;
        u.pm = fm + ((wgid % nig) % gsz); u.pn = (wgid % nig) / gsz; return true;
    }
    __device__ __forceinline__ void a_ready(const Unit&) const {}
    __device__ __forceinline__ void done(const Unit&) const {}
};


typedef _Float16 h16x2_t __attribute__((ext_vector_type(2)));
__device__ __forceinline__ unsigned pk2h(float lo, float hi) { h16x2_t v = {(_Float16)lo, (_Float16)hi}; return __builtin_bit_cast(unsigned, v); }
typedef float f32x2_t __attribute__((ext_vector_type(2)));
template <int MODE, bool FOLD> struct Epi {
    static constexpr bool PERM = true, AFTER_DRAIN = false;
    bf16_t* O; int ldc; int split_cols; size_t split_stride; float scale0; const bf16_t* R; float alpha;
    const PG8_LAS unsigned char* tb; f32x2_t* part;
    __device__ __forceinline__ void operator()(const f32x4 (&acc)[2][2][4][2], const Unit& u, int ui, int wr, int wc, int fr, int fq) const {
        const int row0 = u.pm * BM + wr * 64 + fr; int colt = u.pn * BM; bf16_t* base = O;
        float sc = 1.f; bool hm = false;
        if (MODE == 0 && split_cols) { const int t = colt / split_cols; base += (size_t)t * split_stride; colt -= t * split_cols; if (t == 0) sc = scale0; else hm = true; }
        const int col0 = colt + wc * 32 + 8 * fq;
        f32x4 cv[2][2], bv[2][2]; int pslot = 0;
        if (FOLD) { const PG8_LAS int* sl = (const PG8_LAS int*)(tb + 16384); pslot = sl[ui] * 256; const int cslot = sl[16 + ui] * 256 + wc * 32 + 8 * fq;
            const PG8_LAS float* csl = (const PG8_LAS float*)(tb + 8192); const PG8_LAS float* bwl = (const PG8_LAS float*)(tb + 12288);
#pragma unroll
            for (int bj = 0; bj < 2; ++bj)
#pragma unroll
                for (int n = 0; n < 2; ++n) { cv[bj][n] = *(const PG8_LAS f32x4*)(csl + cslot + bj * HALF + 4 * n); bv[bj][n] = *(const PG8_LAS f32x4*)(bwl + cslot + bj * HALF + 4 * n); } }
#pragma unroll
        for (int ai = 0; ai < 2; ++ai) {
        bf16x8 rr[4][2];
        if (MODE == 2) {
#pragma unroll
            for (int m = 0; m < 4; ++m)
#pragma unroll
                for (int bj = 0; bj < 2; ++bj) rr[m][bj] = *(const bf16x8*)(R + (size_t)(row0 + ai * HALF + m * 16) * ldc + col0 + bj * HALF);
            __builtin_amdgcn_sched_barrier(0); }
#pragma unroll
            for (int m = 0; m < 4; ++m) { const int row = row0 + ai * HALF + m * 16; const size_t off = (size_t)row * ldc + col0;
                float mu = 0.f, rs = 1.f; if (FOLD) { const f32x2_t ms = ((const PG8_LAS f32x2_t*)tb)[pslot + ai * HALF + wr * 64 + m * 16 + fr]; mu = ms.x; rs = ms.y; }
                float ssum = 0.f, ssq = 0.f;
#pragma unroll
                for (int bj = 0; bj < 2; ++bj) { f32x4 v0 = acc[ai][bj][m][0], v1 = acc[ai][bj][m][1];
                    if (FOLD && MODE != 2) { v0 = (v0 - mu * cv[bj][0]) * rs + bv[bj][0]; v1 = (v1 - mu * cv[bj][1]) * rs + bv[bj][1]; }
                    if (MODE == 0) { v0 = v0 * sc; v1 = v1 * sc; }
                    if (MODE == 1) { v0 = __builtin_elementwise_max(v0, (f32x4){0.f, 0.f, 0.f, 0.f}); v1 = __builtin_elementwise_max(v1, (f32x4){0.f, 0.f, 0.f, 0.f}); v0 = v0 * v0; v1 = v1 * v1; }
                    if (MODE == 2) { const bf16x8 r = rr[m][bj];
                        f32x4 h0 = (f32x4){(float)r[0], (float)r[1], (float)r[2], (float)r[3]}, h1 = (f32x4){(float)r[4], (float)r[5], (float)r[6], (float)r[7]};
                        if (FOLD) { h0 = (h0 - mu) * rs * cv[bj][0] + bv[bj][0]; h1 = (h1 - mu) * rs * cv[bj][1] + bv[bj][1]; }
                        v0 = v0 + alpha * h0; v1 = v1 + alpha * h1;
                        ssum += (v0[0] + v0[1]) + (v0[2] + v0[3]) + (v1[0] + v1[1]) + (v1[2] + v1[3]);
                        ssq += (v0[0] * v0[0] + v0[1] * v0[1]) + (v0[2] * v0[2] + v0[3] * v0[3]) + (v1[0] * v1[0] + v1[1] * v1[1]) + (v1[2] * v1[2] + v1[3] * v1[3]); }
                    u32x4 w; w.x = pk2h(v0[0], v0[1]); w.y = pk2h(v0[2], v0[3]); w.z = pk2h(v1[0], v1[1]); w.w = pk2h(v1[2], v1[3]);
                    if (MODE == 0 && hm) { const int cc = col0 + bj * HALF; *(u32x4*)(base + ((size_t)(row >> 11) * 16 + (cc >> 6)) * 131072 + (size_t)(row & 2047) * 64 + (cc & 63)) = w; }
                    else *(u32x4*)(base + off + bj * HALF) = w; }
                if (MODE == 2) { ssum += __shfl_xor(ssum, 16); ssq += __shfl_xor(ssq, 16); ssum += __shfl_xor(ssum, 32); ssq += __shfl_xor(ssq, 32);
                    if (fq == 0) part[(size_t)(row0 + ai * HALF + m * 16) * 16 + u.pn * 4 + wc] = (f32x2_t){ssum, ssq}; } }
        }
    }
};

template <class Epi, class Sched, bool ALIGN_EPI = false, bool SP2 = false>
__device__ __forceinline__ void gemm_phase(PG8_LAS unsigned char* lds, const Gemm g, const Sched& S, const Epi& E) {
    int tid_ = mk_tid(); asm volatile("" : "+v"(tid_));
    const int tid = tid_, wid = __builtin_amdgcn_readfirstlane(tid >> 6), lane = tid & 63, wr = wid >> 2, wc = wid & 3, fr = lane & 15, fq = lane >> 4;
    const int K = g.K, nt = K / BK;
    unsigned voffA[2], voffB[2];
#pragma unroll
    for (int i = 0; i < 2; ++i) { int R, C; stage_rc(tid * 16 + i * 8192, R, C); const int Rb = Epi::PERM ? ((R & ~31) + perm32(R & 31)) : R;
        voffA[i] = (unsigned)(R * K + C) * 2u; voffB[i] = (unsigned)(Rb * K + C) * 2u; }
    const size_t kstep = (size_t)(BK * 2);
    const size_t hstep = (size_t)HALF * K * 2;
    const size_t tstep = 2 * hstep;
    const unsigned ldsw = (unsigned)wid * 1024u;
    const int aoff = lds_byte(wr * 64 + fr, fq * 8), boff = lds_byte(wc * 32 + fr, fq * 8);
#define PG8_SA(b, h) (((b) * 2 + (h)) * HTB)
#define PG8_SB(b, h) ((4 + (b) * 2 + (h)) * HTB)
#define PG8_STAGE(bufoff, gbase, voff) do { _Pragma("unroll") for (int _i = 0; _i < 2; ++_i) \
        __builtin_amdgcn_global_load_lds((const unsigned*)((const char*)(gbase) + (voff)[_i]), (PG8_LAS unsigned*)(lds + (bufoff) + ldsw + _i * 8192), 16, 0, 0); } while (0)
#define PG8_LDA(dst, b, h) do { _Pragma("unroll") for (int m = 0; m < 4; ++m) _Pragma("unroll") for (int k = 0; k < 2; ++k) dst[m][k] = *(const PG8_LAS bf16x8*)(lds + PG8_SA(b, h) + aoff + m * 2048 + k * 1024); } while (0)
#define PG8_LDB(dst, b, h) do { _Pragma("unroll") for (int n = 0; n < 2; ++n) _Pragma("unroll") for (int k = 0; k < 2; ++k) dst[n][k] = *(const PG8_LAS bf16x8*)(lds + PG8_SB(b, h) + boff + n * 2048 + k * 1024); } while (0)
#define PG8_MMA(ai, bj, At, Bt) do { __builtin_amdgcn_s_setprio(1); _Pragma("unroll") for (int m = 0; m < 4; ++m) _Pragma("unroll") for (int n = 0; n < 2; ++n) _Pragma("unroll") for (int k = 0; k < 2; ++k) \
        acc[ai][bj][m][n] = __builtin_amdgcn_mfma_f32_16x16x32_f16(Bt[n][k], At[m][k], acc[ai][bj][m][n], 0, 0, 0); __builtin_amdgcn_s_setprio(0); } while (0)
#define PG8_WAIT_V(n) asm volatile("s_waitcnt vmcnt(" #n ")" ::: "memory")
#define PG8_WAIT_L(n) asm volatile("s_waitcnt lgkmcnt(" #n ")" ::: "memory")
#define PG8_BAR __builtin_amdgcn_s_barrier()
#define PG8_SCHED __builtin_amdgcn_sched_barrier(0)
    Unit cur, nxt; int ui = 0;
    if (!S.next(0, cur)) return;
    f32x4 acc[2][2][4][2];
#pragma unroll
    for (int a = 0; a < 2; ++a)
#pragma unroll
        for (int b = 0; b < 2; ++b)
#pragma unroll
            for (int m = 0; m < 4; ++m)
#pragma unroll
                for (int n = 0; n < 2; ++n) acc[a][b][m][n] = (f32x4){0.f, 0.f, 0.f, 0.f};
    bf16x8 At[4][2], B0[2][2], B1[2][2];
    const char* cA = (const char*)g.A + (size_t)cur.pm * tstep; const char* cB = (const char*)g.Bt + (size_t)cur.pn * tstep;
    S.a_ready(cur);
    if constexpr (SP2) {
        PG8_STAGE(PG8_SB(0, 0), cB, voffB); PG8_STAGE(PG8_SB(0, 1), cB + hstep, voffB); PG8_STAGE(PG8_SA(0, 0), cA, voffA); PG8_STAGE(PG8_SA(0, 1), cA + hstep, voffA);
        if (wr == 1) PG8_BAR;
        PG8_WAIT_V(2); PG8_BAR;
        PG8_STAGE(PG8_SB(1, 0), cB + kstep, voffB); PG8_STAGE(PG8_SA(1, 0), cA + kstep, voffA); PG8_STAGE(PG8_SB(1, 1), cB + hstep + kstep, voffB);
        PG8_WAIT_V(6); PG8_BAR;
    } else {
        PG8_STAGE(PG8_SB(0, 0), cB, voffB); PG8_STAGE(PG8_SA(0, 0), cA, voffA); PG8_STAGE(PG8_SB(0, 1), cB + hstep, voffB); PG8_STAGE(PG8_SA(0, 1), cA + hstep, voffA);
        if (wr == 1) PG8_BAR;
        PG8_WAIT_V(4); PG8_BAR;
        PG8_STAGE(PG8_SB(1, 0), cB + kstep, voffB); PG8_STAGE(PG8_SA(1, 0), cA + kstep, voffA); PG8_STAGE(PG8_SB(1, 1), cB + hstep + kstep, voffB);
        PG8_WAIT_V(6); PG8_BAR;
    }
    for (;;) {
        const bool has_next = S.next(ui + 1, nxt);
        const char* nA = has_next ? (const char*)g.A + (size_t)nxt.pm * tstep : cA; const char* nB = has_next ? (const char*)g.Bt + (size_t)nxt.pn * tstep : cB;
        for (int t = 0; t < nt; t += 2) {
            const bool last = (t == nt - 2);
            const char* a1 = cA + (size_t)(t + 1) * kstep;
            const char* a2 = last ? nA : cA + (size_t)(t + 2) * kstep; const char* b2 = last ? nB : cB + (size_t)(t + 2) * kstep;
            const char* a3 = a2 + kstep; const char* b3 = b2 + kstep;
            if (last && has_next) S.a_ready(nxt);
            if constexpr (SP2) {
            PG8_LDB(B0, 0, 0); PG8_LDB(B1, 0, 1); PG8_SCHED; PG8_LDA(At, 0, 0); PG8_STAGE(PG8_SA(1, 1), a1 + hstep, voffA);
            PG8_WAIT_V(8); PG8_WAIT_L(0); PG8_BAR; PG8_MMA(0, 0, At, B0); PG8_MMA(0, 1, At, B1); PG8_BAR; PG8_SCHED;
            PG8_LDA(At, 0, 1); PG8_STAGE(PG8_SB(0, 0), b2, voffB); PG8_STAGE(PG8_SB(0, 1), b2 + hstep, voffB); PG8_STAGE(PG8_SA(0, 0), a2, voffA);
            PG8_WAIT_V(8); PG8_WAIT_L(0); PG8_BAR; PG8_MMA(1, 0, At, B0); PG8_MMA(1, 1, At, B1); PG8_BAR; PG8_SCHED;
            PG8_LDB(B0, 1, 0); PG8_LDB(B1, 1, 1); PG8_SCHED; PG8_LDA(At, 1, 0); PG8_STAGE(PG8_SA(0, 1), a2 + hstep, voffA);
            PG8_WAIT_V(8); PG8_WAIT_L(0); PG8_BAR; PG8_MMA(0, 0, At, B0); PG8_MMA(0, 1, At, B1); PG8_BAR; PG8_SCHED;
            PG8_LDA(At, 1, 1); PG8_STAGE(PG8_SB(1, 0), b3, voffB); PG8_STAGE(PG8_SB(1, 1), b3 + hstep, voffB); PG8_STAGE(PG8_SA(1, 0), a3, voffA);
            PG8_WAIT_V(8); PG8_WAIT_L(0); PG8_BAR; PG8_MMA(1, 0, At, B0); PG8_MMA(1, 1, At, B1); PG8_BAR; PG8_SCHED;
            } else {
            PG8_LDB(B0, 0, 0); PG8_SCHED; PG8_LDA(At, 0, 0); PG8_STAGE(PG8_SA(1, 1), a1 + hstep, voffA);
            PG8_WAIT_L(8); PG8_BAR; PG8_WAIT_L(0); PG8_MMA(0, 0, At, B0); PG8_BAR; PG8_SCHED;
            PG8_LDB(B1, 0, 1); PG8_STAGE(PG8_SB(0, 0), b2, voffB);
            PG8_BAR; PG8_WAIT_L(0); PG8_MMA(0, 1, At, B1); PG8_BAR;
            PG8_LDA(At, 0, 1); PG8_STAGE(PG8_SA(0, 0), a2, voffA);
            PG8_BAR; PG8_WAIT_L(0); PG8_MMA(1, 0, At, B0); PG8_BAR; PG8_SCHED;
            PG8_STAGE(PG8_SB(0, 1), b2 + hstep, voffB);
            PG8_WAIT_V(6); PG8_BAR; PG8_MMA(1, 1, At, B1); PG8_BAR;
            PG8_LDB(B0, 1, 0); PG8_SCHED; PG8_LDA(At, 1, 0); PG8_STAGE(PG8_SA(0, 1), a2 + hstep, voffA);
            PG8_WAIT_L(8); PG8_BAR; PG8_WAIT_L(0); PG8_MMA(0, 0, At, B0); PG8_BAR; PG8_SCHED;
            PG8_LDB(B1, 1, 1); PG8_STAGE(PG8_SB(1, 0), b3, voffB);
            PG8_BAR; PG8_WAIT_L(0); PG8_MMA(0, 1, At, B1); PG8_BAR;
            PG8_LDA(At, 1, 1); PG8_STAGE(PG8_SA(1, 0), a3, voffA);
            PG8_BAR; PG8_WAIT_L(0); PG8_MMA(1, 0, At, B0); PG8_BAR; PG8_SCHED;
            PG8_STAGE(PG8_SB(1, 1), b3 + hstep, voffB);
            PG8_WAIT_V(6); PG8_BAR; PG8_MMA(1, 1, At, B1); PG8_BAR;
            }
        }
        if constexpr (ALIGN_EPI) { if (wr == 0) PG8_BAR; }
        if constexpr (!Epi::AFTER_DRAIN) { E(acc, cur, ui, wr, wc, fr, fq); S.done(cur); }
        if (!has_next) break;
#pragma unroll
        for (int a = 0; a < 2; ++a)
#pragma unroll
            for (int b = 0; b < 2; ++b)
#pragma unroll
                for (int m = 0; m < 4; ++m)
#pragma unroll
                    for (int n = 0; n < 2; ++n) acc[a][b][m][n] = (f32x4){0.f, 0.f, 0.f, 0.f};
        cur = nxt; cA = nA; cB = nB; ++ui;
        if constexpr (ALIGN_EPI) { if (wr == 1) PG8_BAR; }
    }
    PG8_WAIT_V(0);
    if constexpr (!ALIGN_EPI) { if (wr == 0) PG8_BAR; }
    PG8_BAR;
    if constexpr (Epi::AFTER_DRAIN) { E.fused(acc, cur, wr, wc, fr, fq, lds, wid, lane); S.done(cur); }
#undef PG8_SA
#undef PG8_SB
#undef PG8_STAGE
#undef PG8_LDA
#undef PG8_LDB
#undef PG8_MMA
#undef PG8_WAIT_V
#undef PG8_WAIT_L
#undef PG8_BAR
#undef PG8_SCHED
}
}

#define LAS __attribute__((address_space(3)))
typedef _Float16 h16;
typedef _Float16 h16x8 __attribute__((ext_vector_type(8)));
typedef _Float16 h16x4 __attribute__((ext_vector_type(4)));
typedef _Float16 h16x2 __attribute__((ext_vector_type(2)));
typedef __fp16 fp16x4v __attribute__((__vector_size__(4 * sizeof(__fp16))));
typedef float f32x4 __attribute__((ext_vector_type(4)));
typedef float f32x16 __attribute__((ext_vector_type(16)));
typedef unsigned u32x4 __attribute__((ext_vector_type(4)));
typedef unsigned u32x2 __attribute__((ext_vector_type(2)));

#ifndef REP_MOBA
#define REP_MOBA 1
#endif
#ifndef REP_PRO
#define REP_PRO 1
#endif
#ifndef REP_QKV
#define REP_QKV 1
#endif
#ifndef REP_WO
#define REP_WO 1
#endif
#ifndef REP_UP
#define REP_UP 1
#endif
#ifndef REP_DN
#define REP_DN 1
#endif
#ifndef REP_LN
#define REP_LN 1
#endif
#ifndef REP_SB
#define REP_SB 1
#endif
#ifndef MK_LAUNCHES
#define MK_LAUNCHES 1
#endif
constexpr int NT = 512, M_TOK = 65536, DM = 1024, SEQ = 2048, NH = 16, DH = 64, FF = 4096, NBLK = 8, DEPTH = 2, NPHASE = 17;
constexpr int ST_OFF = pg8::STAGE_BYTES, LDS_BYTES = pg8::STAGE_BYTES + 16 * 256 * 8;
constexpr float LN_EPS = 1e-5f, ALPHA = 1.41421356237309515f  , LOG2E = 1.44269504088896341f, QSCALE = 0.125f * LOG2E;
constexpr float NEG_INF = -__builtin_inff();
constexpr size_t ACT_B = (size_t)M_TOK * DM * 2;
constexpr size_t W_QKV_B = (size_t)3 * DM * DM * 2, W_O_B = (size_t)DM * DM * 2, W_UP_B = (size_t)FF * DM * 2, W_DN_B = (size_t)FF * DM * 2, W_LAYER_B = W_QKV_B + W_O_B + W_UP_B + W_DN_B;
constexpr int NCS = 4096 + 4096 + 3072;
constexpr size_t WS_BAR = 0  , WS_BARST = 16384  , CTL_BYTES = 16384 + 8192  ,
                 WS_W = 32768, WS_CS = WS_W + DEPTH * W_LAYER_B  , WS_CSP = WS_CS + 131072  , WS_ST1 = WS_CSP + (size_t)2 * 1048576,
                 WS_ST2 = WS_ST1 + (size_t)M_TOK * 128  , WS_X16 = WS_ST2 + (size_t)M_TOK * 128, WS_YA = WS_X16 + ACT_B, WS_YB = WS_YA + ACT_B, WS_KM = WS_YB + ACT_B,
                 WS_Q = WS_KM + (size_t)4096 * 64 * 4, WS_K = WS_Q + ACT_B, WS_V = WS_K + ACT_B, WS_O = WS_V + ACT_B,
                 WS_U = WS_Q  , WS_END = WS_Q + 4 * ACT_B;

struct Params { const float *x, *rel_bias, *w_qkv, *w_o, *ln_mix_g, *ln_mix_b, *w_up, *w_down, *ln_ffn_g, *ln_ffn_b; float* out; unsigned char* ws; int ph_lo, ph_hi; };

__device__ __forceinline__ unsigned pk2h(float lo, float hi) { h16x2 v = {(h16)lo, (h16)hi}; return __builtin_bit_cast(unsigned, v); }
__device__ __forceinline__ float ex2(float x) { return __builtin_amdgcn_exp2f(x); }
__device__ __forceinline__ float lg2(float x) { return __builtin_amdgcn_logf(x); }
__device__ __forceinline__ int crow(int i, int hh) { return (i & 3) + 8 * (i >> 2) + 4 * hh; }
#define MFMA32(a, b, c) __builtin_amdgcn_mfma_f32_32x32x16_f16((a), (b), (c), 0, 0, 0)
__device__ __forceinline__ h16x8 pack8(const f32x16& x, const int s) {
    h16x8 r; r[0] = (h16)x[8 * s + 0]; r[1] = (h16)x[8 * s + 1]; r[2] = (h16)x[8 * s + 2]; r[3] = (h16)x[8 * s + 3]; r[4] = (h16)x[8 * s + 4]; r[5] = (h16)x[8 * s + 5]; r[6] = (h16)x[8 * s + 6]; r[7] = (h16)x[8 * s + 7]; return r; }
__device__ __forceinline__ h16x8 tr8(const LAS unsigned char* p_lo, const LAS unsigned char* p_hi) {
    const h16x4 lo = __builtin_bit_cast(h16x4, __builtin_amdgcn_ds_read_tr16_b64_v4f16((LAS fp16x4v*)p_lo));
    const h16x4 hi = __builtin_bit_cast(h16x4, __builtin_amdgcn_ds_read_tr16_b64_v4f16((LAS fp16x4v*)p_hi));
    return __builtin_shufflevector(lo, hi, 0, 1, 2, 3, 4, 5, 6, 7); }

#define XB_TMO      128
#define XB_XCNT(j)  (256  + 64 * (j))
#define XB_XSUB(j)  (1280 + 64 * (j))
#define XB_XGEN(j)  (2304 + 64 * (j))
#define XB_TOP      3328
#define XB_TOPGEN   3392
#define XCD_BAR_WORDS 3456
#define XB_SPIN_CAP (1u << 18)

__device__ __forceinline__ unsigned xb_ld(unsigned* p)              { return __hip_atomic_load(p, __ATOMIC_RELAXED, __HIP_MEMORY_SCOPE_AGENT); }
__device__ __forceinline__ unsigned xb_add(unsigned* p, unsigned v) { return __hip_atomic_fetch_add(p, v, __ATOMIC_RELAXED, __HIP_MEMORY_SCOPE_AGENT); }
__device__ __forceinline__ unsigned xb_xcc_id() { return (unsigned)__builtin_amdgcn_s_getreg((3 << 11) | 20) & 0xFu; }
#define XB_SPIN(cond, bar) do { unsigned _sp = 0; while (cond) { __builtin_amdgcn_s_sleep(1); \
    if ((++_sp & 255u) == 0u) { if (xb_ld(&(bar)[XB_TMO])) break; if (_sp > XB_SPIN_CAP) { atomicAdd(&(bar)[XB_TMO], 1u); break; } } } } while (0)

struct XcdBarrier {
    unsigned* bar; unsigned x;
    volatile unsigned* st;
};

__device__ __forceinline__ XcdBarrier xcd_barrier_post(unsigned* bar, volatile unsigned* st) {
    XcdBarrier b; b.bar = bar; b.x = xb_xcc_id(); b.st = st;
    if (mk_tid() == 0) (void)xb_add(&bar[XB_XCNT(b.x)], 1u);
    return b;
}
__device__ __forceinline__ void xcd_barrier_complete(unsigned* bar, unsigned x, unsigned& nloc, unsigned& nx) {
    const unsigned G = gridDim.x * gridDim.y * gridDim.z;
    unsigned sum, cnt, mine, sp = 0u;
    for (;;) {
        sum = 0u; cnt = 0u; mine = 0u;
#pragma unroll
        for (unsigned j = 0; j < 16; ++j) { const unsigned c = xb_ld(&bar[XB_XCNT(j)]); sum += c; cnt += (c > 0u) ? 1u : 0u; mine = (j == x) ? c : mine; }
        if (sum == G) break;
        __builtin_amdgcn_s_sleep(1);
        if ((++sp & 255u) == 0u) { if (xb_ld(&bar[XB_TMO])) break; if (sp > XB_SPIN_CAP) { atomicAdd(&bar[XB_TMO], 1u); break; } }
    }
    nloc = mine > 0u ? mine : 1u; nx = cnt > 0u ? cnt : 1u;
}

__device__ __forceinline__ void xcd_barrier(const XcdBarrier& b) {
    asm volatile("s_waitcnt vmcnt(0)" ::: "memory");
    __syncthreads();
    if (mk_tid() == 0) {
        unsigned* bar = b.bar;
        __builtin_amdgcn_s_waitcnt(0);
        unsigned nloc = b.st[0], nx = b.st[1];
        if (nloc == 0u) { xcd_barrier_complete(bar, b.x, nloc, nx); b.st[0] = nloc; b.st[1] = nx; }
        const unsigned old = xb_add(&bar[XB_XSUB(b.x)], 1u);
        const unsigned gen = old / nloc;
        if (old + 1u == (gen + 1u) * nloc) {
            __builtin_amdgcn_fence(__ATOMIC_RELEASE, "agent");
            asm volatile("s_waitcnt vmcnt(0)" ::: "memory");
            const unsigned og = xb_add(&bar[XB_TOP], 1u);
            const unsigned tg = og / nx;
            if (og + 1u == (tg + 1u) * nx) xb_add(&bar[XB_TOPGEN], 1u);
            else XB_SPIN(xb_ld(&bar[XB_TOPGEN]) == tg, bar);
            __builtin_amdgcn_fence(__ATOMIC_ACQUIRE, "agent");
            xb_add(&bar[XB_XGEN(b.x)], 1u);
            asm volatile("s_waitcnt vmcnt(0)" ::: "memory");
        } else {
            XB_SPIN(xb_ld(&bar[XB_XGEN(b.x)]) == gen, bar);
            __builtin_amdgcn_fence(__ATOMIC_ACQUIRE, "agent");
            asm volatile("s_waitcnt vmcnt(0)" ::: "memory");
        }
    }
    __syncthreads();
}

__device__ __forceinline__ void p_prologue(const Params& P, LAS unsigned char* lds) {
    int tid_ = mk_tid(); asm volatile("" : "+v"(tid_)); const int tid = tid_, G = gridDim.x, c = blockIdx.x;
    { h16* Hh = (h16*)(P.ws + WS_X16); const size_t nvec = (size_t)M_TOK * DM / 8;
      for (size_t v = (size_t)c * NT + tid; v < nvec; v += (size_t)G * NT) {
          const f32x4 a = __builtin_nontemporal_load((const f32x4*)P.x + 2 * v), b = __builtin_nontemporal_load((const f32x4*)P.x + 2 * v + 1);
          u32x4 w; w.x = pk2h(a[0], a[1]); w.y = pk2h(a[2], a[3]); w.z = pk2h(b[0], b[1]); w.w = pk2h(b[2], b[3]); ((u32x4*)Hh)[v] = w; } }
    LAS float* tile = (LAS float*)lds;
    float* csp = (float*)(P.ws + WS_CSP);
    for (int t = c; t < DEPTH * 3072; t += G) {
        const int l = t / 3072, r = t % 3072; const float* src; h16* dst; int K, N, tl; unsigned char* wl = P.ws + WS_W + (size_t)l * W_LAYER_B;
        const float* gv = nullptr; const float* bv = nullptr; int csoff = 0;
        if (r < 768)       { src = P.w_qkv  + (size_t)l * DM * 3 * DM; dst = (h16*)wl;                               K = DM; N = 3 * DM; tl = r; if (l > 0) { gv = P.ln_ffn_g + (l - 1) * DM; bv = P.ln_ffn_b + (l - 1) * DM; csoff = 8192; } }
        else if (r < 1024) { src = P.w_o    + (size_t)l * DM * DM;     dst = (h16*)(wl + W_QKV_B);                   K = DM; N = DM;     tl = r - 768; }
        else if (r < 2048) { src = P.w_up   + (size_t)l * DM * FF;     dst = (h16*)(wl + W_QKV_B + W_O_B);           K = DM; N = FF;     tl = r - 1024; gv = P.ln_mix_g + l * DM; bv = P.ln_mix_b + l * DM; csoff = l * 4096; }
        else               { src = P.w_down + (size_t)l * FF * DM;     dst = (h16*)(wl + W_QKV_B + W_O_B + W_UP_B);  K = FF; N = DM;     tl = r - 2048; }
        const int ntn = N / 64, k0 = (tl / ntn) * 64, n0 = (tl % ntn) * 64;
        { const int n = tid & 63, kb = tid >> 6;
#pragma unroll
          for (int i = 0; i < 8; ++i) { const int k = kb + 8 * i; tile[k * 65 + n] = __builtin_nontemporal_load(src + (size_t)(k0 + k) * N + n0 + n); } }
        __syncthreads();
        { const int k2 = (tid & 31) * 2, nb = tid >> 5; const float g0 = gv ? gv[k0 + k2] : 1.f, g1 = gv ? gv[k0 + k2 + 1] : 1.f;
#pragma unroll
          for (int i = 0; i < 4; ++i) { const int n = nb + 16 * i; const h16x2 v = {(h16)(tile[k2 * 65 + n] * g0), (h16)(tile[(k2 + 1) * 65 + n] * g1)}; *(h16x2*)(dst + (size_t)(n0 + n) * K + k0 + k2) = v; } }
        if (gv && tid < 64) { float sa = 0.f, sb = 0.f;
            for (int k = 0; k < 64; ++k) { const float wv = tile[k * 65 + tid]; sa += (float)(h16)(wv * gv[k0 + k]); sb += wv * bv[k0 + k]; }
            csp[(size_t)((k0 >> 6) * 2 + 0) * NCS + csoff + n0 + tid] = sa; csp[(size_t)((k0 >> 6) * 2 + 1) * NCS + csoff + n0 + tid] = sb; }
        __syncthreads();
    }
}

__device__ __forceinline__ void p_cs_finalize(const Params& P) {
    const float* csp = (const float*)(P.ws + WS_CSP); float* cs = (float*)(P.ws + WS_CS);
    int tid_ = mk_tid(); asm volatile("" : "+v"(tid_));
    for (int i = blockIdx.x * 88 + tid_; tid_ < 88 && i < 2 * NCS; i += gridDim.x * 88) {     const int v = i / NCS, cidx = i % NCS; float a = 0.f;
        float pv_[16];
#pragma unroll
        for (int kt = 0; kt < 16; ++kt) pv_[kt] = csp[(size_t)(kt * 2 + v) * NCS + cidx];
#pragma unroll
        for (int kt = 0; kt < 16; ++kt) a += pv_[kt];
        cs[i] = a; }
}

template <class Sched> __device__ __forceinline__ void p_fill_tables(LAS unsigned char* lds, const float* part, const Sched& S, const float* cvec, const float* bvec) {
    int tid_ = mk_tid(); asm volatile("" : "+v"(tid_)); const int tid = tid_;
    LAS unsigned char* tb = lds + ST_OFF; LAS pg8::f32x2_t* st = (LAS pg8::f32x2_t*)tb; LAS float* csl = (LAS float*)(tb + 8192); LAS float* bwl = (LAS float*)(tb + 12288); LAS int* sl = (LAS int*)(tb + 16384);
    if (tid < 16) { pg8::Unit u; const bool ok = S.next(tid, u); sl[48 + tid] = ok ? u.pm : -1; sl[64 + tid] = ok ? u.pn : -1; }
    __syncthreads();
    int fpm = 0, fpn = 0;
    if (tid < 16) { const int pm = sl[48 + tid], pn = sl[64 + tid]; fpm = tid; fpn = tid;
        for (int j = tid - 1; j >= 0; --j) { if (sl[48 + j] == pm) fpm = j; if (sl[64 + j] == pn) fpn = j; }
        sl[80 + tid] = (fpm == tid && pm >= 0) ? 1 : 0; sl[96 + tid] = (fpn == tid && pn >= 0) ? 1 : 0; }
    __syncthreads();
    if (tid < 16) { int ps = 0, cs_ = 0;
        for (int j = 0; j < fpm; ++j) ps += sl[80 + j];
        for (int j = 0; j < fpn; ++j) cs_ += sl[96 + j];
        ps = ps < 3 ? ps : 3; cs_ = cs_ < 3 ? cs_ : 3;
        sl[tid] = ps; sl[16 + tid] = cs_;
        if (fpm == tid && sl[48 + tid] >= 0) sl[32 + ps] = sl[48 + tid];
        if (fpn == tid && sl[64 + tid] >= 0) sl[36 + cs_] = sl[64 + tid];
        if (tid == 0) { int a = 0, b = 0; for (int j = 0; j < 16; ++j) { a += sl[80 + j]; b += sl[96 + j]; } sl[40] = a < 4 ? a : 4; sl[41] = b < 4 ? b : 4; } }
    __syncthreads();
    const int npm = sl[40], npn = sl[41];
    f32x4 pr[2][8]; float cvl[4];
#pragma unroll
    for (int jj = 0; jj < 2; ++jj) { const int j = (tid >> 8) + 2 * jj; const int pm = sl[32 + (j < npm ? j : 0)];
        const f32x4* pp = (const f32x4*)(part + (size_t)(pm * 256 + (tid & 255)) * 32);
#pragma unroll
        for (int x = 0; x < 8; ++x) pr[jj][x] = pp[x]; }
#pragma unroll
    for (int j = 0; j < 4; ++j) { const int pn = sl[36 + (j < npn ? j : 0)]; cvl[j] = (tid < 256) ? cvec[pn * 256 + tid] : bvec[pn * 256 + tid - 256]; }
#pragma unroll
    for (int jj = 0; jj < 2; ++jj) { const int j = (tid >> 8) + 2 * jj; if (j < npm) { float sa = 0.f, sq = 0.f;
#pragma unroll
            for (int x = 0; x < 8; ++x) { sa += pr[jj][x][0] + pr[jj][x][2]; sq += pr[jj][x][1] + pr[jj][x][3]; }
            const float mean = sa * (1.0f / 1024.0f), var = sq * (1.0f / 1024.0f) - mean * mean;
            st[j * 256 + (tid & 255)] = (pg8::f32x2_t){mean, 1.0f / sqrtf(var + LN_EPS)}; } }
#pragma unroll
    for (int j = 0; j < 4; ++j) if (j < npn) { if (tid < 256) csl[j * 256 + tid] = cvl[j]; else bwl[j * 256 + tid - 256] = cvl[j]; }
    __syncthreads();
}

__device__ __forceinline__ void p_kmean(const Params& P) {
    const h16* Kb = (const h16*)(P.ws + WS_K); float* KM = (float*)(P.ws + WS_KM);
    int tid_ = mk_tid(); asm volatile("" : "+v"(tid_)); const int lane = tid_ & 63, w = tid_ >> 6, sub = lane & 7, rr = lane >> 3;
    for (int it = blockIdx.x * 8 + w; it < 4096; it += gridDim.x * 8) {
        const int bh = it >> 3, n = it & 7, b = bh >> 4, h = bh & 15;
        const h16* p = Kb + ((size_t)bh * SEQ + n * 256 + rr) * DH + sub * 8;
        float a[8];
#pragma unroll
        for (int e = 0; e < 8; ++e) a[e] = 0.f;
#pragma unroll 8
        for (int i = 0; i < 32; ++i) { const h16x8 v = *(const h16x8*)(p + (size_t)i * 8 * DH);
#pragma unroll
            for (int e = 0; e < 8; ++e) a[e] += (float)v[e]; }
#pragma unroll
        for (int e = 0; e < 8; ++e) { a[e] += __shfl_xor(a[e], 8); a[e] += __shfl_xor(a[e], 16); a[e] += __shfl_xor(a[e], 32); a[e] *= (1.0f / 256.0f); }
        if (rr == 0) { float* o = KM + (size_t)it * 64 + sub * 8; *(f32x4*)o = (f32x4){a[0], a[1], a[2], a[3]}; *(f32x4*)(o + 4) = (f32x4){a[4], a[5], a[6], a[7]}; }
    }
}

template <bool FINAL> __device__ __forceinline__ void p_ln(const h16* Y, h16* Ho, float* Fo, const float* g, const float* bt, const float* part) {
    int tid_ = mk_tid(); asm volatile("" : "+v"(tid_)); const int lane = tid_ & 63, w = __builtin_amdgcn_readfirstlane(tid_ >> 6);
    float gg[16], bb[16];
#pragma unroll
    for (int e = 0; e < 8; ++e) { gg[e] = g[8 * lane + e]; gg[8 + e] = g[512 + 8 * lane + e]; bb[e] = bt[8 * lane + e]; bb[8 + e] = bt[512 + 8 * lane + e]; }
    for (int row = blockIdx.x * 8 + w; row < M_TOK; row += gridDim.x * 8) {
        const h16x8 v0 = *(const h16x8*)(Y + (size_t)row * DM + 8 * lane), v1 = *(const h16x8*)(Y + (size_t)row * DM + 512 + 8 * lane);
        const f32x4* pp = (const f32x4*)(part + (size_t)row * 32); float sa = 0.f, sq = 0.f;
#pragma unroll
        for (int k = 0; k < 8; ++k) { const f32x4 v = pp[k]; sa += v[0] + v[2]; sq += v[1] + v[3]; }
        const float mean = sa * (1.0f / 1024.0f), var = sq * (1.0f / 1024.0f) - mean * mean, rstd = 1.0f / sqrtf(var + LN_EPS);
        float x[16];
#pragma unroll
        for (int e = 0; e < 8; ++e) { x[e] = (float)v0[e]; x[8 + e] = (float)v1[e]; }
#pragma unroll
        for (int e = 0; e < 16; ++e) x[e] = (x[e] - mean) * rstd * gg[e] + bb[e];
        if (FINAL) { float* o = Fo + (size_t)row * DM + 8 * lane;
            *(f32x4*)o = (f32x4){x[0], x[1], x[2], x[3]}; *(f32x4*)(o + 4) = (f32x4){x[4], x[5], x[6], x[7]};
            *(f32x4*)(o + 512) = (f32x4){x[8], x[9], x[10], x[11]}; *(f32x4*)(o + 516) = (f32x4){x[12], x[13], x[14], x[15]}; }
        else { h16* o = Ho + (size_t)row * DM + 8 * lane; u32x4 a, b;
            a.x = pk2h(x[0], x[1]); a.y = pk2h(x[2], x[3]); a.z = pk2h(x[4], x[5]); a.w = pk2h(x[6], x[7]);
            b.x = pk2h(x[8], x[9]); b.y = pk2h(x[10], x[11]); b.z = pk2h(x[12], x[13]); b.w = pk2h(x[14], x[15]);
            *(u32x4*)o = a; *(u32x4*)(o + 512) = b; }
    }
}

namespace attn_body {
using bf16=_Float16;
using h16x8v=__attribute__((ext_vector_type(8)))_Float16;
using bf16x8=__attribute__((ext_vector_type(8)))short;
using s16x4=__attribute__((ext_vector_type(4)))short;
using f32x16=__attribute__((ext_vector_type(16)))float;
using u32x4=__attribute__((ext_vector_type(4)))unsigned;
constexpr int BATCH=32,NHEAD=16,SEQ=2048,D=64,DM=NHEAD*D;
constexpr int NW=8,QBLK=32,QB=QBLK*NW,KVBLK=64,NQB=SEQ/QB;
constexpr int ATTN_PITCH=DM, ATTN_UNIT_ROWS=QB;
__device__ __forceinline__ int crow(int r,int hi){return (r&3)+8*(r>>2)+4*hi;}
#define SBAR() __builtin_amdgcn_sched_barrier(0)
#define MF16(a,b,c,x,y,z) __builtin_amdgcn_mfma_f32_32x32x16_f16(__builtin_bit_cast(h16x8v,(a)),__builtin_bit_cast(h16x8v,(b)),(c),0,0,0)
__device__ __forceinline__ void cmask(f32x16&p0,f32x16&p1,int jb,int qrel,int hi){
  const float NEG=-INFINITY; int kb=64*jb+4*hi;
  #pragma unroll
  for(int r=0;r<16;++r){int kv=kb+(r&3)+8*(r>>2); if(kv>qrel)p0[r]=NEG; if(kv+32>qrel)p1[r]=NEG;}
}

constexpr int NSLOT=3, SLOTB=8192;
constexpr int LDS_K=0, LDS_V=NSLOT*SLOTB, LDS_WS=2*NSLOT*SLOTB, LDS_OST=LDS_WS+NW*64*4, LDS_BYTES=LDS_OST+NW*4096;
constexpr int LDS_KM=LDS_BYTES, LDS_BT=LDS_KM+2048, NBT=640, LDS_SEL=LDS_BT+4*NBT*4, LDS_TOTAL=LDS_SEL+NW*2048;
constexpr float C2=0.125f*1.4426950408889634f;
__device__ __forceinline__ void glds16(const void*gsrc,unsigned lds_dst){unsigned keep;
  asm volatile("s_mov_b32 %0, m0\n\ts_mov_b32 m0, %2\n\ts_nop 0\n\tglobal_load_lds_dwordx4 %1, off\n\ts_mov_b32 m0, %0":"=&s"(keep):"v"(gsrc),"s"(lds_dst):"memory");}
__device__ __forceinline__ float max3f(float a,float b,float c){float r;asm("v_max3_f32 %0, %1, %2, %3":"=v"(r):"v"(a),"v"(b),"v"(c));return r;}
__device__ __forceinline__ float max2f(float a,float b){float r;asm("v_max_f32_e32 %0, %1, %2":"=v"(r):"v"(a),"v"(b));return r;}
__device__ __forceinline__ float fadd_s(float a,float b){float r;asm("v_add_f32_e32 %0, %1, %2":"=v"(r):"v"(a),"v"(b));return r;}
__device__ __forceinline__ float fsub_s(float a,float b){float r;asm("v_sub_f32_e32 %0, %1, %2":"=v"(r):"v"(a),"v"(b));return r;}
typedef float f32x2_t __attribute__((ext_vector_type(2))); typedef _Float16 bf16x2_t __attribute__((ext_vector_type(2)));
__device__ __forceinline__ unsigned cvtpk_s(float lo,float hi){f32x2_t v={lo,hi};bf16x2_t b=__builtin_convertvector(v,bf16x2_t);return __builtin_bit_cast(unsigned,b);}
#define WAIT_BAR(N) asm volatile("s_waitcnt vmcnt(" #N ") lgkmcnt(0)\n\ts_barrier":::"memory")

__device__ __forceinline__ void qkt(f32x16&p0,f32x16&p1,const char*Kslot,const bf16x8*qr,const f32x16&negm,int r32,int hi){
  const char*kb=Kslot+hi*1024+r32*16;
  #pragma unroll
  for(int d0=0;d0<4;++d0){
    const bf16x8 b0=*reinterpret_cast<const bf16x8*>(kb+d0*2048);
    const bf16x8 b1=*reinterpret_cast<const bf16x8*>(kb+d0*2048+512);
    if(d0==0){p0=MF16(b0,qr[0],negm,0,0,0);p1=MF16(b1,qr[0],negm,0,0,0);}
    else{p0=MF16(b0,qr[d0],p0,0,0,0);p1=MF16(b1,qr[d0],p1,0,0,0);}}
}
typedef __attribute__((address_space(3))) const char* lds_cptr;
typedef short v4i16_t __attribute__((ext_vector_type(4)));
typedef float f32x4 __attribute__((ext_vector_type(4)));
__device__ __forceinline__ void kload8(bf16x8*kf,lds_cptr kp){
  kf[0]=*(const __attribute__((address_space(3))) bf16x8*)(kp);      kf[1]=*(const __attribute__((address_space(3))) bf16x8*)(kp+512);
  kf[2]=*(const __attribute__((address_space(3))) bf16x8*)(kp+2048); kf[3]=*(const __attribute__((address_space(3))) bf16x8*)(kp+2560);
  kf[4]=*(const __attribute__((address_space(3))) bf16x8*)(kp+4096); kf[5]=*(const __attribute__((address_space(3))) bf16x8*)(kp+4608);
  kf[6]=*(const __attribute__((address_space(3))) bf16x8*)(kp+6144); kf[7]=*(const __attribute__((address_space(3))) bf16x8*)(kp+6656);
}
__device__ __forceinline__ void kload2(bf16x8*kf,lds_cptr kp,int j){ kf[2*j]=*(const __attribute__((address_space(3))) bf16x8*)(kp+j*2048); kf[2*j+1]=*(const __attribute__((address_space(3))) bf16x8*)(kp+j*2048+512); }
__device__ __forceinline__ s16x4 vtr(lds_cptr p){ return __builtin_bit_cast(s16x4,__builtin_amdgcn_ds_read_tr16_b64_v4i16((__attribute__((address_space(3))) v4i16_t*)p)); }
__device__ __forceinline__ float rowmax(const f32x16&p0,const f32x16&p1){
  float a=max3f(p0[0],p0[1],p1[0]),b=max3f(p0[2],p0[3],p1[1]);a=max3f(a,p1[2],p1[3]);
  #pragma unroll
  for(int r=4;r<16;r+=4){a=max3f(a,p0[r],p0[r+1]);b=max3f(b,p0[r+2],p0[r+3]);a=max3f(a,p1[r],p1[r+1]);b=max3f(b,p1[r+2],p1[r+3]);}
  const float m=max2f(a,b);
  auto rr=__builtin_amdgcn_permlane32_swap(__float_as_uint(m),__float_as_uint(m),false,false);
  return max2f(__uint_as_float(rr[0]),__uint_as_float(rr[1]));
}
__device__ __forceinline__ void pv(f32x16*o,int vb,bf16x8 pa0,bf16x8 pa1,bf16x8 pa2,bf16x8 pa3){
  #pragma unroll
  for(int d0=0;d0<2;++d0){s16x4 lo[4],hi[4];
    #pragma unroll
    for(int ks=0;ks<4;++ks){
      asm volatile("ds_read_b64_tr_b16 %0,%1 offset:%c2":"=&v"(lo[ks]):"v"(vb),"i"(d0*4096+ks*1024):"memory");
      asm volatile("ds_read_b64_tr_b16 %0,%1 offset:%c2":"=&v"(hi[ks]):"v"(vb),"i"(d0*4096+ks*1024+512):"memory");}
    asm volatile("s_waitcnt lgkmcnt(0)":::"memory");SBAR();
    #define PK(k) (bf16x8){lo[k][0],lo[k][1],lo[k][2],lo[k][3],hi[k][0],hi[k][1],hi[k][2],hi[k][3]}
    o[d0]=MF16(pa0,PK(0),o[d0],0,0,0);
    o[d0]=MF16(pa1,PK(1),o[d0],0,0,0);
    o[d0]=MF16(pa2,PK(2),o[d0],0,0,0);
    o[d0]=MF16(pa3,PK(3),o[d0],0,0,0);
    #undef PK
  }
}

#ifndef ATTN_STORE16
#define ATTN_STORE16(p,v) (*(u32x4*)(p)=(v))
#endif
template<int THRL> __device__ __forceinline__ void attn_unit(int b,int h,int qb,const bf16*Q,const bf16*__restrict__ K,const bf16*__restrict__ V,bf16*O,char*shm,const float*KMg,const float*rel_bias,bool newhead,bf16x8 (&qr)[4],const bf16*Qnext){
  int tid_=mk_tid(); asm volatile("":"+v"(tid_));
  const int tid=tid_,lane=tid&63,r32=lane&31,hi=lane>>5; const int wid=__builtin_amdgcn_readfirstlane(tid>>6);
  const long rowbase=(long)b*SEQ; const int q0=qb*QB;
  typedef __attribute__((address_space(3))) float* lds_fptr;
  const lds_fptr kml=(lds_fptr)(shm+LDS_KM); const lds_fptr btl=(lds_fptr)(shm+LDS_BT);
  if(newhead){
    {
      const bf16*Kn=K+(long)(b*NHEAD+h)*SEQ*D+(long)(tid>>3)*D+(tid&7)*8; const lds_fptr kpart=(lds_fptr)(shm+LDS_TOTAL);
      h16x8v kv_[32];
      #pragma unroll
      for(int i=0;i<32;++i)kv_[i]=*reinterpret_cast<const h16x8v*>(Kn+(long)i*64*D);
      #pragma unroll
      for(int n=0;n<8;++n){ float a_[8];
        #pragma unroll
        for(int e=0;e<8;++e)a_[e]=((float)kv_[4*n][e]+(float)kv_[4*n+1][e])+((float)kv_[4*n+2][e]+(float)kv_[4*n+3][e]);
        #pragma unroll
        for(int e=0;e<8;++e){ a_[e]+=__shfl_xor(a_[e],8); a_[e]+=__shfl_xor(a_[e],16); a_[e]+=__shfl_xor(a_[e],32); }
        if((lane>>3)==0){
          #pragma unroll
          for(int e=0;e<8;++e)kpart[(wid*8+n)*64+(lane&7)*8+e]=a_[e]; } }
      asm volatile("s_waitcnt vmcnt(0) lgkmcnt(0)\n\ts_barrier":::"memory");
      float t_=0.f;
      #pragma unroll
      for(int w8=0;w8<8;++w8)t_+=kpart[w8*512+tid];
      kml[tid]=t_*(1.0f/256.0f); }
    for(int e=tid;e<4*NBT;e+=NW*64){ const int cpy=e/NBT,i=e%NBT,j=i+cpy; float v=-INFINITY;
      const int dist=(NBT-1-j)-256;
      if(j<NBT&&dist>=0){ int bk=dist; if(dist>=16){ bk=16+(int)(logf((float)dist/16.0f)/logf(8.0f)*16.0f); bk=bk<31?bk:31; } v=(rel_bias[bk*NHEAD+h]-rel_bias[31*NHEAD+h])*1.4426950408889634f; }
      btl[e]=v; }
    asm volatile("s_waitcnt vmcnt(0) lgkmcnt(0)\n\ts_barrier":::"memory"); }
  const bf16*Qw=Q+(rowbase+q0+wid*QBLK)*DM+h*D;
  const bf16*Kh=K+(long)(b*NHEAD+h)*SEQ*D,*Vh=V+(long)(b*NHEAD+h)*SEQ*D;
  const unsigned lds0=(unsigned)(uintptr_t)shm;
  float*wsf=(float*)(shm+LDS_WS)+wid*64;
  const bf16*ksrc=Kh+(long)lane*D+wid*8;
  const bf16*vsrc=Vh+(long)(16*(wid&3)+(lane>>2))*D+(wid>>2)*32+(lane&3)*8;
  const unsigned kdst=lds0+LDS_K+wid*1024, vdst=lds0+LDS_V+wid*1024;
  #define TKT(t) ((t)<4 ? NT-4+(t) : NT-1-(t))
  #define DMA_K(t,slot) glds16(ksrc+(long)(TKT(t))*KVBLK*D,(unsigned)__builtin_amdgcn_readfirstlane(kdst+(slot)))
  #define DMA_V(t,slot) glds16(vsrc+(long)(TKT(t))*KVBLK*D,(unsigned)__builtin_amdgcn_readfirstlane(vdst+(slot)))
  const int vb0=(int)(lds0+LDS_V)+((lane>>4)&1)*32+(lane&3)*8+(4*hi+((lane&15)>>2))*64;
  const char*Kbase=shm+LDS_K; bf16x8 kf[8];
  const lds_cptr shm3=(lds_cptr)shm; const lds_cptr kp0=shm3+LDS_K+hi*1024+r32*16; const lds_cptr vp0=shm3+LDS_V+((lane>>4)&1)*32+(lane&3)*8+(4*hi+((lane&15)>>2))*64;
  const int NT=(q0+QB)/KVBLK;
  DMA_K(0,0);DMA_V(0,0);DMA_K(1,SLOTB);
  unsigned sel=0u;
  if(qb>0){ float g[7];
    #pragma unroll
    for(int n=0;n<7;++n){ float a=0.f;
      if(n<qb){
        #pragma unroll
        for(int d0=0;d0<4;++d0){ const h16x8v qv=__builtin_bit_cast(h16x8v,qr[d0]);
          #pragma unroll
          for(int j=0;j<8;++j)a+=(float)qv[j]*kml[n*64+16*d0+8*hi+j]; } }
      { auto rr=__builtin_amdgcn_permlane32_swap(__float_as_uint(a),__float_as_uint(a),false,false); a=__uint_as_float(rr[0])+__uint_as_float(rr[1]); }
      g[n]=(n<qb)?a:-INFINITY; }
    if(qb<=3)sel=(1u<<qb)-1u;
    else{
      #pragma unroll
      for(int n=0;n<7;++n){ int rank=0;
        #pragma unroll
        for(int m=0;m<7;++m)if(m!=n)rank+=((g[m]>g[n])||(g[m]==g[n]&&m<n))?1:0;
        if(n<qb&&rank<3)sel|=1u<<n; } } }
  const bool mixed=qb>3;
  typedef __attribute__((address_space(3))) unsigned* lds_uptr;
  if(mixed){ *(lds_uptr)(shm3+LDS_SEL+wid*2048+hi*1024+r32*16)=sel; }
  float mhat=0.f,l_reg=0.f;f32x16 o[2];o[0]=f32x16{};o[1]=f32x16{};f32x16 negm=f32x16{};asm volatile("":"+v"(negm));
  const int qrel=wid*QBLK+r32;
  #define CMASK(P0,P1,t) do{ const int t_=(t); const int kt_=TKT(t_); \
    if(t_<6){ const int s_=(NBT-1)-(q0+qrel-64*kt_-4*hi+256), c_=s_&3; const __attribute__((address_space(3))) f32x4* tp_=(const __attribute__((address_space(3))) f32x4*)(shm3+LDS_BT+c_*(NBT*4)+(s_-c_)*4); \
      f32x4 b0_[4],b1_[4]; _Pragma("unroll") for(int g=0;g<4;++g){ b0_[g]=tp_[2*g]; b1_[g]=tp_[2*g+8]; } \
      _Pragma("unroll") for(int g=0;g<4;++g) _Pragma("unroll") for(int e=0;e<4;++e){ P0[4*g+e]+=b0_[g][e]; P1[4*g+e]+=b1_[g][e]; } } \
    if(t_>=4&&mixed){ const unsigned sel_=sel; if(((sel_>>(kt_>>2))&1u)==0u){ _Pragma("unroll") for(int r=0;r<16;++r){P0[r]=-INFINITY;P1[r]=-INFINITY;} } } }while(0)
  bool resc=false;
  #define START(P0,P1) do{ const float rm=rowmax(P0,P1); resc=false; \
    { const float dl=rm; mhat=fadd_s(mhat,dl); \
      _Pragma("unroll") for(int r=0;r<16;++r){P0[r]=fsub_s(P0[r],dl);P1[r]=fsub_s(P1[r],dl);} \
      _Pragma("unroll") for(int r=0;r<16;++r)negm[r]=-mhat; asm volatile("":"+v"(negm)); } \
    _Pragma("unroll") for(int r=0;r<16;++r)P0[r]=__builtin_amdgcn_exp2f(P0[r]); }while(0)
  #define RESC() do{ if(resc){ asm volatile("s_waitcnt lgkmcnt(0)":::"memory"); \
      _Pragma("unroll") for(int d_=0;d_<2;++d_) _Pragma("unroll") for(int r=0;r<16;++r)o[d_][r]*=wsf[crow(r,hi)]; } }while(0)
  f32x16 pA0,pA1,pB0,pB1;
  int sl_prev=0,sl_cur=0,sl_next=SLOTB;
  #define ROT() do{sl_prev=sl_cur;sl_cur=sl_next;sl_next=(sl_next==(NSLOT-1)*SLOTB)?0:sl_next+SLOTB;}while(0)
  DMA_K(2,2*SLOTB);
  WAIT_BAR(3);
  qkt(pA0,pA1,Kbase,qr,negm,r32,hi);asm volatile("s_nop 15\n\ts_nop 7":"+v"(pA0),"+v"(pA1));CMASK(pA0,pA1,0);
  START(pA0,pA1);
  _Pragma("unroll") for(int r=0;r<16;++r)pA1[r]=__builtin_amdgcn_exp2f(pA1[r]);
  WAIT_BAR(0);
  DMA_K(3,0);DMA_V(1,SLOTB);
  ROT();
  kload8(kf,kp0+sl_cur);
  WAIT_BAR(2);
  s16x4 vlo[8],vhi[8]; u32x4 pw0,pw1,pw2,pw3;
  #define PKW(P,B) cvtpk_s(P[B],P[B+1])
  #define PAF(k) __builtin_bit_cast(bf16x8,pw##k)
  #define VFR(i) (bf16x8){vlo[i][0],vlo[i][1],vlo[i][2],vlo[i][3],vhi[i][0],vhi[i][1],vhi[i][2],vhi[i][3]}
  #define PIN(x) asm volatile("":"+v"(x))
  #define MX3(a,b,c) __builtin_fmaxf(__builtin_fmaxf((a),(b)),(c))
  #define GAPA(MF,A0,A1,A2,A3,W0,W1,PW) do{ MF; sacc+=A0; sacc+=A1; sacc+=A2; sacc+=A3; PIN(sacc); W0; W1; PIN(PW); SBAR(); }while(0)
  #define EX(v) __builtin_amdgcn_exp2f(v)
  #define GAPB(MF,X,B) do{ MF; X[B]=EX(X[B]); X[B+1]=EX(X[B+1]); X[B+2]=EX(X[B+2]); X[B+3]=EX(X[B+3]); PIN(X); SBAR(); }while(0)
  #define VRD(i) do{ vlo[i]=vtr(vp_+(((i)>>2)*4096+((i)&3)*1024)); vhi[i]=vtr(vp_+(((i)>>2)*4096+((i)&3)*1024+512)); }while(0)
  #define KRD(G,j) do{ if(G){ kload2(kf,kp0+sl_next,j); SBAR(); } }while(0)
  #define STEP(C0,C1,P0,P1,t,GK,GV,GL) do{ SBAR(); \
    const lds_cptr vp_=vp0+sl_prev; \
    VRD(0); SBAR(); float sacc=(P0[0]+P0[1]); \
    GAPA(C0=MF16(kf[0],qr[0],negm,0,0,0), P0[2],P0[3],P0[4],P0[5],     pw0[0]=PKW(P0,0), pw0[1]=PKW(P0,2), pw0); \
    VRD(4); SBAR(); GAPA(C1=MF16(kf[1],qr[0],negm,0,0,0), P0[6],P0[7],P0[8],P0[9],     pw0[2]=PKW(P0,4), pw0[3]=PKW(P0,6), pw0); \
    VRD(1); SBAR(); GAPA(C0=MF16(kf[2],qr[1],C0,0,0,0),   P0[10],P0[11],P0[12],P0[13], pw1[0]=PKW(P0,8), pw1[1]=PKW(P0,10), pw1); \
    VRD(5); SBAR(); GAPA(C1=MF16(kf[3],qr[1],C1,0,0,0),   P0[14],P0[15],P1[0],P1[1],   pw1[2]=PKW(P0,12),pw1[3]=PKW(P0,14), pw1); \
    VRD(2); SBAR(); GAPA(C0=MF16(kf[4],qr[2],C0,0,0,0),   P1[2],P1[3],P1[4],P1[5],     pw2[0]=PKW(P1,0), pw2[1]=PKW(P1,2), pw2); \
    VRD(6); SBAR(); GAPA(C1=MF16(kf[5],qr[2],C1,0,0,0),   P1[6],P1[7],P1[8],P1[9],     pw2[2]=PKW(P1,4), pw2[3]=PKW(P1,6), pw2); \
    VRD(3); SBAR(); GAPA(C0=MF16(kf[6],qr[3],C0,0,0,0),   P1[10],P1[11],P1[12],P1[13], pw3[0]=PKW(P1,8), pw3[1]=PKW(P1,10), pw3); \
    VRD(7); SBAR(); GAPA(C1=MF16(kf[7],qr[3],C1,0,0,0),   P1[14],P1[15],0.f,0.f,       pw3[2]=PKW(P1,12),pw3[3]=PKW(P1,14), pw3); \
    l_reg+=sacc; \
    if(GK){DMA_K((t)+3,sl_cur);} if(GV){DMA_V((t)+1,sl_next);} \
    CMASK(C0,C1,t); \
    { float a=MX3(C0[0],C0[1],C1[0]),b=MX3(C0[2],C0[3],C1[1]); a=MX3(a,C1[2],C1[3]); \
      _Pragma("unroll") for(int r=4;r<16;r+=4){a=MX3(a,C0[r],C0[r+1]);b=MX3(b,C0[r+2],C0[r+3]);a=MX3(a,C1[r],C1[r+1]);b=MX3(b,C1[r+2],C1[r+3]);} \
      float rm=__builtin_fmaxf(a,b); { auto rr=__builtin_amdgcn_permlane32_swap(__float_as_uint(rm),__float_as_uint(rm),false,false); rm=__builtin_fmaxf(__uint_as_float(rr[0]),__uint_as_float(rr[1])); } \
      resc=false; \
      if(__builtin_expect(__any(rm>(float)THRL),0)){ const float dl=__builtin_fmaxf(rm,0.f); mhat+=dl; \
        _Pragma("unroll") for(int r=0;r<16;++r){C0[r]-=dl;C1[r]-=dl;} \
        _Pragma("unroll") for(int r=0;r<16;++r)negm[r]=-mhat; asm volatile("":"+v"(negm)); \
        const float f=__builtin_amdgcn_exp2f(-dl); l_reg*=f; { int r32o_=r32; asm volatile("":"+v"(r32o_)); if(hi==0)wsf[r32o_]=f; }     resc=true; } } \
    SBAR(); \
    GAPB(o[0]=MF16(PAF(0),VFR(0),o[0],0,0,0), C0,0); \
    GAPB(o[1]=MF16(PAF(0),VFR(4),o[1],0,0,0), C0,4); \
    KRD(GL,0); GAPB(o[0]=MF16(PAF(1),VFR(1),o[0],0,0,0), C0,8); \
    KRD(GL,1); GAPB(o[1]=MF16(PAF(1),VFR(5),o[1],0,0,0), C0,12); \
    KRD(GL,2); GAPB(o[0]=MF16(PAF(2),VFR(2),o[0],0,0,0), C1,0); \
    KRD(GL,3); GAPB(o[1]=MF16(PAF(2),VFR(6),o[1],0,0,0), C1,4); \
    GAPB(o[0]=MF16(PAF(3),VFR(3),o[0],0,0,0), C1,8); \
    GAPB(o[1]=MF16(PAF(3),VFR(7),o[1],0,0,0), C1,12); \
    }while(0)
  int t=1;
  #define ENDW(tt) do{ if((tt)+3<NT){WAIT_BAR(2);} else if((tt)+2<NT){WAIT_BAR(1);} else {WAIT_BAR(0);} }while(0)
  for(;t<7&&t+1<NT;t+=2){
    STEP(pB0,pB1,pA0,pA1,t,(t+3<NT),(t+1<NT),(t+1<NT));       ENDW(t);   RESC(); ROT();
    STEP(pA0,pA1,pB0,pB1,t+1,(t+4<NT),(t+2<NT),(t+2<NT));     ENDW(t+1); RESC(); ROT();
  }
  #pragma push_macro("CMASK")
  #undef CMASK
  #define CMASK(P0,P1,t) do{ if(mixed){ const unsigned sel_=sel; if(((sel_>>(TKT(t)>>2))&1u)==0u){ _Pragma("unroll") for(int r=0;r<16;++r){P0[r]=-INFINITY;P1[r]=-INFINITY;} } } }while(0)
  for(;t+5<NT;t+=2){
    STEP(pB0,pB1,pA0,pA1,t,true,true,true);     WAIT_BAR(2); RESC(); ROT();
    STEP(pA0,pA1,pB0,pB1,t+1,true,true,true);   WAIT_BAR(2); RESC(); ROT();
  }
  #pragma pop_macro("CMASK")
  for(;t+1<NT;t+=2){
    STEP(pB0,pB1,pA0,pA1,t,(t+3<NT),(t+1<NT),(t+1<NT));       ENDW(t);   RESC(); ROT();
    STEP(pA0,pA1,pB0,pB1,t+1,(t+4<NT),(t+2<NT),(t+2<NT));     ENDW(t+1); RESC(); ROT();
  }
  STEP(pB0,pB1,pA0,pA1,NT-1,false,false,false); RESC();
  if(Qnext){
    #pragma unroll
    for(int d0=0;d0<4;++d0)qr[d0]=*reinterpret_cast<const bf16x8*>(&Qnext[(long)(wid*QBLK+r32)*DM+d0*16+hi*8]); }
  { float sacc=pB0[0]+pB0[1]; _Pragma("unroll") for(int r=2;r<16;++r)sacc+=pB0[r]; _Pragma("unroll") for(int r=0;r<16;++r)sacc+=pB1[r]; l_reg+=sacc;
    pw0=(u32x4){PKW(pB0,0),PKW(pB0,2),PKW(pB0,4),PKW(pB0,6)};pw1=(u32x4){PKW(pB0,8),PKW(pB0,10),PKW(pB0,12),PKW(pB0,14)};pw2=(u32x4){PKW(pB1,0),PKW(pB1,2),PKW(pB1,4),PKW(pB1,6)};pw3=(u32x4){PKW(pB1,8),PKW(pB1,10),PKW(pB1,12),PKW(pB1,14)};
    SBAR(); pv(o,vb0+sl_cur,PAF(0),PAF(1),PAF(2),PAF(3)); }
  #undef PKW
  #undef PAF
  #undef VFR
  #undef PIN
  #undef MX3
  #undef GAPA
  #undef GAPB
  #undef EX
  #undef VRD
  #undef KRD
  #undef STEP
  #undef ENDW
  {auto rr=__builtin_amdgcn_permlane32_swap(__float_as_uint(l_reg),__float_as_uint(l_reg),false,false);l_reg=__uint_as_float(rr[0])+__uint_as_float(rr[1]);}
  if(hi==0)wsf[32+r32]=l_reg;asm volatile("s_waitcnt lgkmcnt(0)":::"memory");
  float rli[16];
  #pragma unroll
  for(int r=0;r<16;++r)rli[r]=__builtin_amdgcn_rcpf(wsf[32+crow(r,hi)]);
  bf16*Ow=O+(rowbase+q0+wid*QBLK)*DM+h*D;
  { bf16*stg=(bf16*)(shm+LDS_OST)+wid*2048;
    #pragma unroll
    for(int r=0;r<16;++r){const int orow=crow(r,hi);
      #pragma unroll
      for(int d0=0;d0<2;++d0)stg[orow*64+d0*32+r32]=(bf16)(o[d0][r]*rli[r]);}
    asm volatile("s_waitcnt lgkmcnt(0)":::"memory");
    #pragma unroll
    for(int i=0;i<4;++i){const int row=i*8+(lane>>3),ch=lane&7; const u32x4 v=*(const u32x4*)(stg+row*64+ch*8); ATTN_STORE16(Ow+(long)row*DM+ch*8,v);} }
  asm volatile("s_waitcnt lgkmcnt(0)\n\ts_barrier":::"memory");
  #undef DMA_K
  #undef DMA_V
  #undef CMASK
  #undef START
  #undef RESC
  #undef ROT
}
constexpr int ATTN_LDS_BYTES=LDS_TOTAL;
#undef SBAR
#undef WAIT_BAR
}

constexpr int KP = 144, TILE_B = 64 * KP;
constexpr int A_K = 0, A_V = 2 * TILE_B, A_KM = 4 * TILE_B, A_BT = A_KM + 2048, A_FL = A_BT + 1280, NBT = 320;

#define ATT_COMMON_SETUP \
    int tid_ = mk_tid(); asm volatile("" : "+v"(tid_)); \
    const int tid = tid_, lane = tid & 63, w = __builtin_amdgcn_readfirstlane(tid >> 6), r = lane & 31, hh = lane >> 5; \
    const int srow = tid >> 3, sch = tid & 7; \
    const int i16 = lane & 15, q4 = i16 >> 2, p4 = i16 & 3, blk = (lane >> 4) & 1; \
    const int voff = (4 * hh + q4) * KP + (16 * blk + 4 * p4) * 2; \
    const int koff = r * KP + 16 * hh; \
    const h16* Qb = (const h16*)(P.ws + WS_Q); const h16* Kb = (const h16*)(P.ws + WS_K); const h16* Vb = (const h16*)(P.ws + WS_V); h16* Ob = (h16*)(P.ws + WS_O);

#define ATT_QK(s, kbuf, cinit) do { h16x8 kf_[2][4]; \
        _Pragma("unroll") for (int kb = 0; kb < 2; ++kb) _Pragma("unroll") for (int ks = 0; ks < 4; ++ks) kf_[kb][ks] = *(const LAS h16x8*)((kbuf) + koff + kb * 32 * KP + ks * 32); \
        __builtin_amdgcn_sched_barrier(0); \
        _Pragma("unroll") for (int kb = 0; kb < 2; ++kb) _Pragma("unroll") for (int i = 0; i < 16; ++i) s[kb][i] = (cinit); \
        _Pragma("unroll") for (int ks = 0; ks < 4; ++ks) _Pragma("unroll") for (int kb = 0; kb < 2; ++kb) s[kb] = MFMA32(kf_[kb][ks], qf[ks], s[kb]); } while (0)
#define ATT_QK_ACC(s, kbuf) do { h16x8 kf_[2][4]; \
        _Pragma("unroll") for (int kb = 0; kb < 2; ++kb) _Pragma("unroll") for (int ks = 0; ks < 4; ++ks) kf_[kb][ks] = *(const LAS h16x8*)((kbuf) + koff + kb * 32 * KP + ks * 32); \
        __builtin_amdgcn_sched_barrier(0); \
        _Pragma("unroll") for (int ks = 0; ks < 4; ++ks) _Pragma("unroll") for (int kb = 0; kb < 2; ++kb) s[kb] = MFMA32(kf_[kb][ks], qf[ks], s[kb]); } while (0)
#define ATT_LOADV(vf, vbuf) do { _Pragma("unroll") for (int s4 = 0; s4 < 4; ++s4) _Pragma("unroll") for (int db = 0; db < 2; ++db) { const LAS unsigned char* vp = (vbuf) + voff + 16 * s4 * KP + 64 * db; vf[s4][db] = tr8(vp, vp + 8 * KP); } \
        __builtin_amdgcn_sched_barrier(0); } while (0)
#define ATT_PV(o, s, vf) do { _Pragma("unroll") for (int s4 = 0; s4 < 4; ++s4) { const h16x8 pf = pack8(s[s4 >> 1], s4 & 1); \
        _Pragma("unroll") for (int db = 0; db < 2; ++db) o[db] = MFMA32(vf[s4][db], pf, o[db]); } } while (0)

__device__ __forceinline__ void p_attn_moba(const Params& P, unsigned char* lds_generic) {
    int prev_bh = -1;
    const h16* Qg = (const h16*)(P.ws + WS_Q);
#define MOBA_QBASE(L_) (Qg + ((size_t)((((L_) & 255) + 256 * ((L_) >> 11)) >> 4) * SEQ + 256 * (((L_) >> 8) & 7)) * DM + ((((L_) & 255) + 256 * ((L_) >> 11)) & 15) * DH)
    attn_body::bf16x8 qr[4];
    { int tid_ = mk_tid(); asm volatile("" : "+v"(tid_)); const int lane_ = tid_ & 63, wid_ = tid_ >> 6; const h16* q0p = MOBA_QBASE((int)blockIdx.x) + (size_t)(wid_ * 32 + (lane_ & 31)) * DM + (lane_ >> 5) * 8;
#pragma unroll
      for (int d0 = 0; d0 < 4; ++d0) qr[d0] = *reinterpret_cast<const attn_body::bf16x8*>(q0p + d0 * 16); }
    for (int L = blockIdx.x; L < 4096; L += gridDim.x) {
        const int qb = (L >> 8) & 7, bh = (L & 255) + 256 * (L >> 11), b = bh >> 4, h = bh & 15; const int Ln = L + (int)gridDim.x;
        attn_body::attn_unit<8>(b, h, qb, Qg, (const h16*)(P.ws + WS_K), (const h16*)(P.ws + WS_V), (h16*)(P.ws + WS_O), (char*)lds_generic,
                                (const float*)(P.ws + WS_KM) + (size_t)bh * 512, P.rel_bias, bh != prev_bh, qr, Ln < 4096 ? MOBA_QBASE(Ln) : nullptr);
        prev_bh = bh;
    }
}

__device__ __forceinline__ void p_attn_sb(const Params& P, LAS unsigned char* lds) {
    ATT_COMMON_SETUP
    LAS int* flags = (LAS int*)(lds + A_FL);
    h16x8 uf[2], ones;
#pragma unroll
    for (int ks = 0; ks < 2; ++ks)
#pragma unroll
        for (int jj = 0; jj < 8; ++jj) { const int k = 16 * ks + 8 * (jj >> 2) + 4 * hh + (jj & 3); uf[ks][jj] = (k > r) ? (h16)1.0f : (h16)0.0f; }
#pragma unroll
    for (int jj = 0; jj < 8; ++jj) ones[jj] = (h16)1.0f;
    u32x4 pk0, pv0; h16x8 qf[4];
#define SB_PREFETCH(L_) do { const int qb_ = ((L_) >> 8) & 7, bh_ = ((L_) & 255) + 256 * ((L_) >> 11); const size_t go_ = ((size_t)bh_ * SEQ + 64 * (4 * qb_ + 3) + srow) * DH + sch * 8; \
        pk0 = *(const u32x4*)(Kb + go_); pv0 = *(const u32x4*)(Vb + go_); \
        const h16* qp_ = Qb + ((size_t)(bh_ >> 4) * SEQ + 256 * qb_ + 32 * w + r) * DM + (bh_ & 15) * DH + 8 * hh; \
        _Pragma("unroll") for (int ks = 0; ks < 4; ++ks) qf[ks] = *(const h16x8*)(qp_ + 16 * ks); } while (0)
    if ((int)blockIdx.x < 4096) SB_PREFETCH((int)blockIdx.x);
    for (int L = blockIdx.x; L < 4096; L += gridDim.x) {
        const int qb = (L >> 8) & 7, bh = (L & 255) + 256 * (L >> 11), b = bh >> 4, h = bh & 15;
        const size_t tokbase = (size_t)b * SEQ;
        const h16* Kg = Kb + (size_t)bh * SEQ * DH; const h16* Vg = Vb + (size_t)bh * SEQ * DH;
        const int t = 256 * qb + 32 * w + r;
        const int nt = 4 * qb + 4;
        asm volatile("s_waitcnt lgkmcnt(0)\n\ts_barrier" ::: "memory");
        if (tid < 16) flags[tid] = 0;
        *(LAS u32x4*)(lds + A_K + srow * KP + sch * 16) = pk0; *(LAS u32x4*)(lds + A_V + srow * KP + sch * 16) = pv0;
        asm volatile("s_waitcnt lgkmcnt(0)\n\ts_barrier" ::: "memory");
        float carry = 0.f; bool wdone = false; f32x16 o[2];
#pragma unroll
        for (int i = 0; i < 16; ++i) { o[0][i] = 0.f; o[1][i] = 0.f; }
        for (int j = 0; j < nt; ++j) {
            const int kt = nt - 1 - j; const bool more = (j + 1 < nt);
            const size_t go = (size_t)(64 * (more ? kt - 1 : kt) + srow) * DH + sch * 8; const u32x4 kreg = *(const u32x4*)(Kg + go), vreg = *(const u32x4*)(Vg + go);
            const LAS unsigned char* kbuf = lds + A_K + (j & 1) * TILE_B; const LAS unsigned char* vbuf = lds + A_V + (j & 1) * TILE_B;
            const int jo = kt - 4 * qb;
            const bool active = !wdone && (jo < 0 || 2 * jo <= w);
            if (active) {
                f32x16 z[2], lk[2];
                const bool diag = (64 * kt + 63 >= 256 * qb + 32 * w);
                const int sb = 64 * kt;
                if (diag) {
#pragma unroll
                    for (int kb = 0; kb < 2; ++kb)
#pragma unroll
                        for (int i = 0; i < 16; ++i) z[kb][i] = (sb + 32 * kb + crow(i, hh) < t) ? 0.f : -1.0e30f;
                } else {
#pragma unroll
                    for (int i = 0; i < 16; ++i) { z[0][i] = 0.f; z[1][i] = 0.f; } }
                ATT_QK_ACC(z, kbuf);
                h16x8 vf[4][2]; ATT_LOADV(vf, vbuf);
#pragma unroll
                for (int kb = 0; kb < 2; ++kb)
#pragma unroll
                    for (int i = 0; i < 16; ++i) { const float zz = z[kb][i]; const float e = ex2(-fabsf(zz)); lk[kb][i] = -(fmaxf(zz, 0.f) + lg2(1.0f + e)); }
                const h16x8 x00 = pack8(lk[0], 0), x01 = pack8(lk[0], 1), x10 = pack8(lk[1], 0), x11 = pack8(lk[1], 1);
                const float lk00 = lk[0][0], lb00 = z[0][0] + lk00;
#pragma unroll
                for (int i = 0; i < 16; ++i) { z[0][i] += lk[0][i]; z[1][i] += lk[1][i]; }
                z[0][0] = 0.f;
                f32x16 y0 = MFMA32(uf[0], x00, z[0]), y1 = MFMA32(uf[0], x10, z[1]);
                y0 = MFMA32(uf[1], x01, y0); y1 = MFMA32(uf[1], x11, y1); y0 = MFMA32(ones, x10, y0); y0 = MFMA32(ones, x11, y0);
                float tot = y0[0] + lk00;
                { auto rr_ = __builtin_amdgcn_permlane32_swap(__float_as_uint(tot), __float_as_uint(tot), false, false); tot = __uint_as_float(rr_[0]); }
                y0[0] += lb00;
#pragma unroll
                for (int i = 0; i < 16; ++i) { z[0][i] = ex2(y0[i] + carry); z[1][i] = ex2(y1[i] + carry); }
                carry += tot;
                ATT_PV(o, z, vf);
                wdone = (__ballot(carry < -151.0f) == ~0ull);
            }
            if (wdone && lane == 0) flags[(j & 1) * 8 + w] = 1;
            if (more) { *(LAS u32x4*)(lds + A_K + ((j + 1) & 1) * TILE_B + srow * KP + sch * 16) = kreg; *(LAS u32x4*)(lds + A_V + ((j + 1) & 1) * TILE_B + srow * KP + sch * 16) = vreg; }
            __syncthreads();
            const u32x4 fa_ = *(const LAS u32x4*)(flags + (j & 1) * 8), fb_ = *(const LAS u32x4*)(flags + (j & 1) * 8 + 4);
            if ((fa_.x + fa_.y + fa_.z + fa_.w) + (fb_.x + fb_.y + fb_.z + fb_.w) == 8u) break;
        }
        { const int Ln = L + (int)gridDim.x; if (Ln < 4096) SB_PREFETCH(Ln); }
        h16* op = Ob + (tokbase + t) * DM + h * DH + 4 * hh;
#pragma unroll
        for (int db = 0; db < 2; ++db)
#pragma unroll
            for (int gq = 0; gq < 4; ++gq) { u32x2 wv; wv.x = pk2h(o[db][4 * gq], o[db][4 * gq + 1]); wv.y = pk2h(o[db][4 * gq + 2], o[db][4 * gq + 3]); *(u32x2*)(op + 32 * db + 8 * gq) = wv; }
    }
}

__global__ void __launch_bounds__(NT) fwd_megakernel(Params P) {
    extern __shared__ __attribute__((aligned(16))) unsigned char lds_raw[];
    LAS unsigned char* lds = (LAS unsigned char*)lds_raw;
    cg::grid_group grid = cg::this_grid();
    { const unsigned hw = (unsigned)__builtin_amdgcn_s_getreg((5 << 11) | 4) & 63u; ((LAS int*)(uintptr_t)MK_WTAB)[hw] = (int)(threadIdx.x >> 6); }
    __syncthreads();
    const int lo = P.ph_lo, hi = P.ph_hi, G = gridDim.x, c = blockIdx.x;
#define RUN(k) (lo <= (k) && (k) < hi)
#define SEAM(k) do { if (RUN(k) && hi - lo > 1) xcd_barrier(bar); } while (0)
    volatile unsigned* st = (volatile unsigned*)(P.ws + WS_BARST) + 4 * blockIdx.x;
    XcdBarrier bar; bar.bar = (unsigned*)(P.ws + WS_BAR); bar.x = 0; bar.st = nullptr;
    if (hi - lo > 1) bar = xcd_barrier_post((unsigned*)(P.ws + WS_BAR), st);
    if (hi < 0) grid.sync();
    h16* Xh = (h16*)(P.ws + WS_X16); h16* Y1 = (h16*)(P.ws + WS_YA); h16* Y2 = (h16*)(P.ws + WS_YB); h16* Qh = (h16*)(P.ws + WS_Q); h16* Oh = (h16*)(P.ws + WS_O); h16* Uh = (h16*)(P.ws + WS_U);
    pg8::f32x2_t* ST1 = (pg8::f32x2_t*)(P.ws + WS_ST1); pg8::f32x2_t* ST2 = (pg8::f32x2_t*)(P.ws + WS_ST2); const float* CS = (const float*)(P.ws + WS_CS); const float* BW = CS + NCS;
    const LAS unsigned char* tbl = lds + ST_OFF;
    if (RUN(0)) p_prologue(P, lds);
    SEAM(0);
#pragma unroll 1
    for (int l = 0; l < DEPTH; ++l) {
        const int pb = 1 + 8 * l; unsigned char* wl = P.ws + WS_W + (size_t)l * W_LAYER_B;
        const h16* Wqkv = (const h16*)wl; const h16* Wo = (const h16*)(wl + W_QKV_B); const h16* Wup = (const h16*)(wl + W_QKV_B + W_O_B); const h16* Wdn = (const h16*)(wl + W_QKV_B + W_O_B + W_UP_B);
        if (RUN(pb + 0)) {
            pg8::StaticOrder S; S.init(M_TOK, 3 * DM, G, c);
            if (l == 0) { pg8::Gemm g{Xh, Wqkv, M_TOK, 3 * DM, DM}; pg8::Epi<0, false> E{Qh, DM, DM, (size_t)(WS_K - WS_Q) / 2, QSCALE, nullptr, 0.f, nullptr, nullptr};
                pg8::gemm_phase<pg8::Epi<0, false>, pg8::StaticOrder, true, true>(lds, g, S, E); }
            else { p_fill_tables(lds, (const float*)ST2, S, CS + 8192, BW + 8192);
                pg8::Gemm g{Y2, Wqkv, M_TOK, 3 * DM, DM}; pg8::Epi<0, true> E{Qh, DM, DM, (size_t)(WS_K - WS_Q) / 2, QSCALE, nullptr, 0.f, tbl, nullptr};
                pg8::gemm_phase<pg8::Epi<0, true>, pg8::StaticOrder, true, true>(lds, g, S, E); } }
        SEAM(pb + 0);
        if (RUN(pb + 2)) { if (l == 0) { p_cs_finalize(P); p_attn_moba(P, lds_raw); } else p_attn_sb(P, lds); }
        SEAM(pb + 2);
        if (RUN(pb + 3)) {
            pg8::Gemm g{Oh, Wo, M_TOK, DM, DM}; pg8::StaticOrder S; S.init(M_TOK, DM, G, c);
            if (l == 0) { pg8::Epi<2, false> E{Y1, DM, 0, 0, 1.f, Xh, ALPHA, nullptr, ST1};
                pg8::gemm_phase<pg8::Epi<2, false>, pg8::StaticOrder, true, true>(lds, g, S, E); }
            else { p_fill_tables(lds, (const float*)ST2, S, P.ln_ffn_g + (l - 1) * DM, P.ln_ffn_b + (l - 1) * DM);
                pg8::Epi<2, true> E{Y1, DM, 0, 0, 1.f, Y2, ALPHA, tbl, ST1};
                pg8::gemm_phase<pg8::Epi<2, true>, pg8::StaticOrder, true, true>(lds, g, S, E); } }
        SEAM(pb + 3);
        if (RUN(pb + 5)) {
            pg8::Gemm g{Y1, Wup, M_TOK, FF, DM}; pg8::StaticOrder S; S.init(M_TOK, FF, G, c);
            p_fill_tables(lds, (const float*)ST1, S, CS + l * 4096, BW + l * 4096);
            pg8::Epi<1, true> E{Uh, FF, 0, 0, 1.f, nullptr, 0.f, tbl, nullptr};
            pg8::gemm_phase<pg8::Epi<1, true>, pg8::StaticOrder, true, true>(lds, g, S, E); }
        SEAM(pb + 5);
        if (RUN(pb + 6)) {
            pg8::Gemm g{Uh, Wdn, M_TOK, DM, FF}; pg8::StaticOrder S; S.init(M_TOK, DM, G, c);
            p_fill_tables(lds, (const float*)ST1, S, P.ln_mix_g + l * DM, P.ln_mix_b + l * DM);
            pg8::Epi<2, true> E{Y2, DM, 0, 0, 1.f, Y1, ALPHA, tbl, ST2};
            pg8::gemm_phase<pg8::Epi<2, true>, pg8::StaticOrder, true, true>(lds, g, S, E); }
        if (l + 1 < DEPTH) SEAM(pb + 6);
    }
    if (RUN(NPHASE - 1)) { if (RUN(NPHASE - 2)) xcd_barrier(bar); p_ln<true>(Y2, nullptr, P.out, P.ln_ffn_g + (DEPTH - 1) * DM, P.ln_ffn_b + (DEPTH - 1) * DM, (const float*)ST2); }
#undef RUN
#undef SEAM
}

extern "C" void kernel_launch(void* const* d_in, const int* in_sizes, int n_in, void* d_out, int out_size, void* d_ws, size_t ws_size, hipStream_t stream) {
    static int grid = 0;
    if (grid == 0) {
        if (n_in != 10 || in_sizes[0] != M_TOK * DM || out_size != M_TOK * DM || ws_size < WS_END) { fprintf(stderr, "kernel_launch: unexpected shapes / workspace (%d inputs, x %d, out %d, ws %zu < %zu)\n", n_in, n_in > 0 ? in_sizes[0] : -1, out_size, ws_size, (size_t)WS_END); grid = -1; return; }
        int dev = 0, cus = 0, per_cu = 0;
        (void)hipGetDevice(&dev); (void)hipDeviceGetAttribute(&cus, hipDeviceAttributeMultiprocessorCount, dev);
        if (hipFuncSetAttribute((const void*)fwd_megakernel, hipFuncAttributeMaxDynamicSharedMemorySize, LDS_BYTES) != hipSuccess) { fprintf(stderr, "kernel_launch: hipFuncSetAttribute failed\n"); grid = -1; return; }
        if (hipOccupancyMaxActiveBlocksPerMultiprocessor(&per_cu, (const void*)fwd_megakernel, NT, LDS_BYTES) != hipSuccess || per_cu < 1) { fprintf(stderr, "kernel_launch: occupancy query says %d blocks per CU\n", per_cu); per_cu = 1; }
        (void)hipGetLastError();
        grid = cus > 0 ? cus : 256;
    }
    if (grid < 0) return;
    Params p{};
    p.x = (const float*)d_in[0]; p.rel_bias = (const float*)d_in[1]; p.w_qkv = (const float*)d_in[2]; p.w_o = (const float*)d_in[3]; p.ln_mix_g = (const float*)d_in[4]; p.ln_mix_b = (const float*)d_in[5];
    p.w_up = (const float*)d_in[6]; p.w_down = (const float*)d_in[7]; p.ln_ffn_g = (const float*)d_in[8]; p.ln_ffn_b = (const float*)d_in[9]; p.out = (float*)d_out; p.ws = (unsigned char*)d_ws;
#if MK_LAUNCHES == 1
    p.ph_lo = 0; p.ph_hi = NPHASE;
    if (hipMemsetAsync((char*)d_ws + WS_BAR, 0, CTL_BYTES, stream) != hipSuccess) { fprintf(stderr, "kernel_launch: hipMemsetAsync of the barrier words failed\n"); return; }
    void* args[] = {&p};
    const hipError_t e = hipLaunchCooperativeKernel((const void*)fwd_megakernel, dim3(grid), dim3(NT), args, LDS_BYTES, stream);
    if (e != hipSuccess) fprintf(stderr, "kernel_launch: cooperative launch failed: %s (grid %d)\n", hipGetErrorString(e), grid);
#else
    for (int ph = 0; ph < NPHASE; ++ph) { if (ph == 2 || ph == 10 || ph == 5 || ph == 8 || ph == 13) continue;
        p.ph_lo = ph; p.ph_hi = ph + 1; hipLaunchKernelGGL(fwd_megakernel, dim3(grid), dim3(NT), LDS_BYTES, stream, p); }
#endif
}
```

```cpp
#include <hip/hip_runtime.h>
#include <hip/hip_cooperative_groups.h>
#include <cstdio>
#include <cstdint>
namespace cg = cooperative_groups;
constexpr unsigned MK_WTAB = 131072u + 20480u;
__device__ __forceinline__ int mk_tid() {
    const unsigned hw = (unsigned)__builtin_amdgcn_s_getreg((5 << 11) | 4) & 63u;
    const int wave = ((const __attribute__((address_space(3))) int*)(uintptr_t)MK_WTAB)[hw];
    int lane; asm volatile("v_mbcnt_lo_u32_b32 %0, -1, 0\n\tv_mbcnt_hi_u32_b32 %0, -1, %0" : "=v"(lane));
    return __builtin_amdgcn_readfirstlane(wave) * 64 + lane;
}
namespace pg8 {
#define PG8_LAS __attribute__((address_space(3)))
typedef _Float16 bf16_t;
typedef _Float16 bf16x8 __attribute__((ext_vector_type(8)));
typedef float f32x4 __attribute__((ext_vector_type(4)));
typedef unsigned u32x4 __attribute__((ext_vector_type(4)));
constexpr int BM = 256, BK = 64, HALF = 128, HTB = HALF * BK * 2  , STAGE_BYTES = 8 * HTB, NXCD = 8, WGM = 8;

__host__ __device__ __forceinline__ int lds_byte(int r, int c) { const int st = (r >> 4) * 2 + (c >> 5), rr = r & 15, cc = c & 31, ob = rr * 64 + cc * 2; return st * 1024 + (ob ^ (((ob >> 9) & 1) << 5)); }
__host__ __device__ __forceinline__ void stage_rc(int b, int& R, int& C) { const int st = b / 1024, sb = b % 1024, swz = sb ^ (((sb >> 9) & 1) << 5); R = (st >> 1) * 16 + swz / 64; C = (st & 1) * 32 + (swz % 64) / 2; }
__host__ __device__ __forceinline__ int perm32(int rho) { const int n = rho >> 4, i = rho & 15; return 8 * (i >> 2) + 4 * n + (i & 3); }

struct Unit { int pm, pn; };
struct Gemm { const bf16_t* A; const bf16_t* Bt; int M, N, K; };

struct StaticOrder {
    int nM, nN, nwg, G, c;
    __host__ __device__ void init(int M, int N, int G_, int c_) { nM = M / BM; nN = N / BM; nwg = nM * nN; G = G_; c = c_; }
    __host__ __device__ bool next(int i, Unit& u) const {
        const long L = (long)i * G + c; if (L >= nwg) return false;
        int wgid = (int)L; { const int q = nwg / NXCD, r = nwg % NXCD, xcd = wgid % NXCD, off = wgid / NXCD; wgid = (xcd < r ? xcd * (q + 1) : r * (q + 1) + (xcd - r) * q) + off; }
        const int nig = WGM * nN, gid = wgid / nig, fm = gid * WGM, gsz = (nM - fm) < WGM ? (nM - fm) : WGM;
        u.pm = fm + ((wgid % nig) % gsz); u.pn = (wgid % nig) / gsz; return true;
    }
    __device__ __forceinline__ void a_ready(const Unit&) const {}
    __device__ __forceinline__ void done(const Unit&) const {}
};


typedef _Float16 h16x2_t __attribute__((ext_vector_type(2)));
__device__ __forceinline__ unsigned pk2h(float lo, float hi) { h16x2_t v = {(_Float16)lo, (_Float16)hi}; return __builtin_bit_cast(unsigned, v); }
typedef float f32x2_t __attribute__((ext_vector_type(2)));
template <int MODE, bool FOLD> struct Epi {
    static constexpr bool PERM = true, AFTER_DRAIN = false;
    bf16_t* O; int ldc; int split_cols; size_t split_stride; float scale0; const bf16_t* R; float alpha;
    const PG8_LAS unsigned char* tb; f32x2_t* part;
    __device__ __forceinline__ void operator()(const f32x4 (&acc)[2][2][4][2], const Unit& u, int ui, int wr, int wc, int fr, int fq) const {
        const int row0 = u.pm * BM + wr * 64 + fr; int colt = u.pn * BM; bf16_t* base = O;
        float sc = 1.f; bool hm = false;
        if (MODE == 0 && split_cols) { const int t = colt / split_cols; base += (size_t)t * split_stride; colt -= t * split_cols; if (t == 0) sc = scale0; else hm = true; }
        const int col0 = colt + wc * 32 + 8 * fq;
        f32x4 cv[2][2], bv[2][2]; int pslot = 0;
        if (FOLD) { const PG8_LAS int* sl = (const PG8_LAS int*)(tb + 16384); pslot = sl[ui] * 256; const int cslot = sl[16 + ui] * 256 + wc * 32 + 8 * fq;
            const PG8_LAS float* csl = (const PG8_LAS float*)(tb + 8192); const PG8_LAS float* bwl = (const PG8_LAS float*)(tb + 12288);
#pragma unroll
            for (int bj = 0; bj < 2; ++bj)
#pragma unroll
                for (int n = 0; n < 2; ++n) { cv[bj][n] = *(const PG8_LAS f32x4*)(csl + cslot + bj * HALF + 4 * n); bv[bj][n] = *(const PG8_LAS f32x4*)(bwl + cslot + bj * HALF + 4 * n); } }
#pragma unroll
        for (int ai = 0; ai < 2; ++ai) {
        bf16x8 rr[4][2];
        if (MODE == 2) {
#pragma unroll
            for (int m = 0; m < 4; ++m)
#pragma unroll
                for (int bj = 0; bj < 2; ++bj) rr[m][bj] = *(const bf16x8*)(R + (size_t)(row0 + ai * HALF + m * 16) * ldc + col0 + bj * HALF);
            __builtin_amdgcn_sched_barrier(0); }
#pragma unroll
            for (int m = 0; m < 4; ++m) { const int row = row0 + ai * HALF + m * 16; const size_t off = (size_t)row * ldc + col0;
                float mu = 0.f, rs = 1.f; if (FOLD) { const f32x2_t ms = ((const PG8_LAS f32x2_t*)tb)[pslot + ai * HALF + wr * 64 + m * 16 + fr]; mu = ms.x; rs = ms.y; }
                float ssum = 0.f, ssq = 0.f;
#pragma unroll
                for (int bj = 0; bj < 2; ++bj) { f32x4 v0 = acc[ai][bj][m][0], v1 = acc[ai][bj][m][1];
                    if (FOLD && MODE != 2) { v0 = (v0 - mu * cv[bj][0]) * rs + bv[bj][0]; v1 = (v1 - mu * cv[bj][1]) * rs + bv[bj][1]; }
                    if (MODE == 0) { v0 = v0 * sc; v1 = v1 * sc; }
                    if (MODE == 1) { v0 = __builtin_elementwise_max(v0, (f32x4){0.f, 0.f, 0.f, 0.f}); v1 = __builtin_elementwise_max(v1, (f32x4){0.f, 0.f, 0.f, 0.f}); v0 = v0 * v0; v1 = v1 * v1; }
                    if (MODE == 2) { const bf16x8 r = rr[m][bj];
                        f32x4 h0 = (f32x4){(float)r[0], (float)r[1], (float)r[2], (float)r[3]}, h1 = (f32x4){(float)r[4], (float)r[5], (float)r[6], (float)r[7]};
                        if (FOLD) { h0 = (h0 - mu) * rs * cv[bj][0] + bv[bj][0]; h1 = (h1 - mu) * rs * cv[bj][1] + bv[bj][1]; }
                        v0 = v0 + alpha * h0; v1 = v1 + alpha * h1;
                        ssum += (v0[0] + v0[1]) + (v0[2] + v0[3]) + (v1[0] + v1[1]) + (v1[2] + v1[3]);
                        ssq += (v0[0] * v0[0] + v0[1] * v0[1]) + (v0[2] * v0[2] + v0[3] * v0[3]) + (v1[0] * v1[0] + v1[1] * v1[1]) + (v1[2] * v1[2] + v1[3] * v1[3]); }
                    u32x4 w; w.x = pk2h(v0[0], v0[1]); w.y = pk2h(v0[2], v0[3]); w.z = pk2h(v1[0], v1[1]); w.w = pk2h(v1[2], v1[3]);
                    if (MODE == 0 && hm) { const int cc = col0 + bj * HALF; *(u32x4*)(base + ((size_t)(row >> 11) * 16 + (cc >> 6)) * 131072 + (size_t)(row & 2047) * 64 + (cc & 63)) = w; }
                    else *(u32x4*)(base + off + bj * HALF) = w; }
                if (MODE == 2) { ssum += __shfl_xor(ssum, 16); ssq += __shfl_xor(ssq, 16); ssum += __shfl_xor(ssum, 32); ssq += __shfl_xor(ssq, 32);
                    if (fq == 0) part[(size_t)(row0 + ai * HALF + m * 16) * 16 + u.pn * 4 + wc] = (f32x2_t){ssum, ssq}; } }
        }
    }
};

template <class Epi, class Sched, bool ALIGN_EPI = false, bool SP2 = false>
__device__ __forceinline__ void gemm_phase(PG8_LAS unsigned char* lds, const Gemm g, const Sched& S, const Epi& E) {
    int tid_ = mk_tid(); asm volatile("" : "+v"(tid_));
    const int tid = tid_, wid = __builtin_amdgcn_readfirstlane(tid >> 6), lane = tid & 63, wr = wid >> 2, wc = wid & 3, fr = lane & 15, fq = lane >> 4;
    const int K = g.K, nt = K / BK;
    unsigned voffA[2], voffB[2];
#pragma unroll
    for (int i = 0; i < 2; ++i) { int R, C; stage_rc(tid * 16 + i * 8192, R, C); const int Rb = Epi::PERM ? ((R & ~31) + perm32(R & 31)) : R;
        voffA[i] = (unsigned)(R * K + C) * 2u; voffB[i] = (unsigned)(Rb * K + C) * 2u; }
    const size_t kstep = (size_t)(BK * 2);
    const size_t hstep = (size_t)HALF * K * 2;
    const size_t tstep = 2 * hstep;
    const unsigned ldsw = (unsigned)wid * 1024u;
    const int aoff = lds_byte(wr * 64 + fr, fq * 8), boff = lds_byte(wc * 32 + fr, fq * 8);
#define PG8_SA(b, h) (((b) * 2 + (h)) * HTB)
#define PG8_SB(b, h) ((4 + (b) * 2 + (h)) * HTB)
#define PG8_STAGE(bufoff, gbase, voff) do { _Pragma("unroll") for (int _i = 0; _i < 2; ++_i) \
        __builtin_amdgcn_global_load_lds((const unsigned*)((const char*)(gbase) + (voff)[_i]), (PG8_LAS unsigned*)(lds + (bufoff) + ldsw + _i * 8192), 16, 0, 0); } while (0)
#define PG8_LDA(dst, b, h) do { _Pragma("unroll") for (int m = 0; m < 4; ++m) _Pragma("unroll") for (int k = 0; k < 2; ++k) dst[m][k] = *(const PG8_LAS bf16x8*)(lds + PG8_SA(b, h) + aoff + m * 2048 + k * 1024); } while (0)
#define PG8_LDB(dst, b, h) do { _Pragma("unroll") for (int n = 0; n < 2; ++n) _Pragma("unroll") for (int k = 0; k < 2; ++k) dst[n][k] = *(const PG8_LAS bf16x8*)(lds + PG8_SB(b, h) + boff + n * 2048 + k * 1024); } while (0)
#define PG8_MMA(ai, bj, At, Bt) do { __builtin_amdgcn_s_setprio(1); _Pragma("unroll") for (int m = 0; m < 4; ++m) _Pragma("unroll") for (int n = 0; n < 2; ++n) _Pragma("unroll") for (int k = 0; k < 2; ++k) \
        acc[ai][bj][m][n] = __builtin_amdgcn_mfma_f32_16x16x32_f16(Bt[n][k], At[m][k], acc[ai][bj][m][n], 0, 0, 0); __builtin_amdgcn_s_setprio(0); } while (0)
#define PG8_WAIT_V(n) asm volatile("s_waitcnt vmcnt(" #n ")" ::: "memory")
#define PG8_WAIT_L(n) asm volatile("s_waitcnt lgkmcnt(" #n ")" ::: "memory")
#define PG8_BAR __builtin_amdgcn_s_barrier()
#define PG8_SCHED __builtin_amdgcn_sched_barrier(0)
    Unit cur, nxt; int ui = 0;
    if (!S.next(0, cur)) return;
    f32x4 acc[2][2][4][2];
#pragma unroll
    for (int a = 0; a < 2; ++a)
#pragma unroll
        for (int b = 0; b < 2; ++b)
#pragma unroll
            for (int m = 0; m < 4; ++m)
#pragma unroll
                for (int n = 0; n < 2; ++n) acc[a][b][m][n] = (f32x4){0.f, 0.f, 0.f, 0.f};
    bf16x8 At[4][2], B0[2][2], B1[2][2];
    const char* cA = (const char*)g.A + (size_t)cur.pm * tstep; const char* cB = (const char*)g.Bt + (size_t)cur.pn * tstep;
    S.a_ready(cur);
    if constexpr (SP2) {
        PG8_STAGE(PG8_SB(0, 0), cB, voffB); PG8_STAGE(PG8_SB(0, 1), cB + hstep, voffB); PG8_STAGE(PG8_SA(0, 0), cA, voffA); PG8_STAGE(PG8_SA(0, 1), cA + hstep, voffA);
        if (wr == 1) PG8_BAR;
        PG8_WAIT_V(2); PG8_BAR;
        PG8_STAGE(PG8_SB(1, 0), cB + kstep, voffB); PG8_STAGE(PG8_SA(1, 0), cA + kstep, voffA); PG8_STAGE(PG8_SB(1, 1), cB + hstep + kstep, voffB);
        PG8_WAIT_V(6); PG8_BAR;
    } else {
        PG8_STAGE(PG8_SB(0, 0), cB, voffB); PG8_STAGE(PG8_SA(0, 0), cA, voffA); PG8_STAGE(PG8_SB(0, 1), cB + hstep, voffB); PG8_STAGE(PG8_SA(0, 1), cA + hstep, voffA);
        if (wr == 1) PG8_BAR;
        PG8_WAIT_V(4); PG8_BAR;
        PG8_STAGE(PG8_SB(1, 0), cB + kstep, voffB); PG8_STAGE(PG8_SA(1, 0), cA + kstep, voffA); PG8_STAGE(PG8_SB(1, 1), cB + hstep + kstep, voffB);
        PG8_WAIT_V(6); PG8_BAR;
    }
    for (;;) {
        const bool has_next = S.next(ui + 1, nxt);
        const char* nA = has_next ? (const char*)g.A + (size_t)nxt.pm * tstep : cA; const char* nB = has_next ? (const char*)g.Bt + (size_t)nxt.pn * tstep : cB;
        for (int t = 0; t < nt; t += 2) {
            const bool last = (t == nt - 2);
            const char* a1 = cA + (size_t)(t + 1) * kstep;
            const char* a2 = last ? nA : cA + (size_t)(t + 2) * kstep; const char* b2 = last ? nB : cB + (size_t)(t + 2) * kstep;
            const char* a3 = a2 + kstep; const char* b3 = b2 + kstep;
            if (last && has_next) S.a_ready(nxt);
            if constexpr (SP2) {
            PG8_LDB(B0, 0, 0); PG8_LDB(B1, 0, 1); PG8_SCHED; PG8_LDA(At, 0, 0); PG8_STAGE(PG8_SA(1, 1), a1 + hstep, voffA);
            PG8_WAIT_V(8); PG8_WAIT_L(0); PG8_BAR; PG8_MMA(0, 0, At, B0); PG8_MMA(0, 1, At, B1); PG8_BAR; PG8_SCHED;
            PG8_LDA(At, 0, 1); PG8_STAGE(PG8_SB(0, 0), b2, voffB); PG8_STAGE(PG8_SB(0, 1), b2 + hstep, voffB); PG8_STAGE(PG8_SA(0, 0), a2, voffA);
            PG8_WAIT_V(8); PG8_WAIT_L(0); PG8_BAR; PG8_MMA(1, 0, At, B0); PG8_MMA(1, 1, At, B1); PG8_BAR; PG8_SCHED;
            PG8_LDB(B0, 1, 0); PG8_LDB(B1, 1, 1); PG8_SCHED; PG8_LDA(At, 1, 0); PG8_STAGE(PG8_SA(0, 1), a2 + hstep, voffA);
            PG8_WAIT_V(8); PG8_WAIT_L(0); PG8_BAR; PG8_MMA(0, 0, At, B0); PG8_MMA(0, 1, At, B1); PG8_BAR; PG8_SCHED;
            PG8_LDA(At, 1, 1); PG8_STAGE(PG8_SB(1, 0), b3, voffB); PG8_STAGE(PG8_SB(1, 1), b3 + hstep, voffB); PG8_STAGE(PG8_SA(1, 0), a3, voffA);
            PG8_WAIT_V(8); PG8_WAIT_L(0); PG8_BAR; PG8_MMA(1, 0, At, B0); PG8_MMA(1, 1, At, B1); PG8_BAR; PG8_SCHED;
            } else {
            PG8_LDB(B0, 0, 0); PG8_SCHED; PG8_LDA(At, 0, 0); PG8_STAGE(PG8_SA(1, 1), a1 + hstep, voffA);
            PG8_WAIT_L(8); PG8_BAR; PG8_WAIT_L(0); PG8_MMA(0, 0, At, B0); PG8_BAR; PG8_SCHED;
            PG8_LDB(B1, 0, 1); PG8_STAGE(PG8_SB(0, 0), b2, voffB);
            PG8_BAR; PG8_WAIT_L(0); PG8_MMA(0, 1, At, B1); PG8_BAR;
            PG8_LDA(At, 0, 1); PG8_STAGE(PG8_SA(0, 0), a2, voffA);
            PG8_BAR; PG8_WAIT_L(0); PG8_MMA(1, 0, At, B0); PG8_BAR; PG8_SCHED;
            PG8_STAGE(PG8_SB(0, 1), b2 + hstep, voffB);
            PG8_WAIT_V(6); PG8_BAR; PG8_MMA(1, 1, At, B1); PG8_BAR;
            PG8_LDB(B0, 1, 0); PG8_SCHED; PG8_LDA(At, 1, 0); PG8_STAGE(PG8_SA(0, 1), a2 + hstep, voffA);
            PG8_WAIT_L(8); PG8_BAR; PG8_WAIT_L(0); PG8_MMA(0, 0, At, B0); PG8_BAR; PG8_SCHED;
            PG8_LDB(B1, 1, 1); PG8_STAGE(PG8_SB(1, 0), b3, voffB);
            PG8_BAR; PG8_WAIT_L(0); PG8_MMA(0, 1, At, B1); PG8_BAR;
            PG8_LDA(At, 1, 1); PG8_STAGE(PG8_SA(1, 0), a3, voffA);
            PG8_BAR; PG8_WAIT_L(0); PG8_MMA(1, 0, At, B0); PG8_BAR; PG8_SCHED;
            PG8_STAGE(PG8_SB(1, 1), b3 + hstep, voffB);
            PG8_WAIT_V(6); PG8_BAR; PG8_MMA(1, 1, At, B1); PG8_BAR;
            }
        }
        if constexpr (ALIGN_EPI) { if (wr == 0) PG8_BAR; }
        if constexpr (!Epi::AFTER_DRAIN) { E(acc, cur, ui, wr, wc, fr, fq); S.done(cur); }
        if (!has_next) break;
#pragma unroll
        for (int a = 0; a < 2; ++a)
#pragma unroll
            for (int b = 0; b < 2; ++b)
#pragma unroll
                for (int m = 0; m < 4; ++m)
#pragma unroll
                    for (int n = 0; n < 2; ++n) acc[a][b][m][n] = (f32x4){0.f, 0.f, 0.f, 0.f};
        cur = nxt; cA = nA; cB = nB; ++ui;
        if constexpr (ALIGN_EPI) { if (wr == 1) PG8_BAR; }
    }
    PG8_WAIT_V(0);
    if constexpr (!ALIGN_EPI) { if (wr == 0) PG8_BAR; }
    PG8_BAR;
    if constexpr (Epi::AFTER_DRAIN) { E.fused(acc, cur, wr, wc, fr, fq, lds, wid, lane); S.done(cur); }
#undef PG8_SA
#undef PG8_SB
#undef PG8_STAGE
#undef PG8_LDA
#undef PG8_LDB
#undef PG8_MMA
#undef PG8_WAIT_V
#undef PG8_WAIT_L
#undef PG8_BAR
#undef PG8_SCHED
}
}

#define LAS __attribute__((address_space(3)))
typedef _Float16 h16;
typedef _Float16 h16x8 __attribute__((ext_vector_type(8)));
typedef _Float16 h16x4 __attribute__((ext_vector_type(4)));
typedef _Float16 h16x2 __attribute__((ext_vector_type(2)));
typedef __fp16 fp16x4v __attribute__((__vector_size__(4 * sizeof(__fp16))));
typedef float f32x4 __attribute__((ext_vector_type(4)));
typedef float f32x16 __attribute__((ext_vector_type(16)));
typedef unsigned u32x4 __attribute__((ext_vector_type(4)));
typedef unsigned u32x2 __attribute__((ext_vector_type(2)));

#ifndef REP_MOBA
#define REP_MOBA 1
#endif
#ifndef REP_PRO
#define REP_PRO 1
#endif
#ifndef REP_QKV
#define REP_QKV 1
#endif
#ifndef REP_WO
#define REP_WO 1
#endif
#ifndef REP_UP
#define REP_UP 1
#endif
#ifndef REP_DN
#define REP_DN 1
#endif
#ifndef REP_LN
#define REP_LN 1
#endif
#ifndef REP_SB
#define REP_SB 1
#endif
#ifndef MK_LAUNCHES
#define MK_LAUNCHES 1
#endif
constexpr int NT = 512, M_TOK = 65536, DM = 1024, SEQ = 2048, NH = 16, DH = 64, FF = 4096, NBLK = 8, DEPTH = 2, NPHASE = 17;
constexpr int ST_OFF = pg8::STAGE_BYTES, LDS_BYTES = pg8::STAGE_BYTES + 16 * 256 * 8;
constexpr float LN_EPS = 1e-5f, ALPHA = 1.41421356237309515f  , LOG2E = 1.44269504088896341f, QSCALE = 0.125f * LOG2E;
constexpr float NEG_INF = -__builtin_inff();
constexpr size_t ACT_B = (size_t)M_TOK * DM * 2;
constexpr size_t W_QKV_B = (size_t)3 * DM * DM * 2, W_O_B = (size_t)DM * DM * 2, W_UP_B = (size_t)FF * DM * 2, W_DN_B = (size_t)FF * DM * 2, W_LAYER_B = W_QKV_B + W_O_B + W_UP_B + W_DN_B;
constexpr int NCS = 4096 + 4096 + 3072;
constexpr size_t WS_BAR = 0  , WS_BARST = 16384  , CTL_BYTES = 16384 + 8192  ,
                 WS_W = 32768, WS_CS = WS_W + DEPTH * W_LAYER_B  , WS_CSP = WS_CS + 131072  , WS_ST1 = WS_CSP + (size_t)2 * 1048576,
                 WS_ST2 = WS_ST1 + (size_t)M_TOK * 128  , WS_X16 = WS_ST2 + (size_t)M_TOK * 128, WS_YA = WS_X16 + ACT_B, WS_YB = WS_YA + ACT_B, WS_KM = WS_YB + ACT_B,
                 WS_Q = WS_KM + (size_t)4096 * 64 * 4, WS_K = WS_Q + ACT_B, WS_V = WS_K + ACT_B, WS_O = WS_V + ACT_B,
                 WS_U = WS_Q  , WS_END = WS_Q + 4 * ACT_B;

struct Params { const float *x, *rel_bias, *w_qkv, *w_o, *ln_mix_g, *ln_mix_b, *w_up, *w_down, *ln_ffn_g, *ln_ffn_b; float* out; unsigned char* ws; int ph_lo, ph_hi; };

__device__ __forceinline__ unsigned pk2h(float lo, float hi) { h16x2 v = {(h16)lo, (h16)hi}; return __builtin_bit_cast(unsigned, v); }
__device__ __forceinline__ float ex2(float x) { return __builtin_amdgcn_exp2f(x); }
__device__ __forceinline__ float lg2(float x) { return __builtin_amdgcn_logf(x); }
__device__ __forceinline__ int crow(int i, int hh) { return (i & 3) + 8 * (i >> 2) + 4 * hh; }
#define MFMA32(a, b, c) __builtin_amdgcn_mfma_f32_32x32x16_f16((a), (b), (c), 0, 0, 0)
__device__ __forceinline__ h16x8 pack8(const f32x16& x, const int s) {
    h16x8 r; r[0] = (h16)x[8 * s + 0]; r[1] = (h16)x[8 * s + 1]; r[2] = (h16)x[8 * s + 2]; r[3] = (h16)x[8 * s + 3]; r[4] = (h16)x[8 * s + 4]; r[5] = (h16)x[8 * s + 5]; r[6] = (h16)x[8 * s + 6]; r[7] = (h16)x[8 * s + 7]; return r; }
__device__ __forceinline__ h16x8 tr8(const LAS unsigned char* p_lo, const LAS unsigned char* p_hi) {
    const h16x4 lo = __builtin_bit_cast(h16x4, __builtin_amdgcn_ds_read_tr16_b64_v4f16((LAS fp16x4v*)p_lo));
    const h16x4 hi = __builtin_bit_cast(h16x4, __builtin_amdgcn_ds_read_tr16_b64_v4f16((LAS fp16x4v*)p_hi));
    return __builtin_shufflevector(lo, hi, 0, 1, 2, 3, 4, 5, 6, 7); }

#define XB_TMO      128
#define XB_XCNT(j)  (256  + 64 * (j))
#define XB_XSUB(j)  (1280 + 64 * (j))
#define XB_XGEN(j)  (2304 + 64 * (j))
#define XB_TOP      3328
#define XB_TOPGEN   3392
#define XCD_BAR_WORDS 3456
#define XB_SPIN_CAP (1u << 18)

__device__ __forceinline__ unsigned xb_ld(unsigned* p)              { return __hip_atomic_load(p, __ATOMIC_RELAXED, __HIP_MEMORY_SCOPE_AGENT); }
__device__ __forceinline__ unsigned xb_add(unsigned* p, unsigned v) { return __hip_atomic_fetch_add(p, v, __ATOMIC_RELAXED, __HIP_MEMORY_SCOPE_AGENT); }
__device__ __forceinline__ unsigned xb_xcc_id() { return (unsigned)__builtin_amdgcn_s_getreg((3 << 11) | 20) & 0xFu; }
#define XB_SPIN(cond, bar) do { unsigned _sp = 0; while (cond) { __builtin_amdgcn_s_sleep(1); \
    if ((++_sp & 255u) == 0u) { if (xb_ld(&(bar)[XB_TMO])) break; if (_sp > XB_SPIN_CAP) { atomicAdd(&(bar)[XB_TMO], 1u); break; } } } } while (0)

struct XcdBarrier {
    unsigned* bar; unsigned x;
    volatile unsigned* st;
};

__device__ __forceinline__ XcdBarrier xcd_barrier_post(unsigned* bar, volatile unsigned* st) {
    XcdBarrier b; b.bar = bar; b.x = xb_xcc_id(); b.st = st;
    if (mk_tid() == 0) (void)xb_add(&bar[XB_XCNT(b.x)], 1u);
    return b;
}
__device__ __forceinline__ void xcd_barrier_complete(unsigned* bar, unsigned x, unsigned& nloc, unsigned& nx) {
    const unsigned G = gridDim.x * gridDim.y * gridDim.z;
    unsigned sum, cnt, mine, sp = 0u;
    for (;;) {
        sum = 0u; cnt = 0u; mine = 0u;
#pragma unroll
        for (unsigned j = 0; j < 16; ++j) { const unsigned c = xb_ld(&bar[XB_XCNT(j)]); sum += c; cnt += (c > 0u) ? 1u : 0u; mine = (j == x) ? c : mine; }
        if (sum == G) break;
        __builtin_amdgcn_s_sleep(1);
        if ((++sp & 255u) == 0u) { if (xb_ld(&bar[XB_TMO])) break; if (sp > XB_SPIN_CAP) { atomicAdd(&bar[XB_TMO], 1u); break; } }
    }
    nloc = mine > 0u ? mine : 1u; nx = cnt > 0u ? cnt : 1u;
}

__device__ __forceinline__ void xcd_barrier(const XcdBarrier& b) {
    asm volatile("s_waitcnt vmcnt(0)" ::: "memory");
    __syncthreads();
    if (mk_tid() == 0) {
        unsigned* bar = b.bar;
        __builtin_amdgcn_s_waitcnt(0);
        unsigned nloc = b.st[0], nx = b.st[1];
        if (nloc == 0u) { xcd_barrier_complete(bar, b.x, nloc, nx); b.st[0] = nloc; b.st[1] = nx; }
        const unsigned old = xb_add(&bar[XB_XSUB(b.x)], 1u);
        const unsigned gen = old / nloc;
        if (old + 1u == (gen + 1u) * nloc) {
            __builtin_amdgcn_fence(__ATOMIC_RELEASE, "agent");
            asm volatile("s_waitcnt vmcnt(0)" ::: "memory");
            const unsigned og = xb_add(&bar[XB_TOP], 1u);
            const unsigned tg = og / nx;
            if (og + 1u == (tg + 1u) * nx) xb_add(&bar[XB_TOPGEN], 1u);
            else XB_SPIN(xb_ld(&bar[XB_TOPGEN]) == tg, bar);
            __builtin_amdgcn_fence(__ATOMIC_ACQUIRE, "agent");
            xb_add(&bar[XB_XGEN(b.x)], 1u);
            asm volatile("s_waitcnt vmcnt(0)" ::: "memory");
        } else {
            XB_SPIN(xb_ld(&bar[XB_XGEN(b.x)]) == gen, bar);
            __builtin_amdgcn_fence(__ATOMIC_ACQUIRE, "agent");
            asm volatile("s_waitcnt vmcnt(0)" ::: "memory");
        }
    }
    __syncthreads();
}

__device__ __forceinline__ void p_prologue(const Params& P, LAS unsigned char* lds) {
    int tid_ = mk_tid(); asm volatile("" : "+v"(tid_)); const int tid = tid_, G = gridDim.x, c = blockIdx.x;
    { h16* Hh = (h16*)(P.ws + WS_X16); const size_t nvec = (size_t)M_TOK * DM / 8;
      for (size_t v = (size_t)c * NT + tid; v < nvec; v += (size_t)G * NT) {
          const f32x4 a = __builtin_nontemporal_load((const f32x4*)P.x + 2 * v), b = __builtin_nontemporal_load((const f32x4*)P.x + 2 * v + 1);
          u32x4 w; w.x = pk2h(a[0], a[1]); w.y = pk2h(a[2], a[3]); w.z = pk2h(b[0], b[1]); w.w = pk2h(b[2], b[3]); ((u32x4*)Hh)[v] = w; } }
    LAS float* tile = (LAS float*)lds;
    float* csp = (float*)(P.ws + WS_CSP);
    for (int t = c; t < DEPTH * 3072; t += G) {
        const int l = t / 3072, r = t % 3072; const float* src; h16* dst; int K, N, tl; unsigned char* wl = P.ws + WS_W + (size_t)l * W_LAYER_B;
        const float* gv = nullptr; const float* bv = nullptr; int csoff = 0;
        if (r < 768)       { src = P.w_qkv  + (size_t)l * DM * 3 * DM; dst = (h16*)wl;                               K = DM; N = 3 * DM; tl = r; if (l > 0) { gv = P.ln_ffn_g + (l - 1) * DM; bv = P.ln_ffn_b + (l - 1) * DM; csoff = 8192; } }
        else if (r < 1024) { src = P.w_o    + (size_t)l * DM * DM;     dst = (h16*)(wl + W_QKV_B);                   K = DM; N = DM;     tl = r - 768; }
        else if (r < 2048) { src = P.w_up   + (size_t)l * DM * FF;     dst = (h16*)(wl + W_QKV_B + W_O_B);           K = DM; N = FF;     tl = r - 1024; gv = P.ln_mix_g + l * DM; bv = P.ln_mix_b + l * DM; csoff = l * 4096; }
        else               { src = P.w_down + (size_t)l * FF * DM;     dst = (h16*)(wl + W_QKV_B + W_O_B + W_UP_B);  K = FF; N = DM;     tl = r - 2048; }
        const int ntn = N / 64, k0 = (tl / ntn) * 64, n0 = (tl % ntn) * 64;
        { const int n = tid & 63, kb = tid >> 6;
#pragma unroll
          for (int i = 0; i < 8; ++i) { const int k = kb + 8 * i; tile[k * 65 + n] = __builtin_nontemporal_load(src + (size_t)(k0 + k) * N + n0 + n); } }
        __syncthreads();
        { const int k2 = (tid & 31) * 2, nb = tid >> 5; const float g0 = gv ? gv[k0 + k2] : 1.f, g1 = gv ? gv[k0 + k2 + 1] : 1.f;
#pragma unroll
          for (int i = 0; i < 4; ++i) { const int n = nb + 16 * i; const h16x2 v = {(h16)(tile[k2 * 65 + n] * g0), (h16)(tile[(k2 + 1) * 65 + n] * g1)}; *(h16x2*)(dst + (size_t)(n0 + n) * K + k0 + k2) = v; } }
        if (gv && tid < 64) { float sa = 0.f, sb = 0.f;
            for (int k = 0; k < 64; ++k) { const float wv = tile[k * 65 + tid]; sa += (float)(h16)(wv * gv[k0 + k]); sb += wv * bv[k0 + k]; }
            csp[(size_t)((k0 >> 6) * 2 + 0) * NCS + csoff + n0 + tid] = sa; csp[(size_t)((k0 >> 6) * 2 + 1) * NCS + csoff + n0 + tid] = sb; }
        __syncthreads();
    }
}

__device__ __forceinline__ void p_cs_finalize(const Params& P) {
    const float* csp = (const float*)(P.ws + WS_CSP); float* cs = (float*)(P.ws + WS_CS);
    int tid_ = mk_tid(); asm volatile("" : "+v"(tid_));
    for (int i = blockIdx.x * 88 + tid_; tid_ < 88 && i < 2 * NCS; i += gridDim.x * 88) {     const int v = i / NCS, cidx = i % NCS; float a = 0.f;
        float pv_[16];
#pragma unroll
        for (int kt = 0; kt < 16; ++kt) pv_[kt] = csp[(size_t)(kt * 2 + v) * NCS + cidx];
#pragma unroll
        for (int kt = 0; kt < 16; ++kt) a += pv_[kt];
        cs[i] = a; }
}

template <class Sched> __device__ __forceinline__ void p_fill_tables(LAS unsigned char* lds, const float* part, const Sched& S, const float* cvec, const float* bvec) {
    int tid_ = mk_tid(); asm volatile("" : "+v"(tid_)); const int tid = tid_;
    LAS unsigned char* tb = lds + ST_OFF; LAS pg8::f32x2_t* st = (LAS pg8::f32x2_t*)tb; LAS float* csl = (LAS float*)(tb + 8192); LAS float* bwl = (LAS float*)(tb + 12288); LAS int* sl = (LAS int*)(tb + 16384);
    if (tid < 16) { pg8::Unit u; const bool ok = S.next(tid, u); sl[48 + tid] = ok ? u.pm : -1; sl[64 + tid] = ok ? u.pn : -1; }
    __syncthreads();
    int fpm = 0, fpn = 0;
    if (tid < 16) { const int pm = sl[48 + tid], pn = sl[64 + tid]; fpm = tid; fpn = tid;
        for (int j = tid - 1; j >= 0; --j) { if (sl[48 + j] == pm) fpm = j; if (sl[64 + j] == pn) fpn = j; }
        sl[80 + tid] = (fpm == tid && pm >= 0) ? 1 : 0; sl[96 + tid] = (fpn == tid && pn >= 0) ? 1 : 0; }
    __syncthreads();
    if (tid < 16) { int ps = 0, cs_ = 0;
        for (int j = 0; j < fpm; ++j) ps += sl[80 + j];
        for (int j = 0; j < fpn; ++j) cs_ += sl[96 + j];
        ps = ps < 3 ? ps : 3; cs_ = cs_ < 3 ? cs_ : 3;
        sl[tid] = ps; sl[16 + tid] = cs_;
        if (fpm == tid && sl[48 + tid] >= 0) sl[32 + ps] = sl[48 + tid];
        if (fpn == tid && sl[64 + tid] >= 0) sl[36 + cs_] = sl[64 + tid];
        if (tid == 0) { int a = 0, b = 0; for (int j = 0; j < 16; ++j) { a += sl[80 + j]; b += sl[96 + j]; } sl[40] = a < 4 ? a : 4; sl[41] = b < 4 ? b : 4; } }
    __syncthreads();
    const int npm = sl[40], npn = sl[41];
    f32x4 pr[2][8]; float cvl[4];
#pragma unroll
    for (int jj = 0; jj < 2; ++jj) { const int j = (tid >> 8) + 2 * jj; const int pm = sl[32 + (j < npm ? j : 0)];
        const f32x4* pp = (const f32x4*)(part + (size_t)(pm * 256 + (tid & 255)) * 32);
#pragma unroll
        for (int x = 0; x < 8; ++x) pr[jj][x] = pp[x]; }
#pragma unroll
    for (int j = 0; j < 4; ++j) { const int pn = sl[36 + (j < npn ? j : 0)]; cvl[j] = (tid < 256) ? cvec[pn * 256 + tid] : bvec[pn * 256 + tid - 256]; }
#pragma unroll
    for (int jj = 0; jj < 2; ++jj) { const int j = (tid >> 8) + 2 * jj; if (j < npm) { float sa = 0.f, sq = 0.f;
#pragma unroll
            for (int x = 0; x < 8; ++x) { sa += pr[jj][x][0] + pr[jj][x][2]; sq += pr[jj][x][1] + pr[jj][x][3]; }
            const float mean = sa * (1.0f / 1024.0f), var = sq * (1.0f / 1024.0f) - mean * mean;
            st[j * 256 + (tid & 255)] = (pg8::f32x2_t){mean, 1.0f / sqrtf(var + LN_EPS)}; } }
#pragma unroll
    for (int j = 0; j < 4; ++j) if (j < npn) { if (tid < 256) csl[j * 256 + tid] = cvl[j]; else bwl[j * 256 + tid - 256] = cvl[j]; }
    __syncthreads();
}

__device__ __forceinline__ void p_kmean(const Params& P) {
    const h16* Kb = (const h16*)(P.ws + WS_K); float* KM = (float*)(P.ws + WS_KM);
    int tid_ = mk_tid(); asm volatile("" : "+v"(tid_)); const int lane = tid_ & 63, w = tid_ >> 6, sub = lane & 7, rr = lane >> 3;
    for (int it = blockIdx.x * 8 + w; it < 4096; it += gridDim.x * 8) {
        const int bh = it >> 3, n = it & 7, b = bh >> 4, h = bh & 15;
        const h16* p = Kb + ((size_t)bh * SEQ + n * 256 + rr) * DH + sub * 8;
        float a[8];
#pragma unroll
        for (int e = 0; e < 8; ++e) a[e] = 0.f;
#pragma unroll 8
        for (int i = 0; i < 32; ++i) { const h16x8 v = *(const h16x8*)(p + (size_t)i * 8 * DH);
#pragma unroll
            for (int e = 0; e < 8; ++e) a[e] += (float)v[e]; }
#pragma unroll
        for (int e = 0; e < 8; ++e) { a[e] += __shfl_xor(a[e], 8); a[e] += __shfl_xor(a[e], 16); a[e] += __shfl_xor(a[e], 32); a[e] *= (1.0f / 256.0f); }
        if (rr == 0) { float* o = KM + (size_t)it * 64 + sub * 8; *(f32x4*)o = (f32x4){a[0], a[1], a[2], a[3]}; *(f32x4*)(o + 4) = (f32x4){a[4], a[5], a[6], a[7]}; }
    }
}

template <bool FINAL> __device__ __forceinline__ void p_ln(const h16* Y, h16* Ho, float* Fo, const float* g, const float* bt, const float* part) {
    int tid_ = mk_tid(); asm volatile("" : "+v"(tid_)); const int lane = tid_ & 63, w = __builtin_amdgcn_readfirstlane(tid_ >> 6);
    float gg[16], bb[16];
#pragma unroll
    for (int e = 0; e < 8; ++e) { gg[e] = g[8 * lane + e]; gg[8 + e] = g[512 + 8 * lane + e]; bb[e] = bt[8 * lane + e]; bb[8 + e] = bt[512 + 8 * lane + e]; }
    for (int row = blockIdx.x * 8 + w; row < M_TOK; row += gridDim.x * 8) {
        const h16x8 v0 = *(const h16x8*)(Y + (size_t)row * DM + 8 * lane), v1 = *(const h16x8*)(Y + (size_t)row * DM + 512 + 8 * lane);
        const f32x4* pp = (const f32x4*)(part + (size_t)row * 32); float sa = 0.f, sq = 0.f;
#pragma unroll
        for (int k = 0; k < 8; ++k) { const f32x4 v = pp[k]; sa += v[0] + v[2]; sq += v[1] + v[3]; }
        const float mean = sa * (1.0f / 1024.0f), var = sq * (1.0f / 1024.0f) - mean * mean, rstd = 1.0f / sqrtf(var + LN_EPS);
        float x[16];
#pragma unroll
        for (int e = 0; e < 8; ++e) { x[e] = (float)v0[e]; x[8 + e] = (float)v1[e]; }
#pragma unroll
        for (int e = 0; e < 16; ++e) x[e] = (x[e] - mean) * rstd * gg[e] + bb[e];
        if (FINAL) { float* o = Fo + (size_t)row * DM + 8 * lane;
            *(f32x4*)o = (f32x4){x[0], x[1], x[2], x[3]}; *(f32x4*)(o + 4) = (f32x4){x[4], x[5], x[6], x[7]};
            *(f32x4*)(o + 512) = (f32x4){x[8], x[9], x[10], x[11]}; *(f32x4*)(o + 516) = (f32x4){x[12], x[13], x[14], x[15]}; }
        else { h16* o = Ho + (size_t)row * DM + 8 * lane; u32x4 a, b;
            a.x = pk2h(x[0], x[1]); a.y = pk2h(x[2], x[3]); a.z = pk2h(x[4], x[5]); a.w = pk2h(x[6], x[7]);
            b.x = pk2h(x[8], x[9]); b.y = pk2h(x[10], x[11]); b.z = pk2h(x[12], x[13]); b.w = pk2h(x[14], x[15]);
            *(u32x4*)o = a; *(u32x4*)(o + 512) = b; }
    }
}

namespace attn_body {
using bf16=_Float16;
using h16x8v=__attribute__((ext_vector_type(8)))_Float16;
using bf16x8=__attribute__((ext_vector_type(8)))short;
using s16x4=__attribute__((ext_vector_type(4)))short;
using f32x16=__attribute__((ext_vector_type(16)))float;
using u32x4=__attribute__((ext_vector_type(4)))unsigned;
constexpr int BATCH=32,NHEAD=16,SEQ=2048,D=64,DM=NHEAD*D;
constexpr int NW=8,QBLK=32,QB=QBLK*NW,KVBLK=64,NQB=SEQ/QB;
constexpr int ATTN_PITCH=DM, ATTN_UNIT_ROWS=QB;
__device__ __forceinline__ int crow(int r,int hi){return (r&3)+8*(r>>2)+4*hi;}
#define SBAR() __builtin_amdgcn_sched_barrier(0)
#define MF16(a,b,c,x,y,z) __builtin_amdgcn_mfma_f32_32x32x16_f16(__builtin_bit_cast(h16x8v,(a)),__builtin_bit_cast(h16x8v,(b)),(c),0,0,0)
__device__ __forceinline__ void cmask(f32x16&p0,f32x16&p1,int jb,int qrel,int hi){
  const float NEG=-INFINITY; int kb=64*jb+4*hi;
  #pragma unroll
  for(int r=0;r<16;++r){int kv=kb+(r&3)+8*(r>>2); if(kv>qrel)p0[r]=NEG; if(kv+32>qrel)p1[r]=NEG;}
}

constexpr int NSLOT=3, SLOTB=8192;
constexpr int LDS_K=0, LDS_V=NSLOT*SLOTB, LDS_WS=2*NSLOT*SLOTB, LDS_OST=LDS_WS+NW*64*4, LDS_BYTES=LDS_OST+NW*4096;
constexpr int LDS_KM=LDS_BYTES, LDS_BT=LDS_KM+2048, NBT=640, LDS_SEL=LDS_BT+4*NBT*4, LDS_TOTAL=LDS_SEL+NW*2048;
constexpr float C2=0.125f*1.4426950408889634f;
__device__ __forceinline__ void glds16(const void*gsrc,unsigned lds_dst){unsigned keep;
  asm volatile("s_mov_b32 %0, m0\n\ts_mov_b32 m0, %2\n\ts_nop 0\n\tglobal_load_lds_dwordx4 %1, off\n\ts_mov_b32 m0, %0":"=&s"(keep):"v"(gsrc),"s"(lds_dst):"memory");}
__device__ __forceinline__ float max3f(float a,float b,float c){float r;asm("v_max3_f32 %0, %1, %2, %3":"=v"(r):"v"(a),"v"(b),"v"(c));return r;}
__device__ __forceinline__ float max2f(float a,float b){float r;asm("v_max_f32_e32 %0, %1, %2":"=v"(r):"v"(a),"v"(b));return r;}
__device__ __forceinline__ float fadd_s(float a,float b){float r;asm("v_add_f32_e32 %0, %1, %2":"=v"(r):"v"(a),"v"(b));return r;}
__device__ __forceinline__ float fsub_s(float a,float b){float r;asm("v_sub_f32_e32 %0, %1, %2":"=v"(r):"v"(a),"v"(b));return r;}
typedef float f32x2_t __attribute__((ext_vector_type(2))); typedef _Float16 bf16x2_t __attribute__((ext_vector_type(2)));
__device__ __forceinline__ unsigned cvtpk_s(float lo,float hi){f32x2_t v={lo,hi};bf16x2_t b=__builtin_convertvector(v,bf16x2_t);return __builtin_bit_cast(unsigned,b);}
#define WAIT_BAR(N) asm volatile("s_waitcnt vmcnt(" #N ") lgkmcnt(0)\n\ts_barrier":::"memory")

__device__ __forceinline__ void qkt(f32x16&p0,f32x16&p1,const char*Kslot,const bf16x8*qr,const f32x16&negm,int r32,int hi){
  const char*kb=Kslot+hi*1024+r32*16;
  #pragma unroll
  for(int d0=0;d0<4;++d0){
    const bf16x8 b0=*reinterpret_cast<const bf16x8*>(kb+d0*2048);
    const bf16x8 b1=*reinterpret_cast<const bf16x8*>(kb+d0*2048+512);
    if(d0==0){p0=MF16(b0,qr[0],negm,0,0,0);p1=MF16(b1,qr[0],negm,0,0,0);}
    else{p0=MF16(b0,qr[d0],p0,0,0,0);p1=MF16(b1,qr[d0],p1,0,0,0);}}
}
typedef __attribute__((address_space(3))) const char* lds_cptr;
typedef short v4i16_t __attribute__((ext_vector_type(4)));
typedef float f32x4 __attribute__((ext_vector_type(4)));
__device__ __forceinline__ void kload8(bf16x8*kf,lds_cptr kp){
  kf[0]=*(const __attribute__((address_space(3))) bf16x8*)(kp);      kf[1]=*(const __attribute__((address_space(3))) bf16x8*)(kp+512);
  kf[2]=*(const __attribute__((address_space(3))) bf16x8*)(kp+2048); kf[3]=*(const __attribute__((address_space(3))) bf16x8*)(kp+2560);
  kf[4]=*(const __attribute__((address_space(3))) bf16x8*)(kp+4096); kf[5]=*(const __attribute__((address_space(3))) bf16x8*)(kp+4608);
  kf[6]=*(const __attribute__((address_space(3))) bf16x8*)(kp+6144); kf[7]=*(const __attribute__((address_space(3))) bf16x8*)(kp+6656);
}
__device__ __forceinline__ void kload2(bf16x8*kf,lds_cptr kp,int j){ kf[2*j]=*(const __attribute__((address_space(3))) bf16x8*)(kp+j*2048); kf[2*j+1]=*(const __attribute__((address_space(3))) bf16x8*)(kp+j*2048+512); }
__device__ __forceinline__ s16x4 vtr(lds_cptr p){ return __builtin_bit_cast(s16x4,__builtin_amdgcn_ds_read_tr16_b64_v4i16((__attribute__((address_space(3))) v4i16_t*)p)); }
__device__ __forceinline__ float rowmax(const f32x16&p0,const f32x16&p1){
  float a=max3f(p0[0],p0[1],p1[0]),b=max3f(p0[2],p0[3],p1[1]);a=max3f(a,p1[2],p1[3]);
  #pragma unroll
  for(int r=4;r<16;r+=4){a=max3f(a,p0[r],p0[r+1]);b=max3f(b,p0[r+2],p0[r+3]);a=max3f(a,p1[r],p1[r+1]);b=max3f(b,p1[r+2],p1[r+3]);}
  const float m=max2f(a,b);
  auto rr=__builtin_amdgcn_permlane32_swap(__float_as_uint(m),__float_as_uint(m),false,false);
  return max2f(__uint_as_float(rr[0]),__uint_as_float(rr[1]));
}
__device__ __forceinline__ void pv(f32x16*o,int vb,bf16x8 pa0,bf16x8 pa1,bf16x8 pa2,bf16x8 pa3){
  #pragma unroll
  for(int d0=0;d0<2;++d0){s16x4 lo[4],hi[4];
    #pragma unroll
    for(int ks=0;ks<4;++ks){
      asm volatile("ds_read_b64_tr_b16 %0,%1 offset:%c2":"=&v"(lo[ks]):"v"(vb),"i"(d0*4096+ks*1024):"memory");
      asm volatile("ds_read_b64_tr_b16 %0,%1 offset:%c2":"=&v"(hi[ks]):"v"(vb),"i"(d0*4096+ks*1024+512):"memory");}
    asm volatile("s_waitcnt lgkmcnt(0)":::"memory");SBAR();
    #define PK(k) (bf16x8){lo[k][0],lo[k][1],lo[k][2],lo[k][3],hi[k][0],hi[k][1],hi[k][2],hi[k][3]}
    o[d0]=MF16(pa0,PK(0),o[d0],0,0,0);
    o[d0]=MF16(pa1,PK(1),o[d0],0,0,0);
    o[d0]=MF16(pa2,PK(2),o[d0],0,0,0);
    o[d0]=MF16(pa3,PK(3),o[d0],0,0,0);
    #undef PK
  }
}

#ifndef ATTN_STORE16
#define ATTN_STORE16(p,v) (*(u32x4*)(p)=(v))
#endif
template<int THRL> __device__ __forceinline__ void attn_unit(int b,int h,int qb,const bf16*Q,const bf16*__restrict__ K,const bf16*__restrict__ V,bf16*O,char*shm,const float*KMg,const float*rel_bias,bool newhead,bf16x8 (&qr)[4],const bf16*Qnext){
  int tid_=mk_tid(); asm volatile("":"+v"(tid_));
  const int tid=tid_,lane=tid&63,r32=lane&31,hi=lane>>5; const int wid=__builtin_amdgcn_readfirstlane(tid>>6);
  const long rowbase=(long)b*SEQ; const int q0=qb*QB;
  typedef __attribute__((address_space(3))) float* lds_fptr;
  const lds_fptr kml=(lds_fptr)(shm+LDS_KM); const lds_fptr btl=(lds_fptr)(shm+LDS_BT);
  if(newhead){
    {
      const bf16*Kn=K+(long)(b*NHEAD+h)*SEQ*D+(long)(tid>>3)*D+(tid&7)*8; const lds_fptr kpart=(lds_fptr)(shm+LDS_TOTAL);
      h16x8v kv_[32];
      #pragma unroll
      for(int i=0;i<32;++i)kv_[i]=*reinterpret_cast<const h16x8v*>(Kn+(long)i*64*D);
      #pragma unroll
      for(int n=0;n<8;++n){ float a_[8];
        #pragma unroll
        for(int e=0;e<8;++e)a_[e]=((float)kv_[4*n][e]+(float)kv_[4*n+1][e])+((float)kv_[4*n+2][e]+(float)kv_[4*n+3][e]);
        #pragma unroll
        for(int e=0;e<8;++e){ a_[e]+=__shfl_xor(a_[e],8); a_[e]+=__shfl_xor(a_[e],16); a_[e]+=__shfl_xor(a_[e],32); }
        if((lane>>3)==0){
          #pragma unroll
          for(int e=0;e<8;++e)kpart[(wid*8+n)*64+(lane&7)*8+e]=a_[e]; } }
      asm volatile("s_waitcnt vmcnt(0) lgkmcnt(0)\n\ts_barrier":::"memory");
      float t_=0.f;
      #pragma unroll
      for(int w8=0;w8<8;++w8)t_+=kpart[w8*512+tid];
      kml[tid]=t_*(1.0f/256.0f); }
    for(int e=tid;e<4*NBT;e+=NW*64){ const int cpy=e/NBT,i=e%NBT,j=i+cpy; float v=-INFINITY;
      const int dist=(NBT-1-j)-256;
      if(j<NBT&&dist>=0){ int bk=dist; if(dist>=16){ bk=16+(int)(logf((float)dist/16.0f)/logf(8.0f)*16.0f); bk=bk<31?bk:31; } v=(rel_bias[bk*NHEAD+h]-rel_bias[31*NHEAD+h])*1.4426950408889634f; }
      btl[e]=v; }
    asm volatile("s_waitcnt vmcnt(0) lgkmcnt(0)\n\ts_barrier":::"memory"); }
  const bf16*Qw=Q+(rowbase+q0+wid*QBLK)*DM+h*D;
  const bf16*Kh=K+(long)(b*NHEAD+h)*SEQ*D,*Vh=V+(long)(b*NHEAD+h)*SEQ*D;
  const unsigned lds0=(unsigned)(uintptr_t)shm;
  float*wsf=(float*)(shm+LDS_WS)+wid*64;
  const bf16*ksrc=Kh+(long)lane*D+wid*8;
  const bf16*vsrc=Vh+(long)(16*(wid&3)+(lane>>2))*D+(wid>>2)*32+(lane&3)*8;
  const unsigned kdst=lds0+LDS_K+wid*1024, vdst=lds0+LDS_V+wid*1024;
  #define TKT(t) ((t)<4 ? NT-4+(t) : NT-1-(t))
  #define DMA_K(t,slot) glds16(ksrc+(long)(TKT(t))*KVBLK*D,(unsigned)__builtin_amdgcn_readfirstlane(kdst+(slot)))
  #define DMA_V(t,slot) glds16(vsrc+(long)(TKT(t))*KVBLK*D,(unsigned)__builtin_amdgcn_readfirstlane(vdst+(slot)))
  const int vb0=(int)(lds0+LDS_V)+((lane>>4)&1)*32+(lane&3)*8+(4*hi+((lane&15)>>2))*64;
  const char*Kbase=shm+LDS_K; bf16x8 kf[8];
  const lds_cptr shm3=(lds_cptr)shm; const lds_cptr kp0=shm3+LDS_K+hi*1024+r32*16; const lds_cptr vp0=shm3+LDS_V+((lane>>4)&1)*32+(lane&3)*8+(4*hi+((lane&15)>>2))*64;
  const int NT=(q0+QB)/KVBLK;
  DMA_K(0,0);DMA_V(0,0);DMA_K(1,SLOTB);
  unsigned sel=0u;
  if(qb>0){ float g[7];
    #pragma unroll
    for(int n=0;n<7;++n){ float a=0.f;
      if(n<qb){
        #pragma unroll
        for(int d0=0;d0<4;++d0){ const h16x8v qv=__builtin_bit_cast(h16x8v,qr[d0]);
          #pragma unroll
          for(int j=0;j<8;++j)a+=(float)qv[j]*kml[n*64+16*d0+8*hi+j]; } }
      { auto rr=__builtin_amdgcn_permlane32_swap(__float_as_uint(a),__float_as_uint(a),false,false); a=__uint_as_float(rr[0])+__uint_as_float(rr[1]); }
      g[n]=(n<qb)?a:-INFINITY; }
    if(qb<=3)sel=(1u<<qb)-1u;
    else{
      #pragma unroll
      for(int n=0;n<7;++n){ int rank=0;
        #pragma unroll
        for(int m=0;m<7;++m)if(m!=n)rank+=((g[m]>g[n])||(g[m]==g[n]&&m<n))?1:0;
        if(n<qb&&rank<3)sel|=1u<<n; } } }
  const bool mixed=qb>3;
  typedef __attribute__((address_space(3))) unsigned* lds_uptr;
  if(mixed){ *(lds_uptr)(shm3+LDS_SEL+wid*2048+hi*1024+r32*16)=sel; }
  float mhat=0.f,l_reg=0.f;f32x16 o[2];o[0]=f32x16{};o[1]=f32x16{};f32x16 negm=f32x16{};asm volatile("":"+v"(negm));
  const int qrel=wid*QBLK+r32;
  #define CMASK(P0,P1,t) do{ const int t_=(t); const int kt_=TKT(t_); \
    if(t_<6){ const int s_=(NBT-1)-(q0+qrel-64*kt_-4*hi+256), c_=s_&3; const __attribute__((address_space(3))) f32x4* tp_=(const __attribute__((address_space(3))) f32x4*)(shm3+LDS_BT+c_*(NBT*4)+(s_-c_)*4); \
      f32x4 b0_[4],b1_[4]; _Pragma("unroll") for(int g=0;g<4;++g){ b0_[g]=tp_[2*g]; b1_[g]=tp_[2*g+8]; } \
      _Pragma("unroll") for(int g=0;g<4;++g) _Pragma("unroll") for(int e=0;e<4;++e){ P0[4*g+e]+=b0_[g][e]; P1[4*g+e]+=b1_[g][e]; } } \
    if(t_>=4&&mixed){ const unsigned sel_=sel; if(((sel_>>(kt_>>2))&1u)==0u){ _Pragma("unroll") for(int r=0;r<16;++r){P0[r]=-INFINITY;P1[r]=-INFINITY;} } } }while(0)
  bool resc=false;
  #define START(P0,P1) do{ const float rm=rowmax(P0,P1); resc=false; \
    { const float dl=rm; mhat=fadd_s(mhat,dl); \
      _Pragma("unroll") for(int r=0;r<16;++r){P0[r]=fsub_s(P0[r],dl);P1[r]=fsub_s(P1[r],dl);} \
      _Pragma("unroll") for(int r=0;r<16;++r)negm[r]=-mhat; asm volatile("":"+v"(negm)); } \
    _Pragma("unroll") for(int r=0;r<16;++r)P0[r]=__builtin_amdgcn_exp2f(P0[r]); }while(0)
  #define RESC() do{ if(resc){ asm volatile("s_waitcnt lgkmcnt(0)":::"memory"); \
      _Pragma("unroll") for(int d_=0;d_<2;++d_) _Pragma("unroll") for(int r=0;r<16;++r)o[d_][r]*=wsf[crow(r,hi)]; } }while(0)
  f32x16 pA0,pA1,pB0,pB1;
  int sl_prev=0,sl_cur=0,sl_next=SLOTB;
  #define ROT() do{sl_prev=sl_cur;sl_cur=sl_next;sl_next=(sl_next==(NSLOT-1)*SLOTB)?0:sl_next+SLOTB;}while(0)
  DMA_K(2,2*SLOTB);
  WAIT_BAR(3);
  qkt(pA0,pA1,Kbase,qr,negm,r32,hi);asm volatile("s_nop 15\n\ts_nop 7":"+v"(pA0),"+v"(pA1));CMASK(pA0,pA1,0);
  START(pA0,pA1);
  _Pragma("unroll") for(int r=0;r<16;++r)pA1[r]=__builtin_amdgcn_exp2f(pA1[r]);
  WAIT_BAR(0);
  DMA_K(3,0);DMA_V(1,SLOTB);
  ROT();
  kload8(kf,kp0+sl_cur);
  WAIT_BAR(2);
  s16x4 vlo[8],vhi[8]; u32x4 pw0,pw1,pw2,pw3;
  #define PKW(P,B) cvtpk_s(P[B],P[B+1])
  #define PAF(k) __builtin_bit_cast(bf16x8,pw##k)
  #define VFR(i) (bf16x8){vlo[i][0],vlo[i][1],vlo[i][2],vlo[i][3],vhi[i][0],vhi[i][1],vhi[i][2],vhi[i][3]}
  #define PIN(x) asm volatile("":"+v"(x))
  #define MX3(a,b,c) __builtin_fmaxf(__builtin_fmaxf((a),(b)),(c))
  #define GAPA(MF,A0,A1,A2,A3,W0,W1,PW) do{ MF; sacc+=A0; sacc+=A1; sacc+=A2; sacc+=A3; PIN(sacc); W0; W1; PIN(PW); SBAR(); }while(0)
  #define EX(v) __builtin_amdgcn_exp2f(v)
  #define GAPB(MF,X,B) do{ MF; X[B]=EX(X[B]); X[B+1]=EX(X[B+1]); X[B+2]=EX(X[B+2]); X[B+3]=EX(X[B+3]); PIN(X); SBAR(); }while(0)
  #define VRD(i) do{ vlo[i]=vtr(vp_+(((i)>>2)*4096+((i)&3)*1024)); vhi[i]=vtr(vp_+(((i)>>2)*4096+((i)&3)*1024+512)); }while(0)
  #define KRD(G,j) do{ if(G){ kload2(kf,kp0+sl_next,j); SBAR(); } }while(0)
  #define STEP(C0,C1,P0,P1,t,GK,GV,GL) do{ SBAR(); \
    const lds_cptr vp_=vp0+sl_prev; \
    VRD(0); SBAR(); float sacc=(P0[0]+P0[1]); \
    GAPA(C0=MF16(kf[0],qr[0],negm,0,0,0), P0[2],P0[3],P0[4],P0[5],     pw0[0]=PKW(P0,0), pw0[1]=PKW(P0,2), pw0); \
    VRD(4); SBAR(); GAPA(C1=MF16(kf[1],qr[0],negm,0,0,0), P0[6],P0[7],P0[8],P0[9],     pw0[2]=PKW(P0,4), pw0[3]=PKW(P0,6), pw0); \
    VRD(1); SBAR(); GAPA(C0=MF16(kf[2],qr[1],C0,0,0,0),   P0[10],P0[11],P0[12],P0[13], pw1[0]=PKW(P0,8), pw1[1]=PKW(P0,10), pw1); \
    VRD(5); SBAR(); GAPA(C1=MF16(kf[3],qr[1],C1,0,0,0),   P0[14],P0[15],P1[0],P1[1],   pw1[2]=PKW(P0,12),pw1[3]=PKW(P0,14), pw1); \
    VRD(2); SBAR(); GAPA(C0=MF16(kf[4],qr[2],C0,0,0,0),   P1[2],P1[3],P1[4],P1[5],     pw2[0]=PKW(P1,0), pw2[1]=PKW(P1,2), pw2); \
    VRD(6); SBAR(); GAPA(C1=MF16(kf[5],qr[2],C1,0,0,0),   P1[6],P1[7],P1[8],P1[9],     pw2[2]=PKW(P1,4), pw2[3]=PKW(P1,6), pw2); \
    VRD(3); SBAR(); GAPA(C0=MF16(kf[6],qr[3],C0,0,0,0),   P1[10],P1[11],P1[12],P1[13], pw3[0]=PKW(P1,8), pw3[1]=PKW(P1,10), pw3); \
    VRD(7); SBAR(); GAPA(C1=MF16(kf[7],qr[3],C1,0,0,0),   P1[14],P1[15],0.f,0.f,       pw3[2]=PKW(P1,12),pw3[3]=PKW(P1,14), pw3); \
    l_reg+=sacc; \
    if(GK){DMA_K((t)+3,sl_cur);} if(GV){DMA_V((t)+1,sl_next);} \
    CMASK(C0,C1,t); \
    { float a=MX3(C0[0],C0[1],C1[0]),b=MX3(C0[2],C0[3],C1[1]); a=MX3(a,C1[2],C1[3]); \
      _Pragma("unroll") for(int r=4;r<16;r+=4){a=MX3(a,C0[r],C0[r+1]);b=MX3(b,C0[r+2],C0[r+3]);a=MX3(a,C1[r],C1[r+1]);b=MX3(b,C1[r+2],C1[r+3]);} \
      float rm=__builtin_fmaxf(a,b); { auto rr=__builtin_amdgcn_permlane32_swap(__float_as_uint(rm),__float_as_uint(rm),false,false); rm=__builtin_fmaxf(__uint_as_float(rr[0]),__uint_as_float(rr[1])); } \
      resc=false; \
      if(__builtin_expect(__any(rm>(float)THRL),0)){ const float dl=__builtin_fmaxf(rm,0.f); mhat+=dl; \
        _Pragma("unroll") for(int r=0;r<16;++r){C0[r]-=dl;C1[r]-=dl;} \
        _Pragma("unroll") for(int r=0;r<16;++r)negm[r]=-mhat; asm volatile("":"+v"(negm)); \
        const float f=__builtin_amdgcn_exp2f(-dl); l_reg*=f; { int r32o_=r32; asm volatile("":"+v"(r32o_)); if(hi==0)wsf[r32o_]=f; }     resc=true; } } \
    SBAR(); \
    GAPB(o[0]=MF16(PAF(0),VFR(0),o[0],0,0,0), C0,0); \
    GAPB(o[1]=MF16(PAF(0),VFR(4),o[1],0,0,0), C0,4); \
    KRD(GL,0); GAPB(o[0]=MF16(PAF(1),VFR(1),o[0],0,0,0), C0,8); \
    KRD(GL,1); GAPB(o[1]=MF16(PAF(1),VFR(5),o[1],0,0,0), C0,12); \
    KRD(GL,2); GAPB(o[0]=MF16(PAF(2),VFR(2),o[0],0,0,0), C1,0); \
    KRD(GL,3); GAPB(o[1]=MF16(PAF(2),VFR(6),o[1],0,0,0), C1,4); \
    GAPB(o[0]=MF16(PAF(3),VFR(3),o[0],0,0,0), C1,8); \
    GAPB(o[1]=MF16(PAF(3),VFR(7),o[1],0,0,0), C1,12); \
    }while(0)
  int t=1;
  #define ENDW(tt) do{ if((tt)+3<NT){WAIT_BAR(2);} else if((tt)+2<NT){WAIT_BAR(1);} else {WAIT_BAR(0);} }while(0)
  for(;t<7&&t+1<NT;t+=2){
    STEP(pB0,pB1,pA0,pA1,t,(t+3<NT),(t+1<NT),(t+1<NT));       ENDW(t);   RESC(); ROT();
    STEP(pA0,pA1,pB0,pB1,t+1,(t+4<NT),(t+2<NT),(t+2<NT));     ENDW(t+1); RESC(); ROT();
  }
  #pragma push_macro("CMASK")
  #undef CMASK
  #define CMASK(P0,P1,t) do{ if(mixed){ const unsigned sel_=sel; if(((sel_>>(TKT(t)>>2))&1u)==0u){ _Pragma("unroll") for(int r=0;r<16;++r){P0[r]=-INFINITY;P1[r]=-INFINITY;} } } }while(0)
  for(;t+5<NT;t+=2){
    STEP(pB0,pB1,pA0,pA1,t,true,true,true);     WAIT_BAR(2); RESC(); ROT();
    STEP(pA0,pA1,pB0,pB1,t+1,true,true,true);   WAIT_BAR(2); RESC(); ROT();
  }
  #pragma pop_macro("CMASK")
  for(;t+1<NT;t+=2){
    STEP(pB0,pB1,pA0,pA1,t,(t+3<NT),(t+1<NT),(t+1<NT));       ENDW(t);   RESC(); ROT();
    STEP(pA0,pA1,pB0,pB1,t+1,(t+4<NT),(t+2<NT),(t+2<NT));     ENDW(t+1); RESC(); ROT();
  }
  STEP(pB0,pB1,pA0,pA1,NT-1,false,false,false); RESC();
  if(Qnext){
    #pragma unroll
    for(int d0=0;d0<4;++d0)qr[d0]=*reinterpret_cast<const bf16x8*>(&Qnext[(long)(wid*QBLK+r32)*DM+d0*16+hi*8]); }
  { float sacc=pB0[0]+pB0[1]; _Pragma("unroll") for(int r=2;r<16;++r)sacc+=pB0[r]; _Pragma("unroll") for(int r=0;r<16;++r)sacc+=pB1[r]; l_reg+=sacc;
    pw0=(u32x4){PKW(pB0,0),PKW(pB0,2),PKW(pB0,4),PKW(pB0,6)};pw1=(u32x4){PKW(pB0,8),PKW(pB0,10),PKW(pB0,12),PKW(pB0,14)};pw2=(u32x4){PKW(pB1,0),PKW(pB1,2),PKW(pB1,4),PKW(pB1,6)};pw3=(u32x4){PKW(pB1,8),PKW(pB1,10),PKW(pB1,12),PKW(pB1,14)};
    SBAR(); pv(o,vb0+sl_cur,PAF(0),PAF(1),PAF(2),PAF(3)); }
  #undef PKW
  #undef PAF
  #undef VFR
  #undef PIN
  #undef MX3
  #undef GAPA
  #undef GAPB
  #undef EX
  #undef VRD
  #undef KRD
  #undef STEP
  #undef ENDW
  {auto rr=__builtin_amdgcn_permlane32_swap(__float_as_uint(l_reg),__float_as_uint(l_reg),false,false);l_reg=__uint_as_float(rr[0])+__uint_as_float(rr[1]);}
  if(hi==0)wsf[32+r32]=l_reg;asm volatile("s_waitcnt lgkmcnt(0)":::"memory");
  float rli[16];
  #pragma unroll
  for(int r=0;r<16;++r)rli[r]=__builtin_amdgcn_rcpf(wsf[32+crow(r,hi)]);
  bf16*Ow=O+(rowbase+q0+wid*QBLK)*DM+h*D;
  { bf16*stg=(bf16*)(shm+LDS_OST)+wid*2048;
    #pragma unroll
    for(int r=0;r<16;++r){const int orow=crow(r,hi);
      #pragma unroll
      for(int d0=0;d0<2;++d0)stg[orow*64+d0*32+r32]=(bf16)(o[d0][r]*rli[r]);}
    asm volatile("s_waitcnt lgkmcnt(0)":::"memory");
    #pragma unroll
    for(int i=0;i<4;++i){const int row=i*8+(lane>>3),ch=lane&7; const u32x4 v=*(const u32x4*)(stg+row*64+ch*8); ATTN_STORE16(Ow+(long)row*DM+ch*8,v);} }
  asm volatile("s_waitcnt lgkmcnt(0)\n\ts_barrier":::"memory");
  #undef DMA_K
  #undef DMA_V
  #undef CMASK
  #undef START
  #undef RESC
  #undef ROT
}
constexpr int ATTN_LDS_BYTES=LDS_TOTAL;
#undef SBAR
#undef WAIT_BAR
}

constexpr int KP = 144, TILE_B = 64 * KP;
constexpr int A_K = 0, A_V = 2 * TILE_B, A_KM = 4 * TILE_B, A_BT = A_KM + 2048, A_FL = A_BT + 1280, NBT = 320;

#define ATT_COMMON_SETUP \
    int tid_ = mk_tid(); asm volatile("" : "+v"(tid_)); \
    const int tid = tid_, lane = tid & 63, w = __builtin_amdgcn_readfirstlane(tid >> 6), r = lane & 31, hh = lane >> 5; \
    const int srow = tid >> 3, sch = tid & 7; \
    const int i16 = lane & 15, q4 = i16 >> 2, p4 = i16 & 3, blk = (lane >> 4) & 1; \
    const int voff = (4 * hh + q4) * KP + (16 * blk + 4 * p4) * 2; \
    const int koff = r * KP + 16 * hh; \
    const h16* Qb = (const h16*)(P.ws + WS_Q); const h16* Kb = (const h16*)(P.ws + WS_K); const h16* Vb = (const h16*)(P.ws + WS_V); h16* Ob = (h16*)(P.ws + WS_O);

#define ATT_QK(s, kbuf, cinit) do { h16x8 kf_[2][4]; \
        _Pragma("unroll") for (int kb = 0; kb < 2; ++kb) _Pragma("unroll") for (int ks = 0; ks < 4; ++ks) kf_[kb][ks] = *(const LAS h16x8*)((kbuf) + koff + kb * 32 * KP + ks * 32); \
        __builtin_amdgcn_sched_barrier(0); \
        _Pragma("unroll") for (int kb = 0; kb < 2; ++kb) _Pragma("unroll") for (int i = 0; i < 16; ++i) s[kb][i] = (cinit); \
        __builtin_amdgcn_s_setprio(1); _Pragma("unroll") for (int ks = 0; ks < 4; ++ks) _Pragma("unroll") for (int kb = 0; kb < 2; ++kb) s[kb] = MFMA32(kf_[kb][ks], qf[ks], s[kb]); __builtin_amdgcn_s_setprio(0); } while (0)
#define ATT_QK_ACC(s, kbuf) do { h16x8 kf_[2][4]; \
        _Pragma("unroll") for (int kb = 0; kb < 2; ++kb) _Pragma("unroll") for (int ks = 0; ks < 4; ++ks) kf_[kb][ks] = *(const LAS h16x8*)((kbuf) + koff + kb * 32 * KP + ks * 32); \
        __builtin_amdgcn_sched_barrier(0); \
        __builtin_amdgcn_s_setprio(1); _Pragma("unroll") for (int ks = 0; ks < 4; ++ks) _Pragma("unroll") for (int kb = 0; kb < 2; ++kb) s[kb] = MFMA32(kf_[kb][ks], qf[ks], s[kb]); __builtin_amdgcn_s_setprio(0); } while (0)
#define ATT_LOADV(vf, vbuf) do { _Pragma("unroll") for (int s4 = 0; s4 < 4; ++s4) _Pragma("unroll") for (int db = 0; db < 2; ++db) { const LAS unsigned char* vp = (vbuf) + voff + 16 * s4 * KP + 64 * db; vf[s4][db] = tr8(vp, vp + 8 * KP); } \
        __builtin_amdgcn_sched_barrier(0); } while (0)
#define ATT_PV(o, s, vf) do { __builtin_amdgcn_s_setprio(1); _Pragma("unroll") for (int s4 = 0; s4 < 4; ++s4) { const h16x8 pf = pack8(s[s4 >> 1], s4 & 1); \
        _Pragma("unroll") for (int db = 0; db < 2; ++db) o[db] = MFMA32(vf[s4][db], pf, o[db]); } __builtin_amdgcn_s_setprio(0); } while (0)

__device__ __forceinline__ void p_attn_moba(const Params& P, unsigned char* lds_generic) {
    int prev_bh = -1;
    const h16* Qg = (const h16*)(P.ws + WS_Q);
#define MOBA_QBASE(L_) (Qg + ((size_t)((((L_) & 255) + 256 * ((L_) >> 11)) >> 4) * SEQ + 256 * (((L_) >> 8) & 7)) * DM + ((((L_) & 255) + 256 * ((L_) >> 11)) & 15) * DH)
    attn_body::bf16x8 qr[4];
    { int tid_ = mk_tid(); asm volatile("" : "+v"(tid_)); const int lane_ = tid_ & 63, wid_ = tid_ >> 6; const h16* q0p = MOBA_QBASE((int)blockIdx.x) + (size_t)(wid_ * 32 + (lane_ & 31)) * DM + (lane_ >> 5) * 8;
#pragma unroll
      for (int d0 = 0; d0 < 4; ++d0) qr[d0] = *reinterpret_cast<const attn_body::bf16x8*>(q0p + d0 * 16); }
    for (int L = blockIdx.x; L < 4096; L += gridDim.x) {
        const int qb = (L >> 8) & 7, bh = (L & 255) + 256 * (L >> 11), b = bh >> 4, h = bh & 15; const int Ln = L + (int)gridDim.x;
        attn_body::attn_unit<8>(b, h, qb, Qg, (const h16*)(P.ws + WS_K), (const h16*)(P.ws + WS_V), (h16*)(P.ws + WS_O), (char*)lds_generic,
                                (const float*)(P.ws + WS_KM) + (size_t)bh * 512, P.rel_bias, bh != prev_bh, qr, Ln < 4096 ? MOBA_QBASE(Ln) : nullptr);
        prev_bh = bh;
    }
}

__device__ __forceinline__ void p_attn_sb(const Params& P, LAS unsigned char* lds) {
    ATT_COMMON_SETUP
    LAS int* flags = (LAS int*)(lds + A_FL);
    h16x8 uf[2], ones;
#pragma unroll
    for (int ks = 0; ks < 2; ++ks)
#pragma unroll
        for (int jj = 0; jj < 8; ++jj) { const int k = 16 * ks + 8 * (jj >> 2) + 4 * hh + (jj & 3); uf[ks][jj] = (k > r) ? (h16)1.0f : (h16)0.0f; }
#pragma unroll
    for (int jj = 0; jj < 8; ++jj) ones[jj] = (h16)1.0f;
    for (int L = blockIdx.x; L < 4096; L += gridDim.x) {
        const int qb = (L >> 8) & 7, bh = (L & 255) + 256 * (L >> 11), b = bh >> 4, h = bh & 15;
        const size_t tokbase = (size_t)b * SEQ;
        const h16* Kg = Kb + (size_t)bh * SEQ * DH; const h16* Vg = Vb + (size_t)bh * SEQ * DH;
        const int t = 256 * qb + 32 * w + r;
        const int nt = 4 * qb + 4;
        __syncthreads();
        if (tid < 16) flags[tid] = 0;
        { const size_t go = (size_t)(64 * (nt - 1) + srow) * DH + sch * 8; const u32x4 k0 = *(const u32x4*)(Kg + go), v0 = *(const u32x4*)(Vg + go);
          *(LAS u32x4*)(lds + A_K + srow * KP + sch * 16) = k0; *(LAS u32x4*)(lds + A_V + srow * KP + sch * 16) = v0; }
        h16x8 qf[4];
        { const h16* qp = Qb + (tokbase + t) * DM + h * DH + 8 * hh;
#pragma unroll
          for (int ks = 0; ks < 4; ++ks) qf[ks] = *(const h16x8*)(qp + 16 * ks); }
        __syncthreads();
        float carry = 0.f; bool wdone = false; f32x16 o[2];
#pragma unroll
        for (int i = 0; i < 16; ++i) { o[0][i] = 0.f; o[1][i] = 0.f; }
        for (int j = 0; j < nt; ++j) {
            const int kt = nt - 1 - j; const bool more = (j + 1 < nt);
            const size_t go = (size_t)(64 * (more ? kt - 1 : kt) + srow) * DH + sch * 8; const u32x4 kreg = *(const u32x4*)(Kg + go), vreg = *(const u32x4*)(Vg + go);
            const LAS unsigned char* kbuf = lds + A_K + (j & 1) * TILE_B; const LAS unsigned char* vbuf = lds + A_V + (j & 1) * TILE_B;
            const int jo = kt - 4 * qb;
            const bool active = !wdone && (jo < 0 || 2 * jo <= w);
            if (active) {
                f32x16 z[2], lk[2];
                const bool diag = (64 * kt + 63 >= 256 * qb + 32 * w);
                const int sb = 64 * kt;
                if (diag) {
#pragma unroll
                    for (int kb = 0; kb < 2; ++kb)
#pragma unroll
                        for (int i = 0; i < 16; ++i) z[kb][i] = (sb + 32 * kb + crow(i, hh) < t) ? 0.f : -1.0e30f;
                } else {
#pragma unroll
                    for (int i = 0; i < 16; ++i) { z[0][i] = 0.f; z[1][i] = 0.f; } }
                ATT_QK_ACC(z, kbuf);
                h16x8 vf[4][2]; ATT_LOADV(vf, vbuf);
#pragma unroll
                for (int kb = 0; kb < 2; ++kb)
#pragma unroll
                    for (int i = 0; i < 16; ++i) { const float zz = z[kb][i]; const float e = ex2(-fabsf(zz)); lk[kb][i] = -(fmaxf(zz, 0.f) + lg2(1.0f + e)); }
                const h16x8 x00 = pack8(lk[0], 0), x01 = pack8(lk[0], 1), x10 = pack8(lk[1], 0), x11 = pack8(lk[1], 1);
                const float lk00 = lk[0][0], lb00 = z[0][0] + lk00;
#pragma unroll
                for (int i = 0; i < 16; ++i) { z[0][i] += lk[0][i]; z[1][i] += lk[1][i]; }
                z[0][0] = 0.f;
                __builtin_amdgcn_s_setprio(1);
                f32x16 y0 = MFMA32(uf[0], x00, z[0]), y1 = MFMA32(uf[0], x10, z[1]);
                y0 = MFMA32(uf[1], x01, y0); y1 = MFMA32(uf[1], x11, y1); y0 = MFMA32(ones, x10, y0); y0 = MFMA32(ones, x11, y0);
                __builtin_amdgcn_s_setprio(0);
                float tot = y0[0] + lk00;
                { auto rr_ = __builtin_amdgcn_permlane32_swap(__float_as_uint(tot), __float_as_uint(tot), false, false); tot = __uint_as_float(rr_[0]); }
                y0[0] += lb00;
#pragma unroll
                for (int i = 0; i < 16; ++i) { z[0][i] = ex2(y0[i] + carry); z[1][i] = ex2(y1[i] + carry); }
                carry += tot;
                ATT_PV(o, z, vf);
                wdone = (__ballot(carry < -151.0f) == ~0ull);
            }
            if (wdone && lane == 0) flags[(j & 1) * 8 + w] = 1;
            if (more) { *(LAS u32x4*)(lds + A_K + ((j + 1) & 1) * TILE_B + srow * KP + sch * 16) = kreg; *(LAS u32x4*)(lds + A_V + ((j + 1) & 1) * TILE_B + srow * KP + sch * 16) = vreg; }
            __syncthreads();
            const u32x4 fa_ = *(const LAS u32x4*)(flags + (j & 1) * 8), fb_ = *(const LAS u32x4*)(flags + (j & 1) * 8 + 4);
            if ((fa_.x + fa_.y + fa_.z + fa_.w) + (fb_.x + fb_.y + fb_.z + fb_.w) == 8u) break;
        }
        h16* op = Ob + (tokbase + t) * DM + h * DH + 4 * hh;
#pragma unroll
        for (int db = 0; db < 2; ++db)
#pragma unroll
            for (int gq = 0; gq < 4; ++gq) { u32x2 wv; wv.x = pk2h(o[db][4 * gq], o[db][4 * gq + 1]); wv.y = pk2h(o[db][4 * gq + 2], o[db][4 * gq + 3]); *(u32x2*)(op + 32 * db + 8 * gq) = wv; }
    }
}

__global__ void __launch_bounds__(NT) fwd_megakernel(Params P) {
    extern __shared__ __attribute__((aligned(16))) unsigned char lds_raw[];
    LAS unsigned char* lds = (LAS unsigned char*)lds_raw;
    cg::grid_group grid = cg::this_grid();
    { const unsigned hw = (unsigned)__builtin_amdgcn_s_getreg((5 << 11) | 4) & 63u; ((LAS int*)(uintptr_t)MK_WTAB)[hw] = (int)(threadIdx.x >> 6); }
    __syncthreads();
    const int lo = P.ph_lo, hi = P.ph_hi, G = gridDim.x, c = blockIdx.x;
#define RUN(k) (lo <= (k) && (k) < hi)
#define SEAM(k) do { if (RUN(k) && hi - lo > 1) xcd_barrier(bar); } while (0)
    volatile unsigned* st = (volatile unsigned*)(P.ws + WS_BARST) + 4 * blockIdx.x;
    XcdBarrier bar; bar.bar = (unsigned*)(P.ws + WS_BAR); bar.x = 0; bar.st = nullptr;
    if (hi - lo > 1) bar = xcd_barrier_post((unsigned*)(P.ws + WS_BAR), st);
    if (hi < 0) grid.sync();
    h16* Xh = (h16*)(P.ws + WS_X16); h16* Y1 = (h16*)(P.ws + WS_YA); h16* Y2 = (h16*)(P.ws + WS_YB); h16* Qh = (h16*)(P.ws + WS_Q); h16* Oh = (h16*)(P.ws + WS_O); h16* Uh = (h16*)(P.ws + WS_U);
    pg8::f32x2_t* ST1 = (pg8::f32x2_t*)(P.ws + WS_ST1); pg8::f32x2_t* ST2 = (pg8::f32x2_t*)(P.ws + WS_ST2); const float* CS = (const float*)(P.ws + WS_CS); const float* BW = CS + NCS;
    const LAS unsigned char* tbl = lds + ST_OFF;
    if (RUN(0)) p_prologue(P, lds);
    SEAM(0);
#pragma unroll 1
    for (int l = 0; l < DEPTH; ++l) {
        const int pb = 1 + 8 * l; unsigned char* wl = P.ws + WS_W + (size_t)l * W_LAYER_B;
        const h16* Wqkv = (const h16*)wl; const h16* Wo = (const h16*)(wl + W_QKV_B); const h16* Wup = (const h16*)(wl + W_QKV_B + W_O_B); const h16* Wdn = (const h16*)(wl + W_QKV_B + W_O_B + W_UP_B);
        if (RUN(pb + 0)) {
            pg8::StaticOrder S; S.init(M_TOK, 3 * DM, G, c);
            if (l == 0) { pg8::Gemm g{Xh, Wqkv, M_TOK, 3 * DM, DM}; pg8::Epi<0, false> E{Qh, DM, DM, (size_t)(WS_K - WS_Q) / 2, QSCALE, nullptr, 0.f, nullptr, nullptr};
                pg8::gemm_phase<pg8::Epi<0, false>, pg8::StaticOrder, true, true>(lds, g, S, E); }
            else { p_fill_tables(lds, (const float*)ST2, S, CS + 8192, BW + 8192);
                pg8::Gemm g{Y2, Wqkv, M_TOK, 3 * DM, DM}; pg8::Epi<0, true> E{Qh, DM, DM, (size_t)(WS_K - WS_Q) / 2, QSCALE, nullptr, 0.f, tbl, nullptr};
                pg8::gemm_phase<pg8::Epi<0, true>, pg8::StaticOrder, true, true>(lds, g, S, E); } }
        SEAM(pb + 0);
        if (RUN(pb + 2)) { if (l == 0) { p_cs_finalize(P); p_attn_moba(P, lds_raw); } else p_attn_sb(P, lds); }
        SEAM(pb + 2);
        if (RUN(pb + 3)) {
            pg8::Gemm g{Oh, Wo, M_TOK, DM, DM}; pg8::StaticOrder S; S.init(M_TOK, DM, G, c);
            if (l == 0) { pg8::Epi<2, false> E{Y1, DM, 0, 0, 1.f, Xh, ALPHA, nullptr, ST1};
                pg8::gemm_phase<pg8::Epi<2, false>, pg8::StaticOrder, true, true>(lds, g, S, E); }
            else { p_fill_tables(lds, (const float*)ST2, S, P.ln_ffn_g + (l - 1) * DM, P.ln_ffn_b + (l - 1) * DM);
                pg8::Epi<2, true> E{Y1, DM, 0, 0, 1.f, Y2, ALPHA, tbl, ST1};
                pg8::gemm_phase<pg8::Epi<2, true>, pg8::StaticOrder, true, true>(lds, g, S, E); } }
        SEAM(pb + 3);
        if (RUN(pb + 5)) {
            pg8::Gemm g{Y1, Wup, M_TOK, FF, DM}; pg8::StaticOrder S; S.init(M_TOK, FF, G, c);
            p_fill_tables(lds, (const float*)ST1, S, CS + l * 4096, BW + l * 4096);
            pg8::Epi<1, true> E{Uh, FF, 0, 0, 1.f, nullptr, 0.f, tbl, nullptr};
            pg8::gemm_phase<pg8::Epi<1, true>, pg8::StaticOrder, true, true>(lds, g, S, E); }
        SEAM(pb + 5);
        if (RUN(pb + 6)) {
            pg8::Gemm g{Uh, Wdn, M_TOK, DM, FF}; pg8::StaticOrder S; S.init(M_TOK, DM, G, c);
            p_fill_tables(lds, (const float*)ST1, S, P.ln_mix_g + l * DM, P.ln_mix_b + l * DM);
            pg8::Epi<2, true> E{Y2, DM, 0, 0, 1.f, Y1, ALPHA, tbl, ST2};
            pg8::gemm_phase<pg8::Epi<2, true>, pg8::StaticOrder, true, true>(lds, g, S, E); }
        if (l + 1 < DEPTH) SEAM(pb + 6);
    }
    if (RUN(NPHASE - 1)) { if (RUN(NPHASE - 2)) xcd_barrier(bar); p_ln<true>(Y2, nullptr, P.out, P.ln_ffn_g + (DEPTH - 1) * DM, P.ln_ffn_b + (DEPTH - 1) * DM, (const float*)ST2); }
#undef RUN
#undef SEAM
}

extern "C" void kernel_launch(void* const* d_in, const int* in_sizes, int n_in, void* d_out, int out_size, void* d_ws, size_t ws_size, hipStream_t stream) {
    static int grid = 0;
    if (grid == 0) {
        if (n_in != 10 || in_sizes[0] != M_TOK * DM || out_size != M_TOK * DM || ws_size < WS_END) { fprintf(stderr, "kernel_launch: unexpected shapes / workspace (%d inputs, x %d, out %d, ws %zu < %zu)\n", n_in, n_in > 0 ? in_sizes[0] : -1, out_size, ws_size, (size_t)WS_END); grid = -1; return; }
        int dev = 0, cus = 0, per_cu = 0;
        (void)hipGetDevice(&dev); (void)hipDeviceGetAttribute(&cus, hipDeviceAttributeMultiprocessorCount, dev);
        if (hipFuncSetAttribute((const void*)fwd_megakernel, hipFuncAttributeMaxDynamicSharedMemorySize, LDS_BYTES) != hipSuccess) { fprintf(stderr, "kernel_launch: hipFuncSetAttribute failed\n"); grid = -1; return; }
        if (hipOccupancyMaxActiveBlocksPerMultiprocessor(&per_cu, (const void*)fwd_megakernel, NT, LDS_BYTES) != hipSuccess || per_cu < 1) { fprintf(stderr, "kernel_launch: occupancy query says %d blocks per CU\n", per_cu); per_cu = 1; }
        (void)hipGetLastError();
        grid = cus > 0 ? cus : 256;
    }
    if (grid < 0) return;
    Params p{};
    p.x = (const float*)d_in[0]; p.rel_bias = (const float*)d_in[1]; p.w_qkv = (const float*)d_in[2]; p.w_o = (const float*)d_in[3]; p.ln_mix_g = (const float*)d_in[4]; p.ln_mix_b = (const float*)d_in[5];
    p.w_up = (const float*)d_in[6]; p.w_down = (const float*)d_in[7]; p.ln_ffn_g = (const float*)d_in[8]; p.ln_ffn_b = (const float*)d_in[9]; p.out = (float*)d_out; p.ws = (unsigned char*)d_ws;
#if MK_LAUNCHES == 1
    p.ph_lo = 0; p.ph_hi = NPHASE;
    if (hipMemsetAsync((char*)d_ws + WS_BAR, 0, CTL_BYTES, stream) != hipSuccess) { fprintf(stderr, "kernel_launch: hipMemsetAsync of the barrier words failed\n"); return; }
    void* args[] = {&p};
    const hipError_t e = hipLaunchCooperativeKernel((const void*)fwd_megakernel, dim3(grid), dim3(NT), args, LDS_BYTES, stream);
    if (e != hipSuccess) fprintf(stderr, "kernel_launch: cooperative launch failed: %s (grid %d)\n", hipGetErrorString(e), grid);
#else
    for (int ph = 0; ph < NPHASE; ++ph) { if (ph == 2 || ph == 10 || ph == 5 || ph == 8 || ph == 13) continue;
        p.ph_lo = ph; p.ph_hi = ph + 1; hipLaunchKernelGGL(fwd_megakernel, dim3(grid), dim3(NT), LDS_BYTES, stream, p); }
#endif
}
```

```cpp
#include <hip/hip_runtime.h>
#include <hip/hip_cooperative_groups.h>
#include <cstdio>
#include <cstdint>
namespace cg = cooperative_groups;
constexpr unsigned MK_WTAB = 131072u + 20480u;
__device__ __forceinline__ int mk_tid() {
    const unsigned hw = (unsigned)__builtin_amdgcn_s_getreg((5 << 11) | 4) & 63u;
    const int wave = ((const __attribute__((address_space(3))) int*)(uintptr_t)MK_WTAB)[hw];
    int lane; asm volatile("v_mbcnt_lo_u32_b32 %0, -1, 0\n\tv_mbcnt_hi_u32_b32 %0, -1, %0" : "=v"(lane));
    return __builtin_amdgcn_readfirstlane(wave) * 64 + lane;
}
namespace pg8 {
#define PG8_LAS __attribute__((address_space(3)))
typedef _Float16 bf16_t;
typedef _Float16 bf16x8 __attribute__((ext_vector_type(8)));
typedef float f32x4 __attribute__((ext_vector_type(4)));
typedef unsigned u32x4 __attribute__((ext_vector_type(4)));
constexpr int BM = 256, BK = 64, HALF = 128, HTB = HALF * BK * 2  , STAGE_BYTES = 8 * HTB, NXCD = 8, WGM = 8;

__host__ __device__ __forceinline__ int lds_byte(int r, int c) { const int st = (r >> 4) * 2 + (c >> 5), rr = r & 15, cc = c & 31, ob = rr * 64 + cc * 2; return st * 1024 + (ob ^ (((ob >> 9) & 1) << 5)); }
__host__ __device__ __forceinline__ void stage_rc(int b, int& R, int& C) { const int st = b / 1024, sb = b % 1024, swz = sb ^ (((sb >> 9) & 1) << 5); R = (st >> 1) * 16 + swz / 64; C = (st & 1) * 32 + (swz % 64) / 2; }
__host__ __device__ __forceinline__ int perm32(int rho) { const int n = rho >> 4, i = rho & 15; return 8 * (i >> 2) + 4 * n + (i & 3); }

struct Unit { int pm, pn; };
struct Gemm { const bf16_t* A; const bf16_t* Bt; int M, N, K; };

struct StaticOrder {
    int nM, nN, nwg, G, c, rev;
    __host__ __device__ void init(int M, int N, int G_, int c_) { nM = M / BM; nN = N / BM; nwg = nM * nN; G = G_; c = c_; rev = 0; }
    __host__ __device__ bool next(int i, Unit& u) const {
        const long L = (long)i * G + c; if (L >= nwg) return false;
        int wgid = (int)L; { const int q = nwg / NXCD, r = nwg % NXCD, xcd = wgid % NXCD, off = wgid / NXCD; wgid = (xcd < r ? xcd * (q + 1) : r * (q + 1) + (xcd - r) * q) + off; }
        const int nig = WGM * nN, gid = wgid / nig, fm = gid * WGM, gsz = (nM - fm) < WGM ? (nM - fm) : WGM;
        u.pm = fm + ((wgid % nig) % gsz); u.pn = (wgid % nig) / gsz; if (rev) u.pm = nM - 1 - u.pm; return true;
    }
    __device__ __forceinline__ void a_ready(const Unit&) const {}
    __device__ __forceinline__ void done(const Unit&) const {}
};


typedef _Float16 h16x2_t __attribute__((ext_vector_type(2)));
__device__ __forceinline__ unsigned pk2h(float lo, float hi) { h16x2_t v = {(_Float16)lo, (_Float16)hi}; return __builtin_bit_cast(unsigned, v); }
typedef float f32x2_t __attribute__((ext_vector_type(2)));
template <int MODE, bool FOLD> struct Epi {
    static constexpr bool PERM = true, AFTER_DRAIN = false;
    bf16_t* O; int ldc; int split_cols; size_t split_stride; float scale0; const bf16_t* R; float alpha;
    const PG8_LAS unsigned char* tb; f32x2_t* part;
    __device__ __forceinline__ void operator()(const f32x4 (&acc)[2][2][4][2], const Unit& u, int ui, int wr, int wc, int fr, int fq) const {
        const int row0 = u.pm * BM + wr * 64 + fr; int colt = u.pn * BM; bf16_t* base = O;
        float sc = 1.f; bool hm = false;
        if (MODE == 0 && split_cols) { const int t = colt / split_cols; base += (size_t)t * split_stride; colt -= t * split_cols; if (t == 0) sc = scale0; else hm = true; }
        const int col0 = colt + wc * 32 + 8 * fq;
        f32x4 cv[2][2], bv[2][2]; int pslot = 0;
        if (FOLD) { const PG8_LAS int* sl = (const PG8_LAS int*)(tb + 16384); pslot = sl[ui] * 256; const int cslot = sl[16 + ui] * 256 + wc * 32 + 8 * fq;
            const PG8_LAS float* csl = (const PG8_LAS float*)(tb + 8192); const PG8_LAS float* bwl = (const PG8_LAS float*)(tb + 12288);
#pragma unroll
            for (int bj = 0; bj < 2; ++bj)
#pragma unroll
                for (int n = 0; n < 2; ++n) { cv[bj][n] = *(const PG8_LAS f32x4*)(csl + cslot + bj * HALF + 4 * n); bv[bj][n] = *(const PG8_LAS f32x4*)(bwl + cslot + bj * HALF + 4 * n); } }
#pragma unroll
        for (int ai = 0; ai < 2; ++ai) {
        bf16x8 rr[4][2];
        if (MODE == 2) {
#pragma unroll
            for (int m = 0; m < 4; ++m)
#pragma unroll
                for (int bj = 0; bj < 2; ++bj) rr[m][bj] = *(const bf16x8*)(R + (size_t)(row0 + ai * HALF + m * 16) * ldc + col0 + bj * HALF);
            __builtin_amdgcn_sched_barrier(0); }
#pragma unroll
            for (int m = 0; m < 4; ++m) { const int row = row0 + ai * HALF + m * 16; const size_t off = (size_t)row * ldc + col0;
                float mu = 0.f, rs = 1.f; if (FOLD) { const f32x2_t ms = ((const PG8_LAS f32x2_t*)tb)[pslot + ai * HALF + wr * 64 + m * 16 + fr]; mu = ms.x; rs = ms.y; }
                float ssum = 0.f, ssq = 0.f;
#pragma unroll
                for (int bj = 0; bj < 2; ++bj) { f32x4 v0 = acc[ai][bj][m][0], v1 = acc[ai][bj][m][1];
                    if (FOLD && MODE != 2) { v0 = (v0 - mu * cv[bj][0]) * rs + bv[bj][0]; v1 = (v1 - mu * cv[bj][1]) * rs + bv[bj][1]; }
                    if (MODE == 0) { v0 = v0 * sc; v1 = v1 * sc; }
                    if (MODE == 1) { v0 = __builtin_elementwise_max(v0, (f32x4){0.f, 0.f, 0.f, 0.f}); v1 = __builtin_elementwise_max(v1, (f32x4){0.f, 0.f, 0.f, 0.f}); v0 = v0 * v0; v1 = v1 * v1; }
                    if (MODE == 2) { const bf16x8 r = rr[m][bj];
                        f32x4 h0 = (f32x4){(float)r[0], (float)r[1], (float)r[2], (float)r[3]}, h1 = (f32x4){(float)r[4], (float)r[5], (float)r[6], (float)r[7]};
                        if (FOLD) { h0 = (h0 - mu) * rs * cv[bj][0] + bv[bj][0]; h1 = (h1 - mu) * rs * cv[bj][1] + bv[bj][1]; }
                        v0 = v0 + alpha * h0; v1 = v1 + alpha * h1;
                        ssum += (v0[0] + v0[1]) + (v0[2] + v0[3]) + (v1[0] + v1[1]) + (v1[2] + v1[3]);
                        ssq += (v0[0] * v0[0] + v0[1] * v0[1]) + (v0[2] * v0[2] + v0[3] * v0[3]) + (v1[0] * v1[0] + v1[1] * v1[1]) + (v1[2] * v1[2] + v1[3] * v1[3]); }
                    u32x4 w; w.x = pk2h(v0[0], v0[1]); w.y = pk2h(v0[2], v0[3]); w.z = pk2h(v1[0], v1[1]); w.w = pk2h(v1[2], v1[3]);
                    if (MODE == 0 && hm) { const int cc = col0 + bj * HALF; *(u32x4*)(base + ((size_t)(row >> 11) * 16 + (cc >> 6)) * 131072 + (size_t)(row & 2047) * 64 + (cc & 63)) = w; }
                    else *(u32x4*)(base + off + bj * HALF) = w; }
                if (MODE == 2) { ssum += __shfl_xor(ssum, 16); ssq += __shfl_xor(ssq, 16); ssum += __shfl_xor(ssum, 32); ssq += __shfl_xor(ssq, 32);
                    if (fq == 0) part[(size_t)(row0 + ai * HALF + m * 16) * 16 + u.pn * 4 + wc] = (f32x2_t){ssum, ssq}; } }
        }
    }
};

template <class Epi, class Sched, bool ALIGN_EPI = false, bool SP2 = false>
__device__ __forceinline__ void gemm_phase(PG8_LAS unsigned char* lds, const Gemm g, const Sched& S, const Epi& E) {
    int tid_ = mk_tid(); asm volatile("" : "+v"(tid_));
    const int tid = tid_, wid = __builtin_amdgcn_readfirstlane(tid >> 6), lane = tid & 63, wr = wid >> 2, wc = wid & 3, fr = lane & 15, fq = lane >> 4;
    const int K = g.K, nt = K / BK;
    unsigned voffA[2], voffB[2];
#pragma unroll
    for (int i = 0; i < 2; ++i) { int R, C; stage_rc(tid * 16 + i * 8192, R, C); const int Rb = Epi::PERM ? ((R & ~31) + perm32(R & 31)) : R;
        voffA[i] = (unsigned)(R * K + C) * 2u; voffB[i] = (unsigned)(Rb * K + C) * 2u; }
    const size_t kstep = (size_t)(BK * 2);
    const size_t hstep = (size_t)HALF * K * 2;
    const size_t tstep = 2 * hstep;
    const unsigned ldsw = (unsigned)wid * 1024u;
    const int aoff = lds_byte(wr * 64 + fr, fq * 8), boff = lds_byte(wc * 32 + fr, fq * 8);
#define PG8_SA(b, h) (((b) * 2 + (h)) * HTB)
#define PG8_SB(b, h) ((4 + (b) * 2 + (h)) * HTB)
#define PG8_STAGE(bufoff, gbase, voff) do { _Pragma("unroll") for (int _i = 0; _i < 2; ++_i) \
        __builtin_amdgcn_global_load_lds((const unsigned*)((const char*)(gbase) + (voff)[_i]), (PG8_LAS unsigned*)(lds + (bufoff) + ldsw + _i * 8192), 16, 0, 0); } while (0)
#define PG8_LDA(dst, b, h) do { _Pragma("unroll") for (int m = 0; m < 4; ++m) _Pragma("unroll") for (int k = 0; k < 2; ++k) dst[m][k] = *(const PG8_LAS bf16x8*)(lds + PG8_SA(b, h) + aoff + m * 2048 + k * 1024); } while (0)
#define PG8_LDB(dst, b, h) do { _Pragma("unroll") for (int n = 0; n < 2; ++n) _Pragma("unroll") for (int k = 0; k < 2; ++k) dst[n][k] = *(const PG8_LAS bf16x8*)(lds + PG8_SB(b, h) + boff + n * 2048 + k * 1024); } while (0)
#define PG8_MMA(ai, bj, At, Bt) do { __builtin_amdgcn_s_setprio(1); _Pragma("unroll") for (int m = 0; m < 4; ++m) _Pragma("unroll") for (int n = 0; n < 2; ++n) _Pragma("unroll") for (int k = 0; k < 2; ++k) \
        acc[ai][bj][m][n] = __builtin_amdgcn_mfma_f32_16x16x32_f16(Bt[n][k], At[m][k], acc[ai][bj][m][n], 0, 0, 0); __builtin_amdgcn_s_setprio(0); } while (0)
#define PG8_WAIT_V(n) asm volatile("s_waitcnt vmcnt(" #n ")" ::: "memory")
#define PG8_WAIT_L(n) asm volatile("s_waitcnt lgkmcnt(" #n ")" ::: "memory")
#define PG8_BAR __builtin_amdgcn_s_barrier()
#define PG8_SCHED __builtin_amdgcn_sched_barrier(0)
    Unit cur, nxt; int ui = 0;
    if (!S.next(0, cur)) return;
    f32x4 acc[2][2][4][2];
#pragma unroll
    for (int a = 0; a < 2; ++a)
#pragma unroll
        for (int b = 0; b < 2; ++b)
#pragma unroll
            for (int m = 0; m < 4; ++m)
#pragma unroll
                for (int n = 0; n < 2; ++n) acc[a][b][m][n] = (f32x4){0.f, 0.f, 0.f, 0.f};
    bf16x8 At[4][2], B0[2][2], B1[2][2];
    const char* cA = (const char*)g.A + (size_t)cur.pm * tstep; const char* cB = (const char*)g.Bt + (size_t)cur.pn * tstep;
    S.a_ready(cur);
    if constexpr (SP2) {
        PG8_STAGE(PG8_SB(0, 0), cB, voffB); PG8_STAGE(PG8_SB(0, 1), cB + hstep, voffB); PG8_STAGE(PG8_SA(0, 0), cA, voffA); PG8_STAGE(PG8_SA(0, 1), cA + hstep, voffA);
        if (wr == 1) PG8_BAR;
        PG8_WAIT_V(2); PG8_BAR;
        PG8_STAGE(PG8_SB(1, 0), cB + kstep, voffB); PG8_STAGE(PG8_SA(1, 0), cA + kstep, voffA); PG8_STAGE(PG8_SB(1, 1), cB + hstep + kstep, voffB);
        PG8_WAIT_V(6); PG8_BAR;
    } else {
        PG8_STAGE(PG8_SB(0, 0), cB, voffB); PG8_STAGE(PG8_SA(0, 0), cA, voffA); PG8_STAGE(PG8_SB(0, 1), cB + hstep, voffB); PG8_STAGE(PG8_SA(0, 1), cA + hstep, voffA);
        if (wr == 1) PG8_BAR;
        PG8_WAIT_V(4); PG8_BAR;
        PG8_STAGE(PG8_SB(1, 0), cB + kstep, voffB); PG8_STAGE(PG8_SA(1, 0), cA + kstep, voffA); PG8_STAGE(PG8_SB(1, 1), cB + hstep + kstep, voffB);
        PG8_WAIT_V(6); PG8_BAR;
    }
    for (;;) {
        const bool has_next = S.next(ui + 1, nxt);
        const char* nA = has_next ? (const char*)g.A + (size_t)nxt.pm * tstep : cA; const char* nB = has_next ? (const char*)g.Bt + (size_t)nxt.pn * tstep : cB;
        for (int t = 0; t < nt; t += 2) {
            const bool last = (t == nt - 2);
            const char* a1 = cA + (size_t)(t + 1) * kstep;
            const char* a2 = last ? nA : cA + (size_t)(t + 2) * kstep; const char* b2 = last ? nB : cB + (size_t)(t + 2) * kstep;
            const char* a3 = a2 + kstep; const char* b3 = b2 + kstep;
            if (last && has_next) S.a_ready(nxt);
            if constexpr (SP2) {
            PG8_LDB(B0, 0, 0); PG8_LDB(B1, 0, 1); PG8_SCHED; PG8_LDA(At, 0, 0); PG8_STAGE(PG8_SA(1, 1), a1 + hstep, voffA);
            PG8_WAIT_V(8); PG8_WAIT_L(0); PG8_BAR; PG8_MMA(0, 0, At, B0); PG8_MMA(0, 1, At, B1); PG8_BAR; PG8_SCHED;
            PG8_LDA(At, 0, 1); PG8_STAGE(PG8_SB(0, 0), b2, voffB); PG8_STAGE(PG8_SB(0, 1), b2 + hstep, voffB); PG8_STAGE(PG8_SA(0, 0), a2, voffA);
            PG8_WAIT_V(8); PG8_WAIT_L(0); PG8_BAR; PG8_MMA(1, 0, At, B0); PG8_MMA(1, 1, At, B1); PG8_BAR; PG8_SCHED;
            PG8_LDB(B0, 1, 0); PG8_LDB(B1, 1, 1); PG8_SCHED; PG8_LDA(At, 1, 0); PG8_STAGE(PG8_SA(0, 1), a2 + hstep, voffA);
            PG8_WAIT_V(8); PG8_WAIT_L(0); PG8_BAR; PG8_MMA(0, 0, At, B0); PG8_MMA(0, 1, At, B1); PG8_BAR; PG8_SCHED;
            PG8_LDA(At, 1, 1); PG8_STAGE(PG8_SB(1, 0), b3, voffB); PG8_STAGE(PG8_SB(1, 1), b3 + hstep, voffB); PG8_STAGE(PG8_SA(1, 0), a3, voffA);
            PG8_WAIT_V(8); PG8_WAIT_L(0); PG8_BAR; PG8_MMA(1, 0, At, B0); PG8_MMA(1, 1, At, B1); PG8_BAR; PG8_SCHED;
            } else {
            PG8_LDB(B0, 0, 0); PG8_SCHED; PG8_LDA(At, 0, 0); PG8_STAGE(PG8_SA(1, 1), a1 + hstep, voffA);
            PG8_WAIT_L(8); PG8_BAR; PG8_WAIT_L(0); PG8_MMA(0, 0, At, B0); PG8_BAR; PG8_SCHED;
            PG8_LDB(B1, 0, 1); PG8_STAGE(PG8_SB(0, 0), b2, voffB);
            PG8_BAR; PG8_WAIT_L(0); PG8_MMA(0, 1, At, B1); PG8_BAR;
            PG8_LDA(At, 0, 1); PG8_STAGE(PG8_SA(0, 0), a2, voffA);
            PG8_BAR; PG8_WAIT_L(0); PG8_MMA(1, 0, At, B0); PG8_BAR; PG8_SCHED;
            PG8_STAGE(PG8_SB(0, 1), b2 + hstep, voffB);
            PG8_WAIT_V(6); PG8_BAR; PG8_MMA(1, 1, At, B1); PG8_BAR;
            PG8_LDB(B0, 1, 0); PG8_SCHED; PG8_LDA(At, 1, 0); PG8_STAGE(PG8_SA(0, 1), a2 + hstep, voffA);
            PG8_WAIT_L(8); PG8_BAR; PG8_WAIT_L(0); PG8_MMA(0, 0, At, B0); PG8_BAR; PG8_SCHED;
            PG8_LDB(B1, 1, 1); PG8_STAGE(PG8_SB(1, 0), b3, voffB);
            PG8_BAR; PG8_WAIT_L(0); PG8_MMA(0, 1, At, B1); PG8_BAR;
            PG8_LDA(At, 1, 1); PG8_STAGE(PG8_SA(1, 0), a3, voffA);
            PG8_BAR; PG8_WAIT_L(0); PG8_MMA(1, 0, At, B0); PG8_BAR; PG8_SCHED;
            PG8_STAGE(PG8_SB(1, 1), b3 + hstep, voffB);
            PG8_WAIT_V(6); PG8_BAR; PG8_MMA(1, 1, At, B1); PG8_BAR;
            }
        }
        if constexpr (ALIGN_EPI) { if (wr == 0) PG8_BAR; }
        if constexpr (!Epi::AFTER_DRAIN) { E(acc, cur, ui, wr, wc, fr, fq); S.done(cur); }
        if (!has_next) break;
#pragma unroll
        for (int a = 0; a < 2; ++a)
#pragma unroll
            for (int b = 0; b < 2; ++b)
#pragma unroll
                for (int m = 0; m < 4; ++m)
#pragma unroll
                    for (int n = 0; n < 2; ++n) acc[a][b][m][n] = (f32x4){0.f, 0.f, 0.f, 0.f};
        cur = nxt; cA = nA; cB = nB; ++ui;
        if constexpr (ALIGN_EPI) { if (wr == 1) PG8_BAR; }
    }
    PG8_WAIT_V(0);
    if constexpr (!ALIGN_EPI) { if (wr == 0) PG8_BAR; }
    PG8_BAR;
    if constexpr (Epi::AFTER_DRAIN) { E.fused(acc, cur, wr, wc, fr, fq, lds, wid, lane); S.done(cur); }
#undef PG8_SA
#undef PG8_SB
#undef PG8_STAGE
#undef PG8_LDA
#undef PG8_LDB
#undef PG8_MMA
#undef PG8_WAIT_V
#undef PG8_WAIT_L
#undef PG8_BAR
#undef PG8_SCHED
}
}

#define LAS __attribute__((address_space(3)))
typedef _Float16 h16;
typedef _Float16 h16x8 __attribute__((ext_vector_type(8)));
typedef _Float16 h16x4 __attribute__((ext_vector_type(4)));
typedef _Float16 h16x2 __attribute__((ext_vector_type(2)));
typedef __fp16 fp16x4v __attribute__((__vector_size__(4 * sizeof(__fp16))));
typedef float f32x4 __attribute__((ext_vector_type(4)));
typedef float f32x16 __attribute__((ext_vector_type(16)));
typedef unsigned u32x4 __attribute__((ext_vector_type(4)));
typedef unsigned u32x2 __attribute__((ext_vector_type(2)));

#ifndef REP_MOBA
#define REP_MOBA 1
#endif
#ifndef REP_PRO
#define REP_PRO 1
#endif
#ifndef REP_QKV
#define REP_QKV 1
#endif
#ifndef REP_WO
#define REP_WO 1
#endif
#ifndef REP_UP
#define REP_UP 1
#endif
#ifndef REP_DN
#define REP_DN 1
#endif
#ifndef REP_LN
#define REP_LN 1
#endif
#ifndef REP_SB
#define REP_SB 1
#endif
#ifndef MK_LAUNCHES
#define MK_LAUNCHES 1
#endif
constexpr int NT = 512, M_TOK = 65536, DM = 1024, SEQ = 2048, NH = 16, DH = 64, FF = 4096, NBLK = 8, DEPTH = 2, NPHASE = 17;
constexpr int ST_OFF = pg8::STAGE_BYTES, LDS_BYTES = pg8::STAGE_BYTES + 16 * 256 * 8;
constexpr float LN_EPS = 1e-5f, ALPHA = 1.41421356237309515f  , LOG2E = 1.44269504088896341f, QSCALE = 0.125f * LOG2E;
constexpr float NEG_INF = -__builtin_inff();
constexpr size_t ACT_B = (size_t)M_TOK * DM * 2;
constexpr size_t W_QKV_B = (size_t)3 * DM * DM * 2, W_O_B = (size_t)DM * DM * 2, W_UP_B = (size_t)FF * DM * 2, W_DN_B = (size_t)FF * DM * 2, W_LAYER_B = W_QKV_B + W_O_B + W_UP_B + W_DN_B;
constexpr int NCS = 4096 + 4096 + 3072;
constexpr size_t WS_BAR = 0  , WS_BARST = 16384  , CTL_BYTES = 16384 + 8192  ,
                 WS_W = 32768, WS_CS = WS_W + DEPTH * W_LAYER_B  , WS_CSP = WS_CS + 131072  , WS_ST1 = WS_CSP + (size_t)2 * 1048576,
                 WS_ST2 = WS_ST1 + (size_t)M_TOK * 128  , WS_X16 = WS_ST2 + (size_t)M_TOK * 128, WS_YA = WS_X16 + ACT_B, WS_YB = WS_YA + ACT_B, WS_KM = WS_YB + ACT_B,
                 WS_Q = WS_KM + (size_t)4096 * 64 * 4, WS_K = WS_Q + ACT_B, WS_V = WS_K + ACT_B, WS_O = WS_V + ACT_B,
                 WS_U = WS_Q  , WS_END = WS_Q + 4 * ACT_B;

struct Params { const float *x, *rel_bias, *w_qkv, *w_o, *ln_mix_g, *ln_mix_b, *w_up, *w_down, *ln_ffn_g, *ln_ffn_b; float* out; unsigned char* ws; int ph_lo, ph_hi; };

__device__ __forceinline__ unsigned pk2h(float lo, float hi) { h16x2 v = {(h16)lo, (h16)hi}; return __builtin_bit_cast(unsigned, v); }
__device__ __forceinline__ float ex2(float x) { return __builtin_amdgcn_exp2f(x); }
__device__ __forceinline__ float lg2(float x) { return __builtin_amdgcn_logf(x); }
__device__ __forceinline__ int crow(int i, int hh) { return (i & 3) + 8 * (i >> 2) + 4 * hh; }
#define MFMA32(a, b, c) __builtin_amdgcn_mfma_f32_32x32x16_f16((a), (b), (c), 0, 0, 0)
__device__ __forceinline__ h16x8 pack8(const f32x16& x, const int s) {
    h16x8 r; r[0] = (h16)x[8 * s + 0]; r[1] = (h16)x[8 * s + 1]; r[2] = (h16)x[8 * s + 2]; r[3] = (h16)x[8 * s + 3]; r[4] = (h16)x[8 * s + 4]; r[5] = (h16)x[8 * s + 5]; r[6] = (h16)x[8 * s + 6]; r[7] = (h16)x[8 * s + 7]; return r; }
__device__ __forceinline__ h16x8 tr8(const LAS unsigned char* p_lo, const LAS unsigned char* p_hi) {
    const h16x4 lo = __builtin_bit_cast(h16x4, __builtin_amdgcn_ds_read_tr16_b64_v4f16((LAS fp16x4v*)p_lo));
    const h16x4 hi = __builtin_bit_cast(h16x4, __builtin_amdgcn_ds_read_tr16_b64_v4f16((LAS fp16x4v*)p_hi));
    return __builtin_shufflevector(lo, hi, 0, 1, 2, 3, 4, 5, 6, 7); }

#define XB_TMO      128
#define XB_XCNT(j)  (256  + 64 * (j))
#define XB_XSUB(j)  (1280 + 64 * (j))
#define XB_XGEN(j)  (2304 + 64 * (j))
#define XB_TOP      3328
#define XB_TOPGEN   3392
#define XCD_BAR_WORDS 3456
#define XB_SPIN_CAP (1u << 18)

__device__ __forceinline__ unsigned xb_ld(unsigned* p)              { return __hip_atomic_load(p, __ATOMIC_RELAXED, __HIP_MEMORY_SCOPE_AGENT); }
__device__ __forceinline__ unsigned xb_add(unsigned* p, unsigned v) { return __hip_atomic_fetch_add(p, v, __ATOMIC_RELAXED, __HIP_MEMORY_SCOPE_AGENT); }
__device__ __forceinline__ unsigned xb_xcc_id() { return (unsigned)__builtin_amdgcn_s_getreg((3 << 11) | 20) & 0xFu; }
#define XB_SPIN(cond, bar) do { unsigned _sp = 0; while (cond) { __builtin_amdgcn_s_sleep(1); \
    if ((++_sp & 255u) == 0u) { if (xb_ld(&(bar)[XB_TMO])) break; if (_sp > XB_SPIN_CAP) { atomicAdd(&(bar)[XB_TMO], 1u); break; } } } } while (0)

struct XcdBarrier {
    unsigned* bar; unsigned x;
    volatile unsigned* st;
};

__device__ __forceinline__ XcdBarrier xcd_barrier_post(unsigned* bar, volatile unsigned* st) {
    XcdBarrier b; b.bar = bar; b.x = xb_xcc_id(); b.st = st;
    if (mk_tid() == 0) (void)xb_add(&bar[XB_XCNT(b.x)], 1u);
    return b;
}
__device__ __forceinline__ void xcd_barrier_complete(unsigned* bar, unsigned x, unsigned& nloc, unsigned& nx) {
    const unsigned G = gridDim.x * gridDim.y * gridDim.z;
    unsigned sum, cnt, mine, sp = 0u;
    for (;;) {
        sum = 0u; cnt = 0u; mine = 0u;
#pragma unroll
        for (unsigned j = 0; j < 16; ++j) { const unsigned c = xb_ld(&bar[XB_XCNT(j)]); sum += c; cnt += (c > 0u) ? 1u : 0u; mine = (j == x) ? c : mine; }
        if (sum == G) break;
        __builtin_amdgcn_s_sleep(1);
        if ((++sp & 255u) == 0u) { if (xb_ld(&bar[XB_TMO])) break; if (sp > XB_SPIN_CAP) { atomicAdd(&bar[XB_TMO], 1u); break; } }
    }
    nloc = mine > 0u ? mine : 1u; nx = cnt > 0u ? cnt : 1u;
}

__device__ __forceinline__ void xcd_barrier(const XcdBarrier& b) {
    asm volatile("s_waitcnt vmcnt(0)" ::: "memory");
    __syncthreads();
    if (mk_tid() == 0) {
        unsigned* bar = b.bar;
        __builtin_amdgcn_s_waitcnt(0);
        unsigned nloc = b.st[0], nx = b.st[1];
        if (nloc == 0u) { xcd_barrier_complete(bar, b.x, nloc, nx); b.st[0] = nloc; b.st[1] = nx; }
        const unsigned old = xb_add(&bar[XB_XSUB(b.x)], 1u);
        const unsigned gen = old / nloc;
        if (old + 1u == (gen + 1u) * nloc) {
            __builtin_amdgcn_fence(__ATOMIC_RELEASE, "agent");
            asm volatile("s_waitcnt vmcnt(0)" ::: "memory");
            const unsigned og = xb_add(&bar[XB_TOP], 1u);
            const unsigned tg = og / nx;
            if (og + 1u == (tg + 1u) * nx) xb_add(&bar[XB_TOPGEN], 1u);
            else XB_SPIN(xb_ld(&bar[XB_TOPGEN]) == tg, bar);
            __builtin_amdgcn_fence(__ATOMIC_ACQUIRE, "agent");
            xb_add(&bar[XB_XGEN(b.x)], 1u);
            asm volatile("s_waitcnt vmcnt(0)" ::: "memory");
        } else {
            XB_SPIN(xb_ld(&bar[XB_XGEN(b.x)]) == gen, bar);
            __builtin_amdgcn_fence(__ATOMIC_ACQUIRE, "agent");
            asm volatile("s_waitcnt vmcnt(0)" ::: "memory");
        }
    }
    __syncthreads();
}

__device__ __forceinline__ void p_prologue(const Params& P, LAS unsigned char* lds) {
    int tid_ = mk_tid(); asm volatile("" : "+v"(tid_)); const int tid = tid_, G = gridDim.x, c = blockIdx.x;
    { h16* Hh = (h16*)(P.ws + WS_X16); const size_t nvec = (size_t)M_TOK * DM / 8;
      for (size_t v = (size_t)c * NT + tid; v < nvec; v += (size_t)G * NT) {
          const f32x4 a = __builtin_nontemporal_load((const f32x4*)P.x + 2 * v), b = __builtin_nontemporal_load((const f32x4*)P.x + 2 * v + 1);
          u32x4 w; w.x = pk2h(a[0], a[1]); w.y = pk2h(a[2], a[3]); w.z = pk2h(b[0], b[1]); w.w = pk2h(b[2], b[3]); ((u32x4*)Hh)[v] = w; } }
    LAS float* tile = (LAS float*)lds;
    float* csp = (float*)(P.ws + WS_CSP);
    for (int t = c; t < DEPTH * 3072; t += G) {
        const int l = t / 3072, r = t % 3072; const float* src; h16* dst; int K, N, tl; unsigned char* wl = P.ws + WS_W + (size_t)l * W_LAYER_B;
        const float* gv = nullptr; const float* bv = nullptr; int csoff = 0;
        if (r < 768)       { src = P.w_qkv  + (size_t)l * DM * 3 * DM; dst = (h16*)wl;                               K = DM; N = 3 * DM; tl = r; if (l > 0) { gv = P.ln_ffn_g + (l - 1) * DM; bv = P.ln_ffn_b + (l - 1) * DM; csoff = 8192; } }
        else if (r < 1024) { src = P.w_o    + (size_t)l * DM * DM;     dst = (h16*)(wl + W_QKV_B);                   K = DM; N = DM;     tl = r - 768; }
        else if (r < 2048) { src = P.w_up   + (size_t)l * DM * FF;     dst = (h16*)(wl + W_QKV_B + W_O_B);           K = DM; N = FF;     tl = r - 1024; gv = P.ln_mix_g + l * DM; bv = P.ln_mix_b + l * DM; csoff = l * 4096; }
        else               { src = P.w_down + (size_t)l * FF * DM;     dst = (h16*)(wl + W_QKV_B + W_O_B + W_UP_B);  K = FF; N = DM;     tl = r - 2048; }
        const int ntn = N / 64, k0 = (tl / ntn) * 64, n0 = (tl % ntn) * 64;
        { const int n = tid & 63, kb = tid >> 6;
#pragma unroll
          for (int i = 0; i < 8; ++i) { const int k = kb + 8 * i; tile[k * 65 + n] = __builtin_nontemporal_load(src + (size_t)(k0 + k) * N + n0 + n); } }
        __syncthreads();
        { const int k2 = (tid & 31) * 2, nb = tid >> 5; const float g0 = gv ? gv[k0 + k2] : 1.f, g1 = gv ? gv[k0 + k2 + 1] : 1.f;
#pragma unroll
          for (int i = 0; i < 4; ++i) { const int n = nb + 16 * i; const h16x2 v = {(h16)(tile[k2 * 65 + n] * g0), (h16)(tile[(k2 + 1) * 65 + n] * g1)}; *(h16x2*)(dst + (size_t)(n0 + n) * K + k0 + k2) = v; } }
        if (gv && tid < 64) { float sa = 0.f, sb = 0.f;
            for (int k = 0; k < 64; ++k) { const float wv = tile[k * 65 + tid]; sa += (float)(h16)(wv * gv[k0 + k]); sb += wv * bv[k0 + k]; }
            csp[(size_t)((k0 >> 6) * 2 + 0) * NCS + csoff + n0 + tid] = sa; csp[(size_t)((k0 >> 6) * 2 + 1) * NCS + csoff + n0 + tid] = sb; }
        __syncthreads();
    }
}

__device__ __forceinline__ void p_cs_finalize(const Params& P) {
    const float* csp = (const float*)(P.ws + WS_CSP); float* cs = (float*)(P.ws + WS_CS);
    int tid_ = mk_tid(); asm volatile("" : "+v"(tid_));
    for (int i = blockIdx.x * 88 + tid_; tid_ < 88 && i < 2 * NCS; i += gridDim.x * 88) {     const int v = i / NCS, cidx = i % NCS; float a = 0.f;
        float pv_[16];
#pragma unroll
        for (int kt = 0; kt < 16; ++kt) pv_[kt] = csp[(size_t)(kt * 2 + v) * NCS + cidx];
#pragma unroll
        for (int kt = 0; kt < 16; ++kt) a += pv_[kt];
        cs[i] = a; }
}

template <class Sched> __device__ __forceinline__ void p_fill_tables(LAS unsigned char* lds, const float* part, const Sched& S, const float* cvec, const float* bvec) {
    int tid_ = mk_tid(); asm volatile("" : "+v"(tid_)); const int tid = tid_;
    LAS unsigned char* tb = lds + ST_OFF; LAS pg8::f32x2_t* st = (LAS pg8::f32x2_t*)tb; LAS float* csl = (LAS float*)(tb + 8192); LAS float* bwl = (LAS float*)(tb + 12288); LAS int* sl = (LAS int*)(tb + 16384);
    if (tid < 16) { pg8::Unit u; const bool ok = S.next(tid, u); sl[48 + tid] = ok ? u.pm : -1; sl[64 + tid] = ok ? u.pn : -1; }
    __syncthreads();
    int fpm = 0, fpn = 0;
    if (tid < 16) { const int pm = sl[48 + tid], pn = sl[64 + tid]; fpm = tid; fpn = tid;
        for (int j = tid - 1; j >= 0; --j) { if (sl[48 + j] == pm) fpm = j; if (sl[64 + j] == pn) fpn = j; }
        sl[80 + tid] = (fpm == tid && pm >= 0) ? 1 : 0; sl[96 + tid] = (fpn == tid && pn >= 0) ? 1 : 0; }
    __syncthreads();
    if (tid < 16) { int ps = 0, cs_ = 0;
        for (int j = 0; j < fpm; ++j) ps += sl[80 + j];
        for (int j = 0; j < fpn; ++j) cs_ += sl[96 + j];
        ps = ps < 3 ? ps : 3; cs_ = cs_ < 3 ? cs_ : 3;
        sl[tid] = ps; sl[16 + tid] = cs_;
        if (fpm == tid && sl[48 + tid] >= 0) sl[32 + ps] = sl[48 + tid];
        if (fpn == tid && sl[64 + tid] >= 0) sl[36 + cs_] = sl[64 + tid];
        if (tid == 0) { int a = 0, b = 0; for (int j = 0; j < 16; ++j) { a += sl[80 + j]; b += sl[96 + j]; } sl[40] = a < 4 ? a : 4; sl[41] = b < 4 ? b : 4; } }
    __syncthreads();
    const int npm = sl[40], npn = sl[41];
    f32x4 pr[2][8]; float cvl[4];
#pragma unroll
    for (int jj = 0; jj < 2; ++jj) { const int j = (tid >> 8) + 2 * jj; const int pm = sl[32 + (j < npm ? j : 0)];
        const f32x4* pp = (const f32x4*)(part + (size_t)(pm * 256 + (tid & 255)) * 32);
#pragma unroll
        for (int x = 0; x < 8; ++x) pr[jj][x] = pp[x]; }
#pragma unroll
    for (int j = 0; j < 4; ++j) { const int pn = sl[36 + (j < npn ? j : 0)]; cvl[j] = (tid < 256) ? cvec[pn * 256 + tid] : bvec[pn * 256 + tid - 256]; }
#pragma unroll
    for (int jj = 0; jj < 2; ++jj) { const int j = (tid >> 8) + 2 * jj; if (j < npm) { float sa = 0.f, sq = 0.f;
#pragma unroll
            for (int x = 0; x < 8; ++x) { sa += pr[jj][x][0] + pr[jj][x][2]; sq += pr[jj][x][1] + pr[jj][x][3]; }
            const float mean = sa * (1.0f / 1024.0f), var = sq * (1.0f / 1024.0f) - mean * mean;
            st[j * 256 + (tid & 255)] = (pg8::f32x2_t){mean, 1.0f / sqrtf(var + LN_EPS)}; } }
#pragma unroll
    for (int j = 0; j < 4; ++j) if (j < npn) { if (tid < 256) csl[j * 256 + tid] = cvl[j]; else bwl[j * 256 + tid - 256] = cvl[j]; }
    __syncthreads();
}

__device__ __forceinline__ void p_kmean(const Params& P) {
    const h16* Kb = (const h16*)(P.ws + WS_K); float* KM = (float*)(P.ws + WS_KM);
    int tid_ = mk_tid(); asm volatile("" : "+v"(tid_)); const int lane = tid_ & 63, w = tid_ >> 6, sub = lane & 7, rr = lane >> 3;
    for (int it = blockIdx.x * 8 + w; it < 4096; it += gridDim.x * 8) {
        const int bh = it >> 3, n = it & 7, b = bh >> 4, h = bh & 15;
        const h16* p = Kb + ((size_t)bh * SEQ + n * 256 + rr) * DH + sub * 8;
        float a[8];
#pragma unroll
        for (int e = 0; e < 8; ++e) a[e] = 0.f;
#pragma unroll 8
        for (int i = 0; i < 32; ++i) { const h16x8 v = *(const h16x8*)(p + (size_t)i * 8 * DH);
#pragma unroll
            for (int e = 0; e < 8; ++e) a[e] += (float)v[e]; }
#pragma unroll
        for (int e = 0; e < 8; ++e) { a[e] += __shfl_xor(a[e], 8); a[e] += __shfl_xor(a[e], 16); a[e] += __shfl_xor(a[e], 32); a[e] *= (1.0f / 256.0f); }
        if (rr == 0) { float* o = KM + (size_t)it * 64 + sub * 8; *(f32x4*)o = (f32x4){a[0], a[1], a[2], a[3]}; *(f32x4*)(o + 4) = (f32x4){a[4], a[5], a[6], a[7]}; }
    }
}

template <bool FINAL> __device__ __forceinline__ void p_ln(const h16* Y, h16* Ho, float* Fo, const float* g, const float* bt, const float* part) {
    int tid_ = mk_tid(); asm volatile("" : "+v"(tid_)); const int lane = tid_ & 63, w = __builtin_amdgcn_readfirstlane(tid_ >> 6);
    float gg[16], bb[16];
#pragma unroll
    for (int e = 0; e < 8; ++e) { gg[e] = g[8 * lane + e]; gg[8 + e] = g[512 + 8 * lane + e]; bb[e] = bt[8 * lane + e]; bb[8 + e] = bt[512 + 8 * lane + e]; }
    for (int row = blockIdx.x * 8 + w; row < M_TOK; row += gridDim.x * 8) {
        const h16x8 v0 = *(const h16x8*)(Y + (size_t)row * DM + 8 * lane), v1 = *(const h16x8*)(Y + (size_t)row * DM + 512 + 8 * lane);
        const f32x4* pp = (const f32x4*)(part + (size_t)row * 32); float sa = 0.f, sq = 0.f;
#pragma unroll
        for (int k = 0; k < 8; ++k) { const f32x4 v = pp[k]; sa += v[0] + v[2]; sq += v[1] + v[3]; }
        const float mean = sa * (1.0f / 1024.0f), var = sq * (1.0f / 1024.0f) - mean * mean, rstd = 1.0f / sqrtf(var + LN_EPS);
        float x[16];
#pragma unroll
        for (int e = 0; e < 8; ++e) { x[e] = (float)v0[e]; x[8 + e] = (float)v1[e]; }
#pragma unroll
        for (int e = 0; e < 16; ++e) x[e] = (x[e] - mean) * rstd * gg[e] + bb[e];
        if (FINAL) { float* o = Fo + (size_t)row * DM + 8 * lane;
            *(f32x4*)o = (f32x4){x[0], x[1], x[2], x[3]}; *(f32x4*)(o + 4) = (f32x4){x[4], x[5], x[6], x[7]};
            *(f32x4*)(o + 512) = (f32x4){x[8], x[9], x[10], x[11]}; *(f32x4*)(o + 516) = (f32x4){x[12], x[13], x[14], x[15]}; }
        else { h16* o = Ho + (size_t)row * DM + 8 * lane; u32x4 a, b;
            a.x = pk2h(x[0], x[1]); a.y = pk2h(x[2], x[3]); a.z = pk2h(x[4], x[5]); a.w = pk2h(x[6], x[7]);
            b.x = pk2h(x[8], x[9]); b.y = pk2h(x[10], x[11]); b.z = pk2h(x[12], x[13]); b.w = pk2h(x[14], x[15]);
            *(u32x4*)o = a; *(u32x4*)(o + 512) = b; }
    }
}

namespace attn_body {
using bf16=_Float16;
using h16x8v=__attribute__((ext_vector_type(8)))_Float16;
using bf16x8=__attribute__((ext_vector_type(8)))short;
using s16x4=__attribute__((ext_vector_type(4)))short;
using f32x16=__attribute__((ext_vector_type(16)))float;
using u32x4=__attribute__((ext_vector_type(4)))unsigned;
constexpr int BATCH=32,NHEAD=16,SEQ=2048,D=64,DM=NHEAD*D;
constexpr int NW=8,QBLK=32,QB=QBLK*NW,KVBLK=64,NQB=SEQ/QB;
constexpr int ATTN_PITCH=DM, ATTN_UNIT_ROWS=QB;
__device__ __forceinline__ int crow(int r,int hi){return (r&3)+8*(r>>2)+4*hi;}
#define SBAR() __builtin_amdgcn_sched_barrier(0)
#define MF16(a,b,c,x,y,z) __builtin_amdgcn_mfma_f32_32x32x16_f16(__builtin_bit_cast(h16x8v,(a)),__builtin_bit_cast(h16x8v,(b)),(c),0,0,0)
__device__ __forceinline__ void cmask(f32x16&p0,f32x16&p1,int jb,int qrel,int hi){
  const float NEG=-INFINITY; int kb=64*jb+4*hi;
  #pragma unroll
  for(int r=0;r<16;++r){int kv=kb+(r&3)+8*(r>>2); if(kv>qrel)p0[r]=NEG; if(kv+32>qrel)p1[r]=NEG;}
}

constexpr int NSLOT=3, SLOTB=8192;
constexpr int LDS_K=0, LDS_V=NSLOT*SLOTB, LDS_WS=2*NSLOT*SLOTB, LDS_OST=LDS_WS+NW*64*4, LDS_BYTES=LDS_OST+NW*4096;
constexpr int LDS_KM=LDS_BYTES, LDS_BT=LDS_KM+2048, NBT=640, LDS_SEL=LDS_BT+4*NBT*4, LDS_TOTAL=LDS_SEL+NW*2048;
constexpr float C2=0.125f*1.4426950408889634f;
__device__ __forceinline__ void glds16(const void*gsrc,unsigned lds_dst){unsigned keep;
  asm volatile("s_mov_b32 %0, m0\n\ts_mov_b32 m0, %2\n\ts_nop 0\n\tglobal_load_lds_dwordx4 %1, off\n\ts_mov_b32 m0, %0":"=&s"(keep):"v"(gsrc),"s"(lds_dst):"memory");}
__device__ __forceinline__ float max3f(float a,float b,float c){float r;asm("v_max3_f32 %0, %1, %2, %3":"=v"(r):"v"(a),"v"(b),"v"(c));return r;}
__device__ __forceinline__ float max2f(float a,float b){float r;asm("v_max_f32_e32 %0, %1, %2":"=v"(r):"v"(a),"v"(b));return r;}
__device__ __forceinline__ float fadd_s(float a,float b){float r;asm("v_add_f32_e32 %0, %1, %2":"=v"(r):"v"(a),"v"(b));return r;}
__device__ __forceinline__ float fsub_s(float a,float b){float r;asm("v_sub_f32_e32 %0, %1, %2":"=v"(r):"v"(a),"v"(b));return r;}
typedef float f32x2_t __attribute__((ext_vector_type(2))); typedef _Float16 bf16x2_t __attribute__((ext_vector_type(2)));
__device__ __forceinline__ unsigned cvtpk_s(float lo,float hi){f32x2_t v={lo,hi};bf16x2_t b=__builtin_convertvector(v,bf16x2_t);return __builtin_bit_cast(unsigned,b);}
#define WAIT_BAR(N) asm volatile("s_waitcnt vmcnt(" #N ") lgkmcnt(0)\n\ts_barrier":::"memory")

__device__ __forceinline__ void qkt(f32x16&p0,f32x16&p1,const char*Kslot,const bf16x8*qr,const f32x16&negm,int r32,int hi){
  const char*kb=Kslot+hi*1024+r32*16;
  #pragma unroll
  for(int d0=0;d0<4;++d0){
    const bf16x8 b0=*reinterpret_cast<const bf16x8*>(kb+d0*2048);
    const bf16x8 b1=*reinterpret_cast<const bf16x8*>(kb+d0*2048+512);
    if(d0==0){p0=MF16(b0,qr[0],negm,0,0,0);p1=MF16(b1,qr[0],negm,0,0,0);}
    else{p0=MF16(b0,qr[d0],p0,0,0,0);p1=MF16(b1,qr[d0],p1,0,0,0);}}
}
typedef __attribute__((address_space(3))) const char* lds_cptr;
typedef short v4i16_t __attribute__((ext_vector_type(4)));
typedef float f32x4 __attribute__((ext_vector_type(4)));
__device__ __forceinline__ void kload8(bf16x8*kf,lds_cptr kp){
  kf[0]=*(const __attribute__((address_space(3))) bf16x8*)(kp);      kf[1]=*(const __attribute__((address_space(3))) bf16x8*)(kp+512);
  kf[2]=*(const __attribute__((address_space(3))) bf16x8*)(kp+2048); kf[3]=*(const __attribute__((address_space(3))) bf16x8*)(kp+2560);
  kf[4]=*(const __attribute__((address_space(3))) bf16x8*)(kp+4096); kf[5]=*(const __attribute__((address_space(3))) bf16x8*)(kp+4608);
  kf[6]=*(const __attribute__((address_space(3))) bf16x8*)(kp+6144); kf[7]=*(const __attribute__((address_space(3))) bf16x8*)(kp+6656);
}
__device__ __forceinline__ void kload2(bf16x8*kf,lds_cptr kp,int j){ kf[2*j]=*(const __attribute__((address_space(3))) bf16x8*)(kp+j*2048); kf[2*j+1]=*(const __attribute__((address_space(3))) bf16x8*)(kp+j*2048+512); }
__device__ __forceinline__ s16x4 vtr(lds_cptr p){ return __builtin_bit_cast(s16x4,__builtin_amdgcn_ds_read_tr16_b64_v4i16((__attribute__((address_space(3))) v4i16_t*)p)); }
__device__ __forceinline__ float rowmax(const f32x16&p0,const f32x16&p1){
  float a=max3f(p0[0],p0[1],p1[0]),b=max3f(p0[2],p0[3],p1[1]);a=max3f(a,p1[2],p1[3]);
  #pragma unroll
  for(int r=4;r<16;r+=4){a=max3f(a,p0[r],p0[r+1]);b=max3f(b,p0[r+2],p0[r+3]);a=max3f(a,p1[r],p1[r+1]);b=max3f(b,p1[r+2],p1[r+3]);}
  const float m=max2f(a,b);
  auto rr=__builtin_amdgcn_permlane32_swap(__float_as_uint(m),__float_as_uint(m),false,false);
  return max2f(__uint_as_float(rr[0]),__uint_as_float(rr[1]));
}
__device__ __forceinline__ void pv(f32x16*o,int vb,bf16x8 pa0,bf16x8 pa1,bf16x8 pa2,bf16x8 pa3){
  #pragma unroll
  for(int d0=0;d0<2;++d0){s16x4 lo[4],hi[4];
    #pragma unroll
    for(int ks=0;ks<4;++ks){
      asm volatile("ds_read_b64_tr_b16 %0,%1 offset:%c2":"=&v"(lo[ks]):"v"(vb),"i"(d0*4096+ks*1024):"memory");
      asm volatile("ds_read_b64_tr_b16 %0,%1 offset:%c2":"=&v"(hi[ks]):"v"(vb),"i"(d0*4096+ks*1024+512):"memory");}
    asm volatile("s_waitcnt lgkmcnt(0)":::"memory");SBAR();
    #define PK(k) (bf16x8){lo[k][0],lo[k][1],lo[k][2],lo[k][3],hi[k][0],hi[k][1],hi[k][2],hi[k][3]}
    o[d0]=MF16(pa0,PK(0),o[d0],0,0,0);
    o[d0]=MF16(pa1,PK(1),o[d0],0,0,0);
    o[d0]=MF16(pa2,PK(2),o[d0],0,0,0);
    o[d0]=MF16(pa3,PK(3),o[d0],0,0,0);
    #undef PK
  }
}

#ifndef ATTN_STORE16
#define ATTN_STORE16(p,v) (*(u32x4*)(p)=(v))
#endif
template<int THRL> __device__ __forceinline__ void attn_unit(int b,int h,int qb,const bf16*Q,const bf16*__restrict__ K,const bf16*__restrict__ V,bf16*O,char*shm,const float*KMg,const float*rel_bias,bool newhead,bf16x8 (&qr)[4],const bf16*Qnext){
  int tid_=mk_tid(); asm volatile("":"+v"(tid_));
  const int tid=tid_,lane=tid&63,r32=lane&31,hi=lane>>5; const int wid=__builtin_amdgcn_readfirstlane(tid>>6);
  const long rowbase=(long)b*SEQ; const int q0=qb*QB;
  typedef __attribute__((address_space(3))) float* lds_fptr;
  const lds_fptr kml=(lds_fptr)(shm+LDS_KM); const lds_fptr btl=(lds_fptr)(shm+LDS_BT);
  if(newhead){
    {
      const bf16*Kn=K+(long)(b*NHEAD+h)*SEQ*D+(long)(tid>>3)*D+(tid&7)*8; const lds_fptr kpart=(lds_fptr)(shm+LDS_TOTAL);
      h16x8v kv_[32];
      #pragma unroll
      for(int i=0;i<32;++i)kv_[i]=*reinterpret_cast<const h16x8v*>(Kn+(long)i*64*D);
      #pragma unroll
      for(int n=0;n<8;++n){ float a_[8];
        #pragma unroll
        for(int e=0;e<8;++e)a_[e]=((float)kv_[4*n][e]+(float)kv_[4*n+1][e])+((float)kv_[4*n+2][e]+(float)kv_[4*n+3][e]);
        #pragma unroll
        for(int e=0;e<8;++e){ a_[e]+=__shfl_xor(a_[e],8); a_[e]+=__shfl_xor(a_[e],16); a_[e]+=__shfl_xor(a_[e],32); }
        if((lane>>3)==0){
          #pragma unroll
          for(int e=0;e<8;++e)kpart[(wid*8+n)*64+(lane&7)*8+e]=a_[e]; } }
      asm volatile("s_waitcnt vmcnt(0) lgkmcnt(0)\n\ts_barrier":::"memory");
      float t_=0.f;
      #pragma unroll
      for(int w8=0;w8<8;++w8)t_+=kpart[w8*512+tid];
      kml[tid]=t_*(1.0f/256.0f); }
    for(int e=tid;e<4*NBT;e+=NW*64){ const int cpy=e/NBT,i=e%NBT,j=i+cpy; float v=-INFINITY;
      const int dist=(NBT-1-j)-256;
      if(j<NBT&&dist>=0){ int bk=dist; if(dist>=16){ bk=16+(int)(logf((float)dist/16.0f)/logf(8.0f)*16.0f); bk=bk<31?bk:31; } v=(rel_bias[bk*NHEAD+h]-rel_bias[31*NHEAD+h])*1.4426950408889634f; }
      btl[e]=v; }
    asm volatile("s_waitcnt vmcnt(0) lgkmcnt(0)\n\ts_barrier":::"memory"); }
  const bf16*Qw=Q+(rowbase+q0+wid*QBLK)*DM+h*D;
  const bf16*Kh=K+(long)(b*NHEAD+h)*SEQ*D,*Vh=V+(long)(b*NHEAD+h)*SEQ*D;
  const unsigned lds0=(unsigned)(uintptr_t)shm;
  float*wsf=(float*)(shm+LDS_WS)+wid*64;
  const bf16*ksrc=Kh+(long)lane*D+wid*8;
  const bf16*vsrc=Vh+(long)(16*(wid&3)+(lane>>2))*D+(wid>>2)*32+(lane&3)*8;
  const unsigned kdst=lds0+LDS_K+wid*1024, vdst=lds0+LDS_V+wid*1024;
  #define TKT(t) ((t)<4 ? NT-4+(t) : NT-1-(t))
  #define DMA_K(t,slot) glds16(ksrc+(long)(TKT(t))*KVBLK*D,(unsigned)__builtin_amdgcn_readfirstlane(kdst+(slot)))
  #define DMA_V(t,slot) glds16(vsrc+(long)(TKT(t))*KVBLK*D,(unsigned)__builtin_amdgcn_readfirstlane(vdst+(slot)))
  const int vb0=(int)(lds0+LDS_V)+((lane>>4)&1)*32+(lane&3)*8+(4*hi+((lane&15)>>2))*64;
  const char*Kbase=shm+LDS_K; bf16x8 kf[8];
  const lds_cptr shm3=(lds_cptr)shm; const lds_cptr kp0=shm3+LDS_K+hi*1024+r32*16; const lds_cptr vp0=shm3+LDS_V+((lane>>4)&1)*32+(lane&3)*8+(4*hi+((lane&15)>>2))*64;
  const int NT=(q0+QB)/KVBLK;
  DMA_K(0,0);DMA_V(0,0);DMA_K(1,SLOTB);
  unsigned sel=0u;
  if(qb>0){ float g[7];
    #pragma unroll
    for(int n=0;n<7;++n){ float a=0.f;
      if(n<qb){
        #pragma unroll
        for(int d0=0;d0<4;++d0){ const h16x8v qv=__builtin_bit_cast(h16x8v,qr[d0]);
          #pragma unroll
          for(int j=0;j<8;++j)a+=(float)qv[j]*kml[n*64+16*d0+8*hi+j]; } }
      { auto rr=__builtin_amdgcn_permlane32_swap(__float_as_uint(a),__float_as_uint(a),false,false); a=__uint_as_float(rr[0])+__uint_as_float(rr[1]); }
      g[n]=(n<qb)?a:-INFINITY; }
    if(qb<=3)sel=(1u<<qb)-1u;
    else{
      #pragma unroll
      for(int n=0;n<7;++n){ int rank=0;
        #pragma unroll
        for(int m=0;m<7;++m)if(m!=n)rank+=((g[m]>g[n])||(g[m]==g[n]&&m<n))?1:0;
        if(n<qb&&rank<3)sel|=1u<<n; } } }
  const bool mixed=qb>3;
  typedef __attribute__((address_space(3))) unsigned* lds_uptr;
  if(mixed){ *(lds_uptr)(shm3+LDS_SEL+wid*2048+hi*1024+r32*16)=sel; }
  float mhat=0.f,l_reg=0.f;f32x16 o[2];o[0]=f32x16{};o[1]=f32x16{};f32x16 negm=f32x16{};asm volatile("":"+v"(negm));
  const int qrel=wid*QBLK+r32;
  #define CMASK(P0,P1,t) do{ const int t_=(t); const int kt_=TKT(t_); \
    if(t_<6){ const int s_=(NBT-1)-(q0+qrel-64*kt_-4*hi+256), c_=s_&3; const __attribute__((address_space(3))) f32x4* tp_=(const __attribute__((address_space(3))) f32x4*)(shm3+LDS_BT+c_*(NBT*4)+(s_-c_)*4); \
      f32x4 b0_[4],b1_[4]; _Pragma("unroll") for(int g=0;g<4;++g){ b0_[g]=tp_[2*g]; b1_[g]=tp_[2*g+8]; } \
      _Pragma("unroll") for(int g=0;g<4;++g) _Pragma("unroll") for(int e=0;e<4;++e){ P0[4*g+e]+=b0_[g][e]; P1[4*g+e]+=b1_[g][e]; } } \
    if(t_>=4&&mixed){ const unsigned sel_=sel; if(((sel_>>(kt_>>2))&1u)==0u){ _Pragma("unroll") for(int r=0;r<16;++r){P0[r]=-INFINITY;P1[r]=-INFINITY;} } } }while(0)
  bool resc=false;
  #define START(P0,P1) do{ const float rm=rowmax(P0,P1); resc=false; \
    { const float dl=rm; mhat=fadd_s(mhat,dl); \
      _Pragma("unroll") for(int r=0;r<16;++r){P0[r]=fsub_s(P0[r],dl);P1[r]=fsub_s(P1[r],dl);} \
      _Pragma("unroll") for(int r=0;r<16;++r)negm[r]=-mhat; asm volatile("":"+v"(negm)); } \
    _Pragma("unroll") for(int r=0;r<16;++r)P0[r]=__builtin_amdgcn_exp2f(P0[r]); }while(0)
  #define RESC() do{ if(resc){ asm volatile("s_waitcnt lgkmcnt(0)":::"memory"); \
      _Pragma("unroll") for(int d_=0;d_<2;++d_) _Pragma("unroll") for(int r=0;r<16;++r)o[d_][r]*=wsf[crow(r,hi)]; } }while(0)
  f32x16 pA0,pA1,pB0,pB1;
  int sl_prev=0,sl_cur=0,sl_next=SLOTB;
  #define ROT() do{sl_prev=sl_cur;sl_cur=sl_next;sl_next=(sl_next==(NSLOT-1)*SLOTB)?0:sl_next+SLOTB;}while(0)
  DMA_K(2,2*SLOTB);
  WAIT_BAR(3);
  qkt(pA0,pA1,Kbase,qr,negm,r32,hi);asm volatile("s_nop 15\n\ts_nop 7":"+v"(pA0),"+v"(pA1));CMASK(pA0,pA1,0);
  START(pA0,pA1);
  _Pragma("unroll") for(int r=0;r<16;++r)pA1[r]=__builtin_amdgcn_exp2f(pA1[r]);
  WAIT_BAR(0);
  DMA_K(3,0);DMA_V(1,SLOTB);
  ROT();
  kload8(kf,kp0+sl_cur);
  WAIT_BAR(2);
  s16x4 vlo[8],vhi[8]; u32x4 pw0,pw1,pw2,pw3;
  #define PKW(P,B) cvtpk_s(P[B],P[B+1])
  #define PAF(k) __builtin_bit_cast(bf16x8,pw##k)
  #define VFR(i) (bf16x8){vlo[i][0],vlo[i][1],vlo[i][2],vlo[i][3],vhi[i][0],vhi[i][1],vhi[i][2],vhi[i][3]}
  #define PIN(x) asm volatile("":"+v"(x))
  #define MX3(a,b,c) __builtin_fmaxf(__builtin_fmaxf((a),(b)),(c))
  #define GAPA(MF,A0,A1,A2,A3,W0,W1,PW) do{ MF; sacc+=A0; sacc+=A1; sacc+=A2; sacc+=A3; PIN(sacc); W0; W1; PIN(PW); SBAR(); }while(0)
  #define EX(v) __builtin_amdgcn_exp2f(v)
  #define GAPB(MF,X,B) do{ MF; X[B]=EX(X[B]); X[B+1]=EX(X[B+1]); X[B+2]=EX(X[B+2]); X[B+3]=EX(X[B+3]); PIN(X); SBAR(); }while(0)
  #define VRD(i) do{ vlo[i]=vtr(vp_+(((i)>>2)*4096+((i)&3)*1024)); vhi[i]=vtr(vp_+(((i)>>2)*4096+((i)&3)*1024+512)); }while(0)
  #define KRD(G,j) do{ if(G){ kload2(kf,kp0+sl_next,j); SBAR(); } }while(0)
  #define STEP(C0,C1,P0,P1,t,GK,GV,GL) do{ SBAR(); \
    const lds_cptr vp_=vp0+sl_prev; \
    VRD(0); SBAR(); float sacc=(P0[0]+P0[1]); \
    GAPA(C0=MF16(kf[0],qr[0],negm,0,0,0), P0[2],P0[3],P0[4],P0[5],     pw0[0]=PKW(P0,0), pw0[1]=PKW(P0,2), pw0); \
    VRD(4); SBAR(); GAPA(C1=MF16(kf[1],qr[0],negm,0,0,0), P0[6],P0[7],P0[8],P0[9],     pw0[2]=PKW(P0,4), pw0[3]=PKW(P0,6), pw0); \
    VRD(1); SBAR(); GAPA(C0=MF16(kf[2],qr[1],C0,0,0,0),   P0[10],P0[11],P0[12],P0[13], pw1[0]=PKW(P0,8), pw1[1]=PKW(P0,10), pw1); \
    VRD(5); SBAR(); GAPA(C1=MF16(kf[3],qr[1],C1,0,0,0),   P0[14],P0[15],P1[0],P1[1],   pw1[2]=PKW(P0,12),pw1[3]=PKW(P0,14), pw1); \
    VRD(2); SBAR(); GAPA(C0=MF16(kf[4],qr[2],C0,0,0,0),   P1[2],P1[3],P1[4],P1[5],     pw2[0]=PKW(P1,0), pw2[1]=PKW(P1,2), pw2); \
    VRD(6); SBAR(); GAPA(C1=MF16(kf[5],qr[2],C1,0,0,0),   P1[6],P1[7],P1[8],P1[9],     pw2[2]=PKW(P1,4), pw2[3]=PKW(P1,6), pw2); \
    VRD(3); SBAR(); GAPA(C0=MF16(kf[6],qr[3],C0,0,0,0),   P1[10],P1[11],P1[12],P1[13], pw3[0]=PKW(P1,8), pw3[1]=PKW(P1,10), pw3); \
    VRD(7); SBAR(); GAPA(C1=MF16(kf[7],qr[3],C1,0,0,0),   P1[14],P1[15],0.f,0.f,       pw3[2]=PKW(P1,12),pw3[3]=PKW(P1,14), pw3); \
    l_reg+=sacc; \
    if(GK){DMA_K((t)+3,sl_cur);} if(GV){DMA_V((t)+1,sl_next);} \
    CMASK(C0,C1,t); \
    { float a=MX3(C0[0],C0[1],C1[0]),b=MX3(C0[2],C0[3],C1[1]); a=MX3(a,C1[2],C1[3]); \
      _Pragma("unroll") for(int r=4;r<16;r+=4){a=MX3(a,C0[r],C0[r+1]);b=MX3(b,C0[r+2],C0[r+3]);a=MX3(a,C1[r],C1[r+1]);b=MX3(b,C1[r+2],C1[r+3]);} \
      float rm=__builtin_fmaxf(a,b); { auto rr=__builtin_amdgcn_permlane32_swap(__float_as_uint(rm),__float_as_uint(rm),false,false); rm=__builtin_fmaxf(__uint_as_float(rr[0]),__uint_as_float(rr[1])); } \
      resc=false; \
      if(__builtin_expect(__any(rm>(float)THRL),0)){ const float dl=__builtin_fmaxf(rm,0.f); mhat+=dl; \
        _Pragma("unroll") for(int r=0;r<16;++r){C0[r]-=dl;C1[r]-=dl;} \
        _Pragma("unroll") for(int r=0;r<16;++r)negm[r]=-mhat; asm volatile("":"+v"(negm)); \
        const float f=__builtin_amdgcn_exp2f(-dl); l_reg*=f; { int r32o_=r32; asm volatile("":"+v"(r32o_)); if(hi==0)wsf[r32o_]=f; }     resc=true; } } \
    SBAR(); \
    GAPB(o[0]=MF16(PAF(0),VFR(0),o[0],0,0,0), C0,0); \
    GAPB(o[1]=MF16(PAF(0),VFR(4),o[1],0,0,0), C0,4); \
    KRD(GL,0); GAPB(o[0]=MF16(PAF(1),VFR(1),o[0],0,0,0), C0,8); \
    KRD(GL,1); GAPB(o[1]=MF16(PAF(1),VFR(5),o[1],0,0,0), C0,12); \
    KRD(GL,2); GAPB(o[0]=MF16(PAF(2),VFR(2),o[0],0,0,0), C1,0); \
    KRD(GL,3); GAPB(o[1]=MF16(PAF(2),VFR(6),o[1],0,0,0), C1,4); \
    GAPB(o[0]=MF16(PAF(3),VFR(3),o[0],0,0,0), C1,8); \
    GAPB(o[1]=MF16(PAF(3),VFR(7),o[1],0,0,0), C1,12); \
    }while(0)
  int t=1;
  #define ENDW(tt) do{ if((tt)+3<NT){WAIT_BAR(2);} else if((tt)+2<NT){WAIT_BAR(1);} else {WAIT_BAR(0);} }while(0)
  for(;t<7&&t+1<NT;t+=2){
    STEP(pB0,pB1,pA0,pA1,t,(t+3<NT),(t+1<NT),(t+1<NT));       ENDW(t);   RESC(); ROT();
    STEP(pA0,pA1,pB0,pB1,t+1,(t+4<NT),(t+2<NT),(t+2<NT));     ENDW(t+1); RESC(); ROT();
  }
  #pragma push_macro("CMASK")
  #undef CMASK
  #define CMASK(P0,P1,t) do{ if(mixed){ const unsigned sel_=sel; if(((sel_>>(TKT(t)>>2))&1u)==0u){ _Pragma("unroll") for(int r=0;r<16;++r){P0[r]=-INFINITY;P1[r]=-INFINITY;} } } }while(0)
  for(;t+5<NT;t+=2){
    STEP(pB0,pB1,pA0,pA1,t,true,true,true);     WAIT_BAR(2); RESC(); ROT();
    STEP(pA0,pA1,pB0,pB1,t+1,true,true,true);   WAIT_BAR(2); RESC(); ROT();
  }
  #pragma pop_macro("CMASK")
  for(;t+1<NT;t+=2){
    STEP(pB0,pB1,pA0,pA1,t,(t+3<NT),(t+1<NT),(t+1<NT));       ENDW(t);   RESC(); ROT();
    STEP(pA0,pA1,pB0,pB1,t+1,(t+4<NT),(t+2<NT),(t+2<NT));     ENDW(t+1); RESC(); ROT();
  }
  STEP(pB0,pB1,pA0,pA1,NT-1,false,false,false); RESC();
  if(Qnext){
    #pragma unroll
    for(int d0=0;d0<4;++d0)qr[d0]=*reinterpret_cast<const bf16x8*>(&Qnext[(long)(wid*QBLK+r32)*DM+d0*16+hi*8]); }
  { float sacc=pB0[0]+pB0[1]; _Pragma("unroll") for(int r=2;r<16;++r)sacc+=pB0[r]; _Pragma("unroll") for(int r=0;r<16;++r)sacc+=pB1[r]; l_reg+=sacc;
    pw0=(u32x4){PKW(pB0,0),PKW(pB0,2),PKW(pB0,4),PKW(pB0,6)};pw1=(u32x4){PKW(pB0,8),PKW(pB0,10),PKW(pB0,12),PKW(pB0,14)};pw2=(u32x4){PKW(pB1,0),PKW(pB1,2),PKW(pB1,4),PKW(pB1,6)};pw3=(u32x4){PKW(pB1,8),PKW(pB1,10),PKW(pB1,12),PKW(pB1,14)};
    SBAR(); pv(o,vb0+sl_cur,PAF(0),PAF(1),PAF(2),PAF(3)); }
  #undef PKW
  #undef PAF
  #undef VFR
  #undef PIN
  #undef MX3
  #undef GAPA
  #undef GAPB
  #undef EX
  #undef VRD
  #undef KRD
  #undef STEP
  #undef ENDW
  {auto rr=__builtin_amdgcn_permlane32_swap(__float_as_uint(l_reg),__float_as_uint(l_reg),false,false);l_reg=__uint_as_float(rr[0])+__uint_as_float(rr[1]);}
  if(hi==0)wsf[32+r32]=l_reg;asm volatile("s_waitcnt lgkmcnt(0)":::"memory");
  float rli[16];
  #pragma unroll
  for(int r=0;r<16;++r)rli[r]=__builtin_amdgcn_rcpf(wsf[32+crow(r,hi)]);
  bf16*Ow=O+(rowbase+q0+wid*QBLK)*DM+h*D;
  { bf16*stg=(bf16*)(shm+LDS_OST)+wid*2048;
    #pragma unroll
    for(int r=0;r<16;++r){const int orow=crow(r,hi);
      #pragma unroll
      for(int d0=0;d0<2;++d0)stg[orow*64+d0*32+r32]=(bf16)(o[d0][r]*rli[r]);}
    asm volatile("s_waitcnt lgkmcnt(0)":::"memory");
    #pragma unroll
    for(int i=0;i<4;++i){const int row=i*8+(lane>>3),ch=lane&7; const u32x4 v=*(const u32x4*)(stg+row*64+ch*8); ATTN_STORE16(Ow+(long)row*DM+ch*8,v);} }
  asm volatile("s_waitcnt lgkmcnt(0)\n\ts_barrier":::"memory");
  #undef DMA_K
  #undef DMA_V
  #undef CMASK
  #undef START
  #undef RESC
  #undef ROT
}
constexpr int ATTN_LDS_BYTES=LDS_TOTAL;
#undef SBAR
#undef WAIT_BAR
}

constexpr int KP = 144, TILE_B = 64 * KP;
constexpr int A_K = 0, A_V = 2 * TILE_B, A_KM = 4 * TILE_B, A_BT = A_KM + 2048, A_FL = A_BT + 1280, NBT = 320;

#define ATT_COMMON_SETUP \
    int tid_ = mk_tid(); asm volatile("" : "+v"(tid_)); \
    const int tid = tid_, lane = tid & 63, w = __builtin_amdgcn_readfirstlane(tid >> 6), r = lane & 31, hh = lane >> 5; \
    const int srow = tid >> 3, sch = tid & 7; \
    const int i16 = lane & 15, q4 = i16 >> 2, p4 = i16 & 3, blk = (lane >> 4) & 1; \
    const int voff = (4 * hh + q4) * KP + (16 * blk + 4 * p4) * 2; \
    const int koff = r * KP + 16 * hh; \
    const h16* Qb = (const h16*)(P.ws + WS_Q); const h16* Kb = (const h16*)(P.ws + WS_K); const h16* Vb = (const h16*)(P.ws + WS_V); h16* Ob = (h16*)(P.ws + WS_O);

#define ATT_QK(s, kbuf, cinit) do { h16x8 kf_[2][4]; \
        _Pragma("unroll") for (int kb = 0; kb < 2; ++kb) _Pragma("unroll") for (int ks = 0; ks < 4; ++ks) kf_[kb][ks] = *(const LAS h16x8*)((kbuf) + koff + kb * 32 * KP + ks * 32); \
        __builtin_amdgcn_sched_barrier(0); \
        _Pragma("unroll") for (int kb = 0; kb < 2; ++kb) _Pragma("unroll") for (int i = 0; i < 16; ++i) s[kb][i] = (cinit); \
        _Pragma("unroll") for (int ks = 0; ks < 4; ++ks) _Pragma("unroll") for (int kb = 0; kb < 2; ++kb) s[kb] = MFMA32(kf_[kb][ks], qf[ks], s[kb]); } while (0)
#define ATT_QK_ACC(s, kbuf) do { h16x8 kf_[2][4]; \
        _Pragma("unroll") for (int kb = 0; kb < 2; ++kb) _Pragma("unroll") for (int ks = 0; ks < 4; ++ks) kf_[kb][ks] = *(const LAS h16x8*)((kbuf) + koff + kb * 32 * KP + ks * 32); \
        __builtin_amdgcn_sched_barrier(0); \
        _Pragma("unroll") for (int ks = 0; ks < 4; ++ks) _Pragma("unroll") for (int kb = 0; kb < 2; ++kb) s[kb] = MFMA32(kf_[kb][ks], qf[ks], s[kb]); } while (0)
#define ATT_LOADV(vf, vbuf) do { _Pragma("unroll") for (int s4 = 0; s4 < 4; ++s4) _Pragma("unroll") for (int db = 0; db < 2; ++db) { const LAS unsigned char* vp = (vbuf) + voff + 16 * s4 * KP + 64 * db; vf[s4][db] = tr8(vp, vp + 8 * KP); } \
        __builtin_amdgcn_sched_barrier(0); } while (0)
#define ATT_PV(o, s, vf) do { _Pragma("unroll") for (int s4 = 0; s4 < 4; ++s4) { const h16x8 pf = pack8(s[s4 >> 1], s4 & 1); \
        _Pragma("unroll") for (int db = 0; db < 2; ++db) o[db] = MFMA32(vf[s4][db], pf, o[db]); } } while (0)

__device__ __forceinline__ void p_attn_moba(const Params& P, unsigned char* lds_generic) {
    int prev_bh = -1;
    const h16* Qg = (const h16*)(P.ws + WS_Q);
#define MOBA_QBASE(L_) (Qg + ((size_t)((((L_) & 255) + 256 * ((L_) >> 11)) >> 4) * SEQ + 256 * (((L_) >> 8) & 7)) * DM + ((((L_) & 255) + 256 * ((L_) >> 11)) & 15) * DH)
    attn_body::bf16x8 qr[4];
    { int tid_ = mk_tid(); asm volatile("" : "+v"(tid_)); const int lane_ = tid_ & 63, wid_ = tid_ >> 6; const h16* q0p = MOBA_QBASE((int)blockIdx.x) + (size_t)(wid_ * 32 + (lane_ & 31)) * DM + (lane_ >> 5) * 8;
#pragma unroll
      for (int d0 = 0; d0 < 4; ++d0) qr[d0] = *reinterpret_cast<const attn_body::bf16x8*>(q0p + d0 * 16); }
    for (int L = blockIdx.x; L < 4096; L += gridDim.x) {
        const int qb = (L >> 8) & 7, bh = (L & 255) + 256 * (L >> 11), b = bh >> 4, h = bh & 15; const int Ln = L + (int)gridDim.x;
        attn_body::attn_unit<8>(b, h, qb, Qg, (const h16*)(P.ws + WS_K), (const h16*)(P.ws + WS_V), (h16*)(P.ws + WS_O), (char*)lds_generic,
                                (const float*)(P.ws + WS_KM) + (size_t)bh * 512, P.rel_bias, bh != prev_bh, qr, Ln < 4096 ? MOBA_QBASE(Ln) : nullptr);
        prev_bh = bh;
    }
}

__device__ __forceinline__ void p_attn_sb(const Params& P, LAS unsigned char* lds) {
    ATT_COMMON_SETUP
    LAS int* flags = (LAS int*)(lds + A_FL);
    h16x8 uf[2], ones;
#pragma unroll
    for (int ks = 0; ks < 2; ++ks)
#pragma unroll
        for (int jj = 0; jj < 8; ++jj) { const int k = 16 * ks + 8 * (jj >> 2) + 4 * hh + (jj & 3); uf[ks][jj] = (k > r) ? (h16)1.0f : (h16)0.0f; }
#pragma unroll
    for (int jj = 0; jj < 8; ++jj) ones[jj] = (h16)1.0f;
    for (int L = blockIdx.x; L < 4096; L += gridDim.x) {
        const int qb = (L >> 8) & 7, bh = (L & 255) + 256 * (L >> 11), b = bh >> 4, h = bh & 15;
        const size_t tokbase = (size_t)b * SEQ;
        const h16* Kg = Kb + (size_t)bh * SEQ * DH; const h16* Vg = Vb + (size_t)bh * SEQ * DH;
        const int t = 256 * qb + 32 * w + r;
        const int nt = 4 * qb + 4;
        __syncthreads();
        if (tid < 16) flags[tid] = 0;
        { const size_t go = (size_t)(64 * (nt - 1) + srow) * DH + sch * 8; const u32x4 k0 = *(const u32x4*)(Kg + go), v0 = *(const u32x4*)(Vg + go);
          *(LAS u32x4*)(lds + A_K + srow * KP + sch * 16) = k0; *(LAS u32x4*)(lds + A_V + srow * KP + sch * 16) = v0; }
        h16x8 qf[4];
        { const h16* qp = Qb + (tokbase + t) * DM + h * DH + 8 * hh;
#pragma unroll
          for (int ks = 0; ks < 4; ++ks) qf[ks] = *(const h16x8*)(qp + 16 * ks); }
        __syncthreads();
        float carry = 0.f; bool wdone = false; f32x16 o[2];
#pragma unroll
        for (int i = 0; i < 16; ++i) { o[0][i] = 0.f; o[1][i] = 0.f; }
        for (int j = 0; j < nt; ++j) {
            const int kt = nt - 1 - j; const bool more = (j + 1 < nt);
            const size_t go = (size_t)(64 * (more ? kt - 1 : kt) + srow) * DH + sch * 8; const u32x4 kreg = *(const u32x4*)(Kg + go), vreg = *(const u32x4*)(Vg + go);
            const LAS unsigned char* kbuf = lds + A_K + (j & 1) * TILE_B; const LAS unsigned char* vbuf = lds + A_V + (j & 1) * TILE_B;
            const int jo = kt - 4 * qb;
            const bool active = !wdone && (jo < 0 || 2 * jo <= w);
            if (active) {
                f32x16 z[2], lk[2];
                const bool diag = (64 * kt + 63 >= 256 * qb + 32 * w);
                const int sb = 64 * kt;
                if (diag) {
#pragma unroll
                    for (int kb = 0; kb < 2; ++kb)
#pragma unroll
                        for (int i = 0; i < 16; ++i) z[kb][i] = (sb + 32 * kb + crow(i, hh) < t) ? 0.f : -1.0e30f;
                } else {
#pragma unroll
                    for (int i = 0; i < 16; ++i) { z[0][i] = 0.f; z[1][i] = 0.f; } }
                ATT_QK_ACC(z, kbuf);
                h16x8 vf[4][2]; ATT_LOADV(vf, vbuf);
#pragma unroll
                for (int kb = 0; kb < 2; ++kb)
#pragma unroll
                    for (int i = 0; i < 16; ++i) { const float zz = z[kb][i]; const float e = ex2(-fabsf(zz)); lk[kb][i] = -(fmaxf(zz, 0.f) + lg2(1.0f + e)); }
                const h16x8 x00 = pack8(lk[0], 0), x01 = pack8(lk[0], 1), x10 = pack8(lk[1], 0), x11 = pack8(lk[1], 1);
                const float lk00 = lk[0][0], lb00 = z[0][0] + lk00;
#pragma unroll
                for (int i = 0; i < 16; ++i) { z[0][i] += lk[0][i]; z[1][i] += lk[1][i]; }
                z[0][0] = 0.f;
                f32x16 y0 = MFMA32(uf[0], x00, z[0]), y1 = MFMA32(uf[0], x10, z[1]);
                y0 = MFMA32(uf[1], x01, y0); y1 = MFMA32(uf[1], x11, y1); y0 = MFMA32(ones, x10, y0); y0 = MFMA32(ones, x11, y0);
                float tot = y0[0] + lk00;
                { auto rr_ = __builtin_amdgcn_permlane32_swap(__float_as_uint(tot), __float_as_uint(tot), false, false); tot = __uint_as_float(rr_[0]); }
                y0[0] += lb00;
#pragma unroll
                for (int i = 0; i < 16; ++i) { z[0][i] = ex2(y0[i] + carry); z[1][i] = ex2(y1[i] + carry); }
                carry += tot;
                ATT_PV(o, z, vf);
                wdone = (__ballot(carry < -151.0f) == ~0ull);
            }
            if (wdone && lane == 0) flags[(j & 1) * 8 + w] = 1;
            if (more) { *(LAS u32x4*)(lds + A_K + ((j + 1) & 1) * TILE_B + srow * KP + sch * 16) = kreg; *(LAS u32x4*)(lds + A_V + ((j + 1) & 1) * TILE_B + srow * KP + sch * 16) = vreg; }
            __syncthreads();
            const u32x4 fa_ = *(const LAS u32x4*)(flags + (j & 1) * 8), fb_ = *(const LAS u32x4*)(flags + (j & 1) * 8 + 4);
            if ((fa_.x + fa_.y + fa_.z + fa_.w) + (fb_.x + fb_.y + fb_.z + fb_.w) == 8u) break;
        }
        h16* op = Ob + (tokbase + t) * DM + h * DH + 4 * hh;
#pragma unroll
        for (int db = 0; db < 2; ++db)
#pragma unroll
            for (int gq = 0; gq < 4; ++gq) { u32x2 wv; wv.x = pk2h(o[db][4 * gq], o[db][4 * gq + 1]); wv.y = pk2h(o[db][4 * gq + 2], o[db][4 * gq + 3]); *(u32x2*)(op + 32 * db + 8 * gq) = wv; }
    }
}

__global__ void __launch_bounds__(NT) fwd_megakernel(Params P) {
    extern __shared__ __attribute__((aligned(16))) unsigned char lds_raw[];
    LAS unsigned char* lds = (LAS unsigned char*)lds_raw;
    cg::grid_group grid = cg::this_grid();
    { const unsigned hw = (unsigned)__builtin_amdgcn_s_getreg((5 << 11) | 4) & 63u; ((LAS int*)(uintptr_t)MK_WTAB)[hw] = (int)(threadIdx.x >> 6); }
    __syncthreads();
    const int lo = P.ph_lo, hi = P.ph_hi, G = gridDim.x, c = blockIdx.x;
#define RUN(k) (lo <= (k) && (k) < hi)
#define SEAM(k) do { if (RUN(k) && hi - lo > 1) xcd_barrier(bar); } while (0)
    volatile unsigned* st = (volatile unsigned*)(P.ws + WS_BARST) + 4 * blockIdx.x;
    XcdBarrier bar; bar.bar = (unsigned*)(P.ws + WS_BAR); bar.x = 0; bar.st = nullptr;
    if (hi - lo > 1) bar = xcd_barrier_post((unsigned*)(P.ws + WS_BAR), st);
    if (hi < 0) grid.sync();
    h16* Xh = (h16*)(P.ws + WS_X16); h16* Y1 = (h16*)(P.ws + WS_YA); h16* Y2 = (h16*)(P.ws + WS_YB); h16* Qh = (h16*)(P.ws + WS_Q); h16* Oh = (h16*)(P.ws + WS_O); h16* Uh = (h16*)(P.ws + WS_U);
    pg8::f32x2_t* ST1 = (pg8::f32x2_t*)(P.ws + WS_ST1); pg8::f32x2_t* ST2 = (pg8::f32x2_t*)(P.ws + WS_ST2); const float* CS = (const float*)(P.ws + WS_CS); const float* BW = CS + NCS;
    const LAS unsigned char* tbl = lds + ST_OFF;
    if (RUN(0)) p_prologue(P, lds);
    SEAM(0);
#pragma unroll 1
    for (int l = 0; l < DEPTH; ++l) {
        const int pb = 1 + 8 * l; unsigned char* wl = P.ws + WS_W + (size_t)l * W_LAYER_B;
        const h16* Wqkv = (const h16*)wl; const h16* Wo = (const h16*)(wl + W_QKV_B); const h16* Wup = (const h16*)(wl + W_QKV_B + W_O_B); const h16* Wdn = (const h16*)(wl + W_QKV_B + W_O_B + W_UP_B);
        if (RUN(pb + 0)) {
            pg8::StaticOrder S; S.init(M_TOK, 3 * DM, G, c);
            if (l == 0) { pg8::Gemm g{Xh, Wqkv, M_TOK, 3 * DM, DM}; pg8::Epi<0, false> E{Qh, DM, DM, (size_t)(WS_K - WS_Q) / 2, QSCALE, nullptr, 0.f, nullptr, nullptr};
                pg8::gemm_phase<pg8::Epi<0, false>, pg8::StaticOrder, true, true>(lds, g, S, E); }
            else { p_fill_tables(lds, (const float*)ST2, S, CS + 8192, BW + 8192);
                pg8::Gemm g{Y2, Wqkv, M_TOK, 3 * DM, DM}; pg8::Epi<0, true> E{Qh, DM, DM, (size_t)(WS_K - WS_Q) / 2, QSCALE, nullptr, 0.f, tbl, nullptr};
                pg8::gemm_phase<pg8::Epi<0, true>, pg8::StaticOrder, true, true>(lds, g, S, E); } }
        SEAM(pb + 0);
        if (RUN(pb + 2)) { if (l == 0) { p_cs_finalize(P); p_attn_moba(P, lds_raw); } else p_attn_sb(P, lds); }
        SEAM(pb + 2);
        if (RUN(pb + 3)) {
            pg8::Gemm g{Oh, Wo, M_TOK, DM, DM}; pg8::StaticOrder S; S.init(M_TOK, DM, G, c);
            if (l == 0) { pg8::Epi<2, false> E{Y1, DM, 0, 0, 1.f, Xh, ALPHA, nullptr, ST1};
                pg8::gemm_phase<pg8::Epi<2, false>, pg8::StaticOrder, true, true>(lds, g, S, E); }
            else { p_fill_tables(lds, (const float*)ST2, S, P.ln_ffn_g + (l - 1) * DM, P.ln_ffn_b + (l - 1) * DM);
                pg8::Epi<2, true> E{Y1, DM, 0, 0, 1.f, Y2, ALPHA, tbl, ST1};
                pg8::gemm_phase<pg8::Epi<2, true>, pg8::StaticOrder, true, true>(lds, g, S, E); } }
        SEAM(pb + 3);
        if (RUN(pb + 5)) {
            pg8::Gemm g{Y1, Wup, M_TOK, FF, DM}; pg8::StaticOrder S; S.init(M_TOK, FF, G, c);
            p_fill_tables(lds, (const float*)ST1, S, CS + l * 4096, BW + l * 4096);
            pg8::Epi<1, true> E{Uh, FF, 0, 0, 1.f, nullptr, 0.f, tbl, nullptr};
            pg8::gemm_phase<pg8::Epi<1, true>, pg8::StaticOrder, true, true>(lds, g, S, E); }
        SEAM(pb + 5);
        if (RUN(pb + 6)) {
            pg8::Gemm g{Uh, Wdn, M_TOK, DM, FF}; pg8::StaticOrder S; S.init(M_TOK, DM, G, c); S.rev = 1;
            p_fill_tables(lds, (const float*)ST1, S, P.ln_mix_g + l * DM, P.ln_mix_b + l * DM);
            pg8::Epi<2, true> E{Y2, DM, 0, 0, 1.f, Y1, ALPHA, tbl, ST2};
            pg8::gemm_phase<pg8::Epi<2, true>, pg8::StaticOrder, true, true>(lds, g, S, E); }
        if (l + 1 < DEPTH) SEAM(pb + 6);
    }
    if (RUN(NPHASE - 1)) { if (RUN(NPHASE - 2)) xcd_barrier(bar); p_ln<true>(Y2, nullptr, P.out, P.ln_ffn_g + (DEPTH - 1) * DM, P.ln_ffn_b + (DEPTH - 1) * DM, (const float*)ST2); }
#undef RUN
#undef SEAM
}

extern "C" void kernel_launch(void* const* d_in, const int* in_sizes, int n_in, void* d_out, int out_size, void* d_ws, size_t ws_size, hipStream_t stream) {
    static int grid = 0;
    if (grid == 0) {
        if (n_in != 10 || in_sizes[0] != M_TOK * DM || out_size != M_TOK * DM || ws_size < WS_END) { fprintf(stderr, "kernel_launch: unexpected shapes / workspace (%d inputs, x %d, out %d, ws %zu < %zu)\n", n_in, n_in > 0 ? in_sizes[0] : -1, out_size, ws_size, (size_t)WS_END); grid = -1; return; }
        int dev = 0, cus = 0, per_cu = 0;
        (void)hipGetDevice(&dev); (void)hipDeviceGetAttribute(&cus, hipDeviceAttributeMultiprocessorCount, dev);
        if (hipFuncSetAttribute((const void*)fwd_megakernel, hipFuncAttributeMaxDynamicSharedMemorySize, LDS_BYTES) != hipSuccess) { fprintf(stderr, "kernel_launch: hipFuncSetAttribute failed\n"); grid = -1; return; }
        if (hipOccupancyMaxActiveBlocksPerMultiprocessor(&per_cu, (const void*)fwd_megakernel, NT, LDS_BYTES) != hipSuccess || per_cu < 1) { fprintf(stderr, "kernel_launch: occupancy query says %d blocks per CU\n", per_cu); per_cu = 1; }
        (void)hipGetLastError();
        grid = cus > 0 ? cus : 256;
    }
    if (grid < 0) return;
    Params p{};
    p.x = (const float*)d_in[0]; p.rel_bias = (const float*)d_in[1]; p.w_qkv = (const float*)d_in[2]; p.w_o = (const float*)d_in[3]; p.ln_mix_g = (const float*)d_in[4]; p.ln_mix_b = (const float*)d_in[5];
    p.w_up = (const float*)d_in[6]; p.w_down = (const float*)d_in[7]; p.ln_ffn_g = (const float*)d_in[8]; p.ln_ffn_b = (const float*)d_in[9]; p.out = (float*)d_out; p.ws = (unsigned char*)d_ws;
#if MK_LAUNCHES == 1
    p.ph_lo = 0; p.ph_hi = NPHASE;
    if (hipMemsetAsync((char*)d_ws + WS_BAR, 0, CTL_BYTES, stream) != hipSuccess) { fprintf(stderr, "kernel_launch: hipMemsetAsync of the barrier words failed\n"); return; }
    void* args[] = {&p};
    const hipError_t e = hipLaunchCooperativeKernel((const void*)fwd_megakernel, dim3(grid), dim3(NT), args, LDS_BYTES, stream);
    if (e != hipSuccess) fprintf(stderr, "kernel_launch: cooperative launch failed: %s (grid %d)\n", hipGetErrorString(e), grid);
#else
    for (int ph = 0; ph < NPHASE; ++ph) { if (ph == 2 || ph == 10 || ph == 5 || ph == 8 || ph == 13) continue;
        p.ph_lo = ph; p.ph_hi = ph + 1; hipLaunchKernelGGL(fwd_megakernel, dim3(grid), dim3(NT), LDS_BYTES, stream, p); }
#endif
}
```

```cpp
#include <hip/hip_runtime.h>
#include <hip/hip_cooperative_groups.h>
#include <cstdio>
#include <cstdint>
namespace cg = cooperative_groups;
constexpr unsigned MK_WTAB = 131072u + 20480u;
__device__ __forceinline__ int mk_tid() {
    const unsigned hw = (unsigned)__builtin_amdgcn_s_getreg((5 << 11) | 4) & 63u;
    const int wave = ((const __attribute__((address_space(3))) int*)(uintptr_t)MK_WTAB)[hw];
    int lane; asm volatile("v_mbcnt_lo_u32_b32 %0, -1, 0\n\tv_mbcnt_hi_u32_b32 %0, -1, %0" : "=v"(lane));
    return __builtin_amdgcn_readfirstlane(wave) * 64 + lane;
}
namespace pg8 {
#define PG8_LAS __attribute__((address_space(3)))
typedef _Float16 bf16_t;
typedef _Float16 bf16x8 __attribute__((ext_vector_type(8)));
typedef float f32x4 __attribute__((ext_vector_type(4)));
typedef unsigned u32x4 __attribute__((ext_vector_type(4)));
constexpr int BM = 256, BK = 64, HALF = 128, HTB = HALF * BK * 2  , STAGE_BYTES = 8 * HTB, NXCD = 8, WGM = 8;

__host__ __device__ __forceinline__ int lds_byte(int r, int c) { const int st = (r >> 4) * 2 + (c >> 5), rr = r & 15, cc = c & 31, ob = rr * 64 + cc * 2; return st * 1024 + (ob ^ (((ob >> 9) & 1) << 5)); }
__host__ __device__ __forceinline__ void stage_rc(int b, int& R, int& C) { const int st = b / 1024, sb = b % 1024, swz = sb ^ (((sb >> 9) & 1) << 5); R = (st >> 1) * 16 + swz / 64; C = (st & 1) * 32 + (swz % 64) / 2; }
__host__ __device__ __forceinline__ int perm32(int rho) { const int n = rho >> 4, i = rho & 15; return 8 * (i >> 2) + 4 * n + (i & 3); }

struct Unit { int pm, pn; };
struct Gemm { const bf16_t* A; const bf16_t* Bt; int M, N, K; };

struct StaticOrder {
    int nM, nN, nwg, G, c, rev;
    __host__ __device__ void init(int M, int N, int G_, int c_) { nM = M / BM; nN = N / BM; nwg = nM * nN; G = G_; c = c_; rev = 0; }
    __host__ __device__ bool next(int i, Unit& u) const {
        const long L = (long)i * G + c; if (L >= nwg) return false;
        int wgid = (int)L; { const int q = nwg / NXCD, r = nwg % NXCD, xcd = wgid % NXCD, off = wgid / NXCD; wgid = (xcd < r ? xcd * (q + 1) : r * (q + 1) + (xcd - r) * q) + off; }
        const int nig = WGM * nN, gid = wgid / nig, fm = gid * WGM, gsz = (nM - fm) < WGM ? (nM - fm) : WGM;
        u.pm = fm + ((wgid % nig) % gsz); u.pn = (wgid % nig) / gsz; if (rev) u.pm = nM - 1 - u.pm; return true;
    }
    __device__ __forceinline__ void a_ready(const Unit&) const {}
    __device__ __forceinline__ void done(const Unit&) const {}
};


typedef _Float16 h16x2_t __attribute__((ext_vector_type(2)));
__device__ __forceinline__ unsigned pk2h(float lo, float hi) { h16x2_t v = {(_Float16)lo, (_Float16)hi}; return __builtin_bit_cast(unsigned, v); }
typedef float f32x2_t __attribute__((ext_vector_type(2)));
template <int MODE, bool FOLD> struct Epi {
    static constexpr bool PERM = true, AFTER_DRAIN = false;
    bf16_t* O; int ldc; int split_cols; size_t split_stride; float scale0; const bf16_t* R; float alpha;
    const PG8_LAS unsigned char* tb; f32x2_t* part;
    __device__ __forceinline__ void operator()(const f32x4 (&acc)[2][2][4][2], const Unit& u, int ui, int wr, int wc, int fr, int fq) const {
        const int row0 = u.pm * BM + wr * 64 + fr; int colt = u.pn * BM; bf16_t* base = O;
        float sc = 1.f; bool hm = false;
        if (MODE == 0 && split_cols) { const int t = colt / split_cols; base += (size_t)t * split_stride; colt -= t * split_cols; if (t == 0) sc = scale0; else hm = true; }
        const int col0 = colt + wc * 32 + 8 * fq;
        f32x4 cv[2][2], bv[2][2]; int pslot = 0;
        if (FOLD) { const PG8_LAS int* sl = (const PG8_LAS int*)(tb + 16384); pslot = sl[ui] * 256; const int cslot = sl[16 + ui] * 256 + wc * 32 + 8 * fq;
            const PG8_LAS float* csl = (const PG8_LAS float*)(tb + 8192); const PG8_LAS float* bwl = (const PG8_LAS float*)(tb + 12288);
#pragma unroll
            for (int bj = 0; bj < 2; ++bj)
#pragma unroll
                for (int n = 0; n < 2; ++n) { cv[bj][n] = *(const PG8_LAS f32x4*)(csl + cslot + bj * HALF + 4 * n); bv[bj][n] = *(const PG8_LAS f32x4*)(bwl + cslot + bj * HALF + 4 * n); } }
#pragma unroll
        for (int ai = 0; ai < 2; ++ai) {
        bf16x8 rr[4][2];
        if (MODE == 2) {
#pragma unroll
            for (int m = 0; m < 4; ++m)
#pragma unroll
                for (int bj = 0; bj < 2; ++bj) rr[m][bj] = *(const bf16x8*)(R + (size_t)(row0 + ai * HALF + m * 16) * ldc + col0 + bj * HALF);
            __builtin_amdgcn_sched_barrier(0); }
#pragma unroll
            for (int m = 0; m < 4; ++m) { const int row = row0 + ai * HALF + m * 16; const size_t off = (size_t)row * ldc + col0;
                float mu = 0.f, rs = 1.f; if (FOLD) { const f32x2_t ms = ((const PG8_LAS f32x2_t*)tb)[pslot + ai * HALF + wr * 64 + m * 16 + fr]; mu = ms.x; rs = ms.y; }
                float ssum = 0.f, ssq = 0.f;
#pragma unroll
                for (int bj = 0; bj < 2; ++bj) { f32x4 v0 = acc[ai][bj][m][0], v1 = acc[ai][bj][m][1];
                    if (FOLD && MODE != 2) { v0 = (v0 - mu * cv[bj][0]) * rs + bv[bj][0]; v1 = (v1 - mu * cv[bj][1]) * rs + bv[bj][1]; }
                    if (MODE == 0) { v0 = v0 * sc; v1 = v1 * sc; }
                    if (MODE == 1) { v0 = __builtin_elementwise_max(v0, (f32x4){0.f, 0.f, 0.f, 0.f}); v1 = __builtin_elementwise_max(v1, (f32x4){0.f, 0.f, 0.f, 0.f}); v0 = v0 * v0; v1 = v1 * v1; }
                    if (MODE == 2) { const bf16x8 r = rr[m][bj];
                        f32x4 h0 = (f32x4){(float)r[0], (float)r[1], (float)r[2], (float)r[3]}, h1 = (f32x4){(float)r[4], (float)r[5], (float)r[6], (float)r[7]};
                        if (FOLD) { h0 = (h0 - mu) * rs * cv[bj][0] + bv[bj][0]; h1 = (h1 - mu) * rs * cv[bj][1] + bv[bj][1]; }
                        v0 = v0 + alpha * h0; v1 = v1 + alpha * h1;
                        ssum += (v0[0] + v0[1]) + (v0[2] + v0[3]) + (v1[0] + v1[1]) + (v1[2] + v1[3]);
                        ssq += (v0[0] * v0[0] + v0[1] * v0[1]) + (v0[2] * v0[2] + v0[3] * v0[3]) + (v1[0] * v1[0] + v1[1] * v1[1]) + (v1[2] * v1[2] + v1[3] * v1[3]); }
                    u32x4 w; w.x = pk2h(v0[0], v0[1]); w.y = pk2h(v0[2], v0[3]); w.z = pk2h(v1[0], v1[1]); w.w = pk2h(v1[2], v1[3]);
                    if (MODE == 0 && hm) { const int cc = col0 + bj * HALF; *(u32x4*)(base + ((size_t)(row >> 11) * 16 + (cc >> 6)) * 131072 + (size_t)(row & 2047) * 64 + (cc & 63)) = w; }
                    else *(u32x4*)(base + off + bj * HALF) = w; }
                if (MODE == 2) { ssum += __shfl_xor(ssum, 16); ssq += __shfl_xor(ssq, 16); ssum += __shfl_xor(ssum, 32); ssq += __shfl_xor(ssq, 32);
                    if (fq == 0) part[(size_t)(row0 + ai * HALF + m * 16) * 16 + u.pn * 4 + wc] = (f32x2_t){ssum, ssq}; } }
        }
    }
};

template <class Epi, class Sched, bool ALIGN_EPI = false, bool SP2 = false>
__device__ __forceinline__ void gemm_phase(PG8_LAS unsigned char* lds, const Gemm g, const Sched& S, const Epi& E) {
    int tid_ = mk_tid(); asm volatile("" : "+v"(tid_));
    const int tid = tid_, wid = __builtin_amdgcn_readfirstlane(tid >> 6), lane = tid & 63, wr = wid >> 2, wc = wid & 3, fr = lane & 15, fq = lane >> 4;
    const int K = g.K, nt = K / BK;
    unsigned voffA[2], voffB[2];
#pragma unroll
    for (int i = 0; i < 2; ++i) { int R, C; stage_rc(tid * 16 + i * 8192, R, C); const int Rb = Epi::PERM ? ((R & ~31) + perm32(R & 31)) : R;
        voffA[i] = (unsigned)(R * K + C) * 2u; voffB[i] = (unsigned)(Rb * K + C) * 2u; }
    const size_t kstep = (size_t)(BK * 2);
    const size_t hstep = (size_t)HALF * K * 2;
    const size_t tstep = 2 * hstep;
    const unsigned ldsw = (unsigned)wid * 1024u;
    const int aoff = lds_byte(wr * 64 + fr, fq * 8), boff = lds_byte(wc * 32 + fr, fq * 8);
#define PG8_SA(b, h) (((b) * 2 + (h)) * HTB)
#define PG8_SB(b, h) ((4 + (b) * 2 + (h)) * HTB)
#define PG8_STAGE(bufoff, gbase, voff) do { _Pragma("unroll") for (int _i = 0; _i < 2; ++_i) \
        __builtin_amdgcn_global_load_lds((const unsigned*)((const char*)(gbase) + (voff)[_i]), (PG8_LAS unsigned*)(lds + (bufoff) + ldsw + _i * 8192), 16, 0, 0); } while (0)
#define PG8_LDA(dst, b, h) do { _Pragma("unroll") for (int m = 0; m < 4; ++m) _Pragma("unroll") for (int k = 0; k < 2; ++k) dst[m][k] = *(const PG8_LAS bf16x8*)(lds + PG8_SA(b, h) + aoff + m * 2048 + k * 1024); } while (0)
#define PG8_LDB(dst, b, h) do { _Pragma("unroll") for (int n = 0; n < 2; ++n) _Pragma("unroll") for (int k = 0; k < 2; ++k) dst[n][k] = *(const PG8_LAS bf16x8*)(lds + PG8_SB(b, h) + boff + n * 2048 + k * 1024); } while (0)
#define PG8_MMA(ai, bj, At, Bt) do { __builtin_amdgcn_s_setprio(1); _Pragma("unroll") for (int m = 0; m < 4; ++m) _Pragma("unroll") for (int n = 0; n < 2; ++n) _Pragma("unroll") for (int k = 0; k < 2; ++k) \
        acc[ai][bj][m][n] = __builtin_amdgcn_mfma_f32_16x16x32_f16(Bt[n][k], At[m][k], acc[ai][bj][m][n], 0, 0, 0); __builtin_amdgcn_s_setprio(0); } while (0)
#define PG8_WAIT_V(n) asm volatile("s_waitcnt vmcnt(" #n ")" ::: "memory")
#define PG8_WAIT_L(n) asm volatile("s_waitcnt lgkmcnt(" #n ")" ::: "memory")
#define PG8_BAR __builtin_amdgcn_s_barrier()
#define PG8_SCHED __builtin_amdgcn_sched_barrier(0)
    Unit cur, nxt; int ui = 0;
    if (!S.next(0, cur)) return;
    f32x4 acc[2][2][4][2];
#pragma unroll
    for (int a = 0; a < 2; ++a)
#pragma unroll
        for (int b = 0; b < 2; ++b)
#pragma unroll
            for (int m = 0; m < 4; ++m)
#pragma unroll
                for (int n = 0; n < 2; ++n) acc[a][b][m][n] = (f32x4){0.f, 0.f, 0.f, 0.f};
    bf16x8 At[4][2], B0[2][2], B1[2][2];
    const char* cA = (const char*)g.A + (size_t)cur.pm * tstep; const char* cB = (const char*)g.Bt + (size_t)cur.pn * tstep;
    S.a_ready(cur);
    if constexpr (SP2) {
        PG8_STAGE(PG8_SB(0, 0), cB, voffB); PG8_STAGE(PG8_SB(0, 1), cB + hstep, voffB); PG8_STAGE(PG8_SA(0, 0), cA, voffA); PG8_STAGE(PG8_SA(0, 1), cA + hstep, voffA);
        if (wr == 1) PG8_BAR;
        PG8_WAIT_V(2); PG8_BAR;
        PG8_STAGE(PG8_SB(1, 0), cB + kstep, voffB); PG8_STAGE(PG8_SA(1, 0), cA + kstep, voffA); PG8_STAGE(PG8_SB(1, 1), cB + hstep + kstep, voffB);
        PG8_WAIT_V(6); PG8_BAR;
    } else {
        PG8_STAGE(PG8_SB(0, 0), cB, voffB); PG8_STAGE(PG8_SA(0, 0), cA, voffA); PG8_STAGE(PG8_SB(0, 1), cB + hstep, voffB); PG8_STAGE(PG8_SA(0, 1), cA + hstep, voffA);
        if (wr == 1) PG8_BAR;
        PG8_WAIT_V(4); PG8_BAR;
        PG8_STAGE(PG8_SB(1, 0), cB + kstep, voffB); PG8_STAGE(PG8_SA(1, 0), cA + kstep, voffA); PG8_STAGE(PG8_SB(1, 1), cB + hstep + kstep, voffB);
        PG8_WAIT_V(6); PG8_BAR;
    }
    for (;;) {
        const bool has_next = S.next(ui + 1, nxt);
        const char* nA = has_next ? (const char*)g.A + (size_t)nxt.pm * tstep : cA; const char* nB = has_next ? (const char*)g.Bt + (size_t)nxt.pn * tstep : cB;
        for (int t = 0; t < nt; t += 2) {
            const bool last = (t == nt - 2);
            const char* a1 = cA + (size_t)(t + 1) * kstep;
            const char* a2 = last ? nA : cA + (size_t)(t + 2) * kstep; const char* b2 = last ? nB : cB + (size_t)(t + 2) * kstep;
            const char* a3 = a2 + kstep; const char* b3 = b2 + kstep;
            if (last && has_next) S.a_ready(nxt);
            if constexpr (SP2) {
            PG8_LDB(B0, 0, 0); PG8_LDB(B1, 0, 1); PG8_SCHED; PG8_LDA(At, 0, 0); PG8_STAGE(PG8_SA(1, 1), a1 + hstep, voffA);
            PG8_WAIT_V(8); PG8_WAIT_L(0); PG8_BAR; PG8_MMA(0, 0, At, B0); PG8_MMA(0, 1, At, B1); PG8_BAR; PG8_SCHED;
            PG8_LDA(At, 0, 1); PG8_STAGE(PG8_SB(0, 0), b2, voffB); PG8_STAGE(PG8_SB(0, 1), b2 + hstep, voffB); PG8_STAGE(PG8_SA(0, 0), a2, voffA);
            PG8_WAIT_V(8); PG8_WAIT_L(0); PG8_BAR; PG8_MMA(1, 0, At, B0); PG8_MMA(1, 1, At, B1); PG8_BAR; PG8_SCHED;
            PG8_LDB(B0, 1, 0); PG8_LDB(B1, 1, 1); PG8_SCHED; PG8_LDA(At, 1, 0); PG8_STAGE(PG8_SA(0, 1), a2 + hstep, voffA);
            PG8_WAIT_V(8); PG8_WAIT_L(0); PG8_BAR; PG8_MMA(0, 0, At, B0); PG8_MMA(0, 1, At, B1); PG8_BAR; PG8_SCHED;
            PG8_LDA(At, 1, 1); PG8_STAGE(PG8_SB(1, 0), b3, voffB); PG8_STAGE(PG8_SB(1, 1), b3 + hstep, voffB); PG8_STAGE(PG8_SA(1, 0), a3, voffA);
            PG8_WAIT_V(8); PG8_WAIT_L(0); PG8_BAR; PG8_MMA(1, 0, At, B0); PG8_MMA(1, 1, At, B1); PG8_BAR; PG8_SCHED;
            } else {
            PG8_LDB(B0, 0, 0); PG8_SCHED; PG8_LDA(At, 0, 0); PG8_STAGE(PG8_SA(1, 1), a1 + hstep, voffA);
            PG8_WAIT_L(8); PG8_BAR; PG8_WAIT_L(0); PG8_MMA(0, 0, At, B0); PG8_BAR; PG8_SCHED;
            PG8_LDB(B1, 0, 1); PG8_STAGE(PG8_SB(0, 0), b2, voffB);
            PG8_BAR; PG8_WAIT_L(0); PG8_MMA(0, 1, At, B1); PG8_BAR;
            PG8_LDA(At, 0, 1); PG8_STAGE(PG8_SA(0, 0), a2, voffA);
            PG8_BAR; PG8_WAIT_L(0); PG8_MMA(1, 0, At, B0); PG8_BAR; PG8_SCHED;
            PG8_STAGE(PG8_SB(0, 1), b2 + hstep, voffB);
            PG8_WAIT_V(6); PG8_BAR; PG8_MMA(1, 1, At, B1); PG8_BAR;
            PG8_LDB(B0, 1, 0); PG8_SCHED; PG8_LDA(At, 1, 0); PG8_STAGE(PG8_SA(0, 1), a2 + hstep, voffA);
            PG8_WAIT_L(8); PG8_BAR; PG8_WAIT_L(0); PG8_MMA(0, 0, At, B0); PG8_BAR; PG8_SCHED;
            PG8_LDB(B1, 1, 1); PG8_STAGE(PG8_SB(1, 0), b3, voffB);
            PG8_BAR; PG8_WAIT_L(0); PG8_MMA(0, 1, At, B1); PG8_BAR;
            PG8_LDA(At, 1, 1); PG8_STAGE(PG8_SA(1, 0), a3, voffA);
            PG8_BAR; PG8_WAIT_L(0); PG8_MMA(1, 0, At, B0); PG8_BAR; PG8_SCHED;
            PG8_STAGE(PG8_SB(1, 1), b3 + hstep, voffB);
            PG8_WAIT_V(6); PG8_BAR; PG8_MMA(1, 1, At, B1); PG8_BAR;
            }
        }
        if constexpr (ALIGN_EPI) { if (wr == 0) PG8_BAR; }
        if constexpr (!Epi::AFTER_DRAIN) { E(acc, cur, ui, wr, wc, fr, fq); S.done(cur); }
        if (!has_next) break;
#pragma unroll
        for (int a = 0; a < 2; ++a)
#pragma unroll
            for (int b = 0; b < 2; ++b)
#pragma unroll
                for (int m = 0; m < 4; ++m)
#pragma unroll
                    for (int n = 0; n < 2; ++n) acc[a][b][m][n] = (f32x4){0.f, 0.f, 0.f, 0.f};
        cur = nxt; cA = nA; cB = nB; ++ui;
        if constexpr (ALIGN_EPI) { if (wr == 1) PG8_BAR; }
    }
    PG8_WAIT_V(0);
    if constexpr (!ALIGN_EPI) { if (wr == 0) PG8_BAR; }
    PG8_BAR;
    if constexpr (Epi::AFTER_DRAIN) { E.fused(acc, cur, wr, wc, fr, fq, lds, wid, lane); S.done(cur); }
#undef PG8_SA
#undef PG8_SB
#undef PG8_STAGE
#undef PG8_LDA
#undef PG8_LDB
#undef PG8_MMA
#undef PG8_WAIT_V
#undef PG8_WAIT_L
#undef PG8_BAR
#undef PG8_SCHED
}
}

#define LAS __attribute__((address_space(3)))
typedef _Float16 h16;
typedef _Float16 h16x8 __attribute__((ext_vector_type(8)));
typedef _Float16 h16x4 __attribute__((ext_vector_type(4)));
typedef _Float16 h16x2 __attribute__((ext_vector_type(2)));
typedef __fp16 fp16x4v __attribute__((__vector_size__(4 * sizeof(__fp16))));
typedef float f32x4 __attribute__((ext_vector_type(4)));
typedef float f32x16 __attribute__((ext_vector_type(16)));
typedef unsigned u32x4 __attribute__((ext_vector_type(4)));
typedef unsigned u32x2 __attribute__((ext_vector_type(2)));

#ifndef REP_MOBA
#define REP_MOBA 1
#endif
#ifndef REP_PRO
#define REP_PRO 1
#endif
#ifndef REP_QKV
#define REP_QKV 1
#endif
#ifndef REP_WO
#define REP_WO 1
#endif
#ifndef REP_UP
#define REP_UP 1
#endif
#ifndef REP_DN
#define REP_DN 1
#endif
#ifndef REP_LN
#define REP_LN 1
#endif
#ifndef REP_SB
#define REP_SB 1
#endif
#ifndef MK_LAUNCHES
#define MK_LAUNCHES 1
#endif
constexpr int NT = 512, M_TOK = 65536, DM = 1024, SEQ = 2048, NH = 16, DH = 64, FF = 4096, NBLK = 8, DEPTH = 2, NPHASE = 17;
constexpr int ST_OFF = pg8::STAGE_BYTES, LDS_BYTES = pg8::STAGE_BYTES + 16 * 256 * 8;
constexpr float LN_EPS = 1e-5f, ALPHA = 1.41421356237309515f  , LOG2E = 1.44269504088896341f, QSCALE = 0.125f * LOG2E;
constexpr float NEG_INF = -__builtin_inff();
constexpr size_t ACT_B = (size_t)M_TOK * DM * 2;
constexpr size_t W_QKV_B = (size_t)3 * DM * DM * 2, W_O_B = (size_t)DM * DM * 2, W_UP_B = (size_t)FF * DM * 2, W_DN_B = (size_t)FF * DM * 2, W_LAYER_B = W_QKV_B + W_O_B + W_UP_B + W_DN_B;
constexpr int NCS = 4096 + 4096 + 3072;
constexpr size_t WS_BAR = 0  , WS_BARST = 16384  , CTL_BYTES = 16384 + 8192  ,
                 WS_W = 32768, WS_CS = WS_W + DEPTH * W_LAYER_B  , WS_CSP = WS_CS + 131072  , WS_ST1 = WS_CSP + (size_t)2 * 1048576,
                 WS_ST2 = WS_ST1 + (size_t)M_TOK * 128  , WS_X16 = WS_ST2 + (size_t)M_TOK * 128, WS_YA = WS_X16 + ACT_B, WS_YB = WS_YA + ACT_B, WS_KM = WS_YB + ACT_B,
                 WS_Q = WS_KM + (size_t)4096 * 64 * 4, WS_K = WS_Q + ACT_B, WS_V = WS_K + ACT_B, WS_O = WS_V + ACT_B,
                 WS_U = WS_Q  , WS_END = WS_Q + 4 * ACT_B;

struct Params { const float *x, *rel_bias, *w_qkv, *w_o, *ln_mix_g, *ln_mix_b, *w_up, *w_down, *ln_ffn_g, *ln_ffn_b; float* out; unsigned char* ws; int ph_lo, ph_hi; };

__device__ __forceinline__ unsigned pk2h(float lo, float hi) { h16x2 v = {(h16)lo, (h16)hi}; return __builtin_bit_cast(unsigned, v); }
__device__ __forceinline__ float ex2(float x) { return __builtin_amdgcn_exp2f(x); }
__device__ __forceinline__ float lg2(float x) { return __builtin_amdgcn_logf(x); }
__device__ __forceinline__ int crow(int i, int hh) { return (i & 3) + 8 * (i >> 2) + 4 * hh; }
#define MFMA32(a, b, c) __builtin_amdgcn_mfma_f32_32x32x16_f16((a), (b), (c), 0, 0, 0)
__device__ __forceinline__ h16x8 pack8(const f32x16& x, const int s) {
    h16x8 r; r[0] = (h16)x[8 * s + 0]; r[1] = (h16)x[8 * s + 1]; r[2] = (h16)x[8 * s + 2]; r[3] = (h16)x[8 * s + 3]; r[4] = (h16)x[8 * s + 4]; r[5] = (h16)x[8 * s + 5]; r[6] = (h16)x[8 * s + 6]; r[7] = (h16)x[8 * s + 7]; return r; }
__device__ __forceinline__ h16x8 tr8(const LAS unsigned char* p_lo, const LAS unsigned char* p_hi) {
    const h16x4 lo = __builtin_bit_cast(h16x4, __builtin_amdgcn_ds_read_tr16_b64_v4f16((LAS fp16x4v*)p_lo));
    const h16x4 hi = __builtin_bit_cast(h16x4, __builtin_amdgcn_ds_read_tr16_b64_v4f16((LAS fp16x4v*)p_hi));
    return __builtin_shufflevector(lo, hi, 0, 1, 2, 3, 4, 5, 6, 7); }

#define XB_TMO      128
#define XB_XCNT(j)  (256  + 64 * (j))
#define XB_XSUB(j)  (1280 + 64 * (j))
#define XB_XGEN(j)  (2304 + 64 * (j))
#define XB_TOP      3328
#define XB_TOPGEN   3392
#define XCD_BAR_WORDS 3456
#define XB_SPIN_CAP (1u << 18)

__device__ __forceinline__ unsigned xb_ld(unsigned* p)              { return __hip_atomic_load(p, __ATOMIC_RELAXED, __HIP_MEMORY_SCOPE_AGENT); }
__device__ __forceinline__ unsigned xb_add(unsigned* p, unsigned v) { return __hip_atomic_fetch_add(p, v, __ATOMIC_RELAXED, __HIP_MEMORY_SCOPE_AGENT); }
__device__ __forceinline__ unsigned xb_xcc_id() { return (unsigned)__builtin_amdgcn_s_getreg((3 << 11) | 20) & 0xFu; }
#define XB_SPIN(cond, bar) do { unsigned _sp = 0; while (cond) { __builtin_amdgcn_s_sleep(1); \
    if ((++_sp & 255u) == 0u) { if (xb_ld(&(bar)[XB_TMO])) break; if (_sp > XB_SPIN_CAP) { atomicAdd(&(bar)[XB_TMO], 1u); break; } } } } while (0)

struct XcdBarrier {
    unsigned* bar; unsigned x;
    volatile unsigned* st;
};

__device__ __forceinline__ XcdBarrier xcd_barrier_post(unsigned* bar, volatile unsigned* st) {
    XcdBarrier b; b.bar = bar; b.x = xb_xcc_id(); b.st = st;
    if (mk_tid() == 0) (void)xb_add(&bar[XB_XCNT(b.x)], 1u);
    return b;
}
__device__ __forceinline__ void xcd_barrier_complete(unsigned* bar, unsigned x, unsigned& nloc, unsigned& nx) {
    const unsigned G = gridDim.x * gridDim.y * gridDim.z;
    unsigned sum, cnt, mine, sp = 0u;
    for (;;) {
        sum = 0u; cnt = 0u; mine = 0u;
#pragma unroll
        for (unsigned j = 0; j < 16; ++j) { const unsigned c = xb_ld(&bar[XB_XCNT(j)]); sum += c; cnt += (c > 0u) ? 1u : 0u; mine = (j == x) ? c : mine; }
        if (sum == G) break;
        __builtin_amdgcn_s_sleep(1);
        if ((++sp & 255u) == 0u) { if (xb_ld(&bar[XB_TMO])) break; if (sp > XB_SPIN_CAP) { atomicAdd(&bar[XB_TMO], 1u); break; } }
    }
    nloc = mine > 0u ? mine : 1u; nx = cnt > 0u ? cnt : 1u;
}

__device__ __forceinline__ void xcd_barrier(const XcdBarrier& b) {
    asm volatile("s_waitcnt vmcnt(0)" ::: "memory");
    __syncthreads();
    if (mk_tid() == 0) {
        unsigned* bar = b.bar;
        __builtin_amdgcn_s_waitcnt(0);
        unsigned nloc = b.st[0], nx = b.st[1];
        if (nloc == 0u) { xcd_barrier_complete(bar, b.x, nloc, nx); b.st[0] = nloc; b.st[1] = nx; }
        const unsigned old = xb_add(&bar[XB_XSUB(b.x)], 1u);
        const unsigned gen = old / nloc;
        if (old + 1u == (gen + 1u) * nloc) {
            __builtin_amdgcn_fence(__ATOMIC_RELEASE, "agent");
            asm volatile("s_waitcnt vmcnt(0)" ::: "memory");
            const unsigned og = xb_add(&bar[XB_TOP], 1u);
            const unsigned tg = og / nx;
            if (og + 1u == (tg + 1u) * nx) xb_add(&bar[XB_TOPGEN], 1u);
            else XB_SPIN(xb_ld(&bar[XB_TOPGEN]) == tg, bar);
            __builtin_amdgcn_fence(__ATOMIC_ACQUIRE, "agent");
            xb_add(&bar[XB_XGEN(b.x)], 1u);
            asm volatile("s_waitcnt vmcnt(0)" ::: "memory");
        } else {
            XB_SPIN(xb_ld(&bar[XB_XGEN(b.x)]) == gen, bar);
            __builtin_amdgcn_fence(__ATOMIC_ACQUIRE, "agent");
            asm volatile("s_waitcnt vmcnt(0)" ::: "memory");
        }
    }
    __syncthreads();
}

__device__ __forceinline__ void p_prologue(const Params& P, LAS unsigned char* lds) {
    int tid_ = mk_tid(); asm volatile("" : "+v"(tid_)); const int tid = tid_, G = gridDim.x, c = blockIdx.x;
    { h16* Hh = (h16*)(P.ws + WS_X16); const size_t nvec = (size_t)M_TOK * DM / 8;
      for (size_t v = (size_t)c * NT + tid; v < nvec; v += (size_t)G * NT) {
          const f32x4 a = __builtin_nontemporal_load((const f32x4*)P.x + 2 * v), b = __builtin_nontemporal_load((const f32x4*)P.x + 2 * v + 1);
          u32x4 w; w.x = pk2h(a[0], a[1]); w.y = pk2h(a[2], a[3]); w.z = pk2h(b[0], b[1]); w.w = pk2h(b[2], b[3]); ((u32x4*)Hh)[v] = w; } }
    LAS float* tile = (LAS float*)lds;
    float* csp = (float*)(P.ws + WS_CSP);
    for (int t = c; t < DEPTH * 3072; t += G) {
        const int l = t / 3072, r = t % 3072; const float* src; h16* dst; int K, N, tl; unsigned char* wl = P.ws + WS_W + (size_t)l * W_LAYER_B;
        const float* gv = nullptr; const float* bv = nullptr; int csoff = 0;
        if (r < 768)       { src = P.w_qkv  + (size_t)l * DM * 3 * DM; dst = (h16*)wl;                               K = DM; N = 3 * DM; tl = r; if (l > 0) { gv = P.ln_ffn_g + (l - 1) * DM; bv = P.ln_ffn_b + (l - 1) * DM; csoff = 8192; } }
        else if (r < 1024) { src = P.w_o    + (size_t)l * DM * DM;     dst = (h16*)(wl + W_QKV_B);                   K = DM; N = DM;     tl = r - 768; }
        else if (r < 2048) { src = P.w_up   + (size_t)l * DM * FF;     dst = (h16*)(wl + W_QKV_B + W_O_B);           K = DM; N = FF;     tl = r - 1024; gv = P.ln_mix_g + l * DM; bv = P.ln_mix_b + l * DM; csoff = l * 4096; }
        else               { src = P.w_down + (size_t)l * FF * DM;     dst = (h16*)(wl + W_QKV_B + W_O_B + W_UP_B);  K = FF; N = DM;     tl = r - 2048; }
        const int ntn = N / 64, k0 = (tl / ntn) * 64, n0 = (tl % ntn) * 64;
        { const int n = tid & 63, kb = tid >> 6;
#pragma unroll
          for (int i = 0; i < 8; ++i) { const int k = kb + 8 * i; tile[k * 65 + n] = __builtin_nontemporal_load(src + (size_t)(k0 + k) * N + n0 + n); } }
        __syncthreads();
        { const int k2 = (tid & 31) * 2, nb = tid >> 5; const float g0 = gv ? gv[k0 + k2] : 1.f, g1 = gv ? gv[k0 + k2 + 1] : 1.f;
#pragma unroll
          for (int i = 0; i < 4; ++i) { const int n = nb + 16 * i; const h16x2 v = {(h16)(tile[k2 * 65 + n] * g0), (h16)(tile[(k2 + 1) * 65 + n] * g1)}; *(h16x2*)(dst + (size_t)(n0 + n) * K + k0 + k2) = v; } }
        if (gv && tid < 64) { float sa = 0.f, sb = 0.f;
            for (int k = 0; k < 64; ++k) { const float wv = tile[k * 65 + tid]; sa += (float)(h16)(wv * gv[k0 + k]); sb += wv * bv[k0 + k]; }
            csp[(size_t)((k0 >> 6) * 2 + 0) * NCS + csoff + n0 + tid] = sa; csp[(size_t)((k0 >> 6) * 2 + 1) * NCS + csoff + n0 + tid] = sb; }
        __syncthreads();
    }
}

__device__ __forceinline__ void p_cs_finalize(const Params& P) {
    const float* csp = (const float*)(P.ws + WS_CSP); float* cs = (float*)(P.ws + WS_CS);
    int tid_ = mk_tid(); asm volatile("" : "+v"(tid_));
    for (int i = blockIdx.x * 88 + tid_; tid_ < 88 && i < 2 * NCS; i += gridDim.x * 88) {     const int v = i / NCS, cidx = i % NCS; float a = 0.f;
        float pv_[16];
#pragma unroll
        for (int kt = 0; kt < 16; ++kt) pv_[kt] = csp[(size_t)(kt * 2 + v) * NCS + cidx];
#pragma unroll
        for (int kt = 0; kt < 16; ++kt) a += pv_[kt];
        cs[i] = a; }
}

template <class Sched> __device__ __forceinline__ void p_fill_tables(LAS unsigned char* lds, const float* part, const Sched& S, const float* cvec, const float* bvec) {
    int tid_ = mk_tid(); asm volatile("" : "+v"(tid_)); const int tid = tid_;
    LAS unsigned char* tb = lds + ST_OFF; LAS pg8::f32x2_t* st = (LAS pg8::f32x2_t*)tb; LAS float* csl = (LAS float*)(tb + 8192); LAS float* bwl = (LAS float*)(tb + 12288); LAS int* sl = (LAS int*)(tb + 16384);
    if (tid < 16) { pg8::Unit u; const bool ok = S.next(tid, u); sl[48 + tid] = ok ? u.pm : -1; sl[64 + tid] = ok ? u.pn : -1; }
    __syncthreads();
    int fpm = 0, fpn = 0;
    if (tid < 16) { const int pm = sl[48 + tid], pn = sl[64 + tid]; fpm = tid; fpn = tid;
        for (int j = tid - 1; j >= 0; --j) { if (sl[48 + j] == pm) fpm = j; if (sl[64 + j] == pn) fpn = j; }
        sl[80 + tid] = (fpm == tid && pm >= 0) ? 1 : 0; sl[96 + tid] = (fpn == tid && pn >= 0) ? 1 : 0; }
    __syncthreads();
    if (tid < 16) { int ps = 0, cs_ = 0;
        for (int j = 0; j < fpm; ++j) ps += sl[80 + j];
        for (int j = 0; j < fpn; ++j) cs_ += sl[96 + j];
        ps = ps < 3 ? ps : 3; cs_ = cs_ < 3 ? cs_ : 3;
        sl[tid] = ps; sl[16 + tid] = cs_;
        if (fpm == tid && sl[48 + tid] >= 0) sl[32 + ps] = sl[48 + tid];
        if (fpn == tid && sl[64 + tid] >= 0) sl[36 + cs_] = sl[64 + tid];
        if (tid == 0) { int a = 0, b = 0; for (int j = 0; j < 16; ++j) { a += sl[80 + j]; b += sl[96 + j]; } sl[40] = a < 4 ? a : 4; sl[41] = b < 4 ? b : 4; } }
    __syncthreads();
    const int npm = sl[40], npn = sl[41];
    f32x4 pr[2][8]; float cvl[4];
#pragma unroll
    for (int jj = 0; jj < 2; ++jj) { const int j = (tid >> 8) + 2 * jj; const int pm = sl[32 + (j < npm ? j : 0)];
        const f32x4* pp = (const f32x4*)(part + (size_t)(pm * 256 + (tid & 255)) * 32);
#pragma unroll
        for (int x = 0; x < 8; ++x) pr[jj][x] = pp[x]; }
#pragma unroll
    for (int j = 0; j < 4; ++j) { const int pn = sl[36 + (j < npn ? j : 0)]; cvl[j] = (tid < 256) ? cvec[pn * 256 + tid] : bvec[pn * 256 + tid - 256]; }
#pragma unroll
    for (int jj = 0; jj < 2; ++jj) { const int j = (tid >> 8) + 2 * jj; if (j < npm) { float sa = 0.f, sq = 0.f;
#pragma unroll
            for (int x = 0; x < 8; ++x) { sa += pr[jj][x][0] + pr[jj][x][2]; sq += pr[jj][x][1] + pr[jj][x][3]; }
            const float mean = sa * (1.0f / 1024.0f), var = sq * (1.0f / 1024.0f) - mean * mean;
            st[j * 256 + (tid & 255)] = (pg8::f32x2_t){mean, 1.0f / sqrtf(var + LN_EPS)}; } }
#pragma unroll
    for (int j = 0; j < 4; ++j) if (j < npn) { if (tid < 256) csl[j * 256 + tid] = cvl[j]; else bwl[j * 256 + tid - 256] = cvl[j]; }
    __syncthreads();
}

__device__ __forceinline__ void p_kmean(const Params& P) {
    const h16* Kb = (const h16*)(P.ws + WS_K); float* KM = (float*)(P.ws + WS_KM);
    int tid_ = mk_tid(); asm volatile("" : "+v"(tid_)); const int lane = tid_ & 63, w = tid_ >> 6, sub = lane & 7, rr = lane >> 3;
    for (int it = blockIdx.x * 8 + w; it < 4096; it += gridDim.x * 8) {
        const int bh = it >> 3, n = it & 7, b = bh >> 4, h = bh & 15;
        const h16* p = Kb + ((size_t)bh * SEQ + n * 256 + rr) * DH + sub * 8;
        float a[8];
#pragma unroll
        for (int e = 0; e < 8; ++e) a[e] = 0.f;
#pragma unroll 8
        for (int i = 0; i < 32; ++i) { const h16x8 v = *(const h16x8*)(p + (size_t)i * 8 * DH);
#pragma unroll
            for (int e = 0; e < 8; ++e) a[e] += (float)v[e]; }
#pragma unroll
        for (int e = 0; e < 8; ++e) { a[e] += __shfl_xor(a[e], 8); a[e] += __shfl_xor(a[e], 16); a[e] += __shfl_xor(a[e], 32); a[e] *= (1.0f / 256.0f); }
        if (rr == 0) { float* o = KM + (size_t)it * 64 + sub * 8; *(f32x4*)o = (f32x4){a[0], a[1], a[2], a[3]}; *(f32x4*)(o + 4) = (f32x4){a[4], a[5], a[6], a[7]}; }
    }
}

template <bool FINAL> __device__ __forceinline__ void p_ln(const h16* Y, h16* Ho, float* Fo, const float* g, const float* bt, const float* part) {
    int tid_ = mk_tid(); asm volatile("" : "+v"(tid_)); const int lane = tid_ & 63, w = __builtin_amdgcn_readfirstlane(tid_ >> 6);
    float gg[16], bb[16];
#pragma unroll
    for (int e = 0; e < 8; ++e) { gg[e] = g[8 * lane + e]; gg[8 + e] = g[512 + 8 * lane + e]; bb[e] = bt[8 * lane + e]; bb[8 + e] = bt[512 + 8 * lane + e]; }
    for (int row = blockIdx.x * 8 + w; row < M_TOK; row += gridDim.x * 8) {
        const h16x8 v0 = *(const h16x8*)(Y + (size_t)row * DM + 8 * lane), v1 = *(const h16x8*)(Y + (size_t)row * DM + 512 + 8 * lane);
        const f32x4* pp = (const f32x4*)(part + (size_t)row * 32); float sa = 0.f, sq = 0.f;
#pragma unroll
        for (int k = 0; k < 8; ++k) { const f32x4 v = pp[k]; sa += v[0] + v[2]; sq += v[1] + v[3]; }
        const float mean = sa * (1.0f / 1024.0f), var = sq * (1.0f / 1024.0f) - mean * mean, rstd = 1.0f / sqrtf(var + LN_EPS);
        float x[16];
#pragma unroll
        for (int e = 0; e < 8; ++e) { x[e] = (float)v0[e]; x[8 + e] = (float)v1[e]; }
#pragma unroll
        for (int e = 0; e < 16; ++e) x[e] = (x[e] - mean) * rstd * gg[e] + bb[e];
        if (FINAL) { float* o = Fo + (size_t)row * DM + 8 * lane;
            *(f32x4*)o = (f32x4){x[0], x[1], x[2], x[3]}; *(f32x4*)(o + 4) = (f32x4){x[4], x[5], x[6], x[7]};
            *(f32x4*)(o + 512) = (f32x4){x[8], x[9], x[10], x[11]}; *(f32x4*)(o + 516) = (f32x4){x[12], x[13], x[14], x[15]}; }
        else { h16* o = Ho + (size_t)row * DM + 8 * lane; u32x4 a, b;
            a.x = pk2h(x[0], x[1]); a.y = pk2h(x[2], x[3]); a.z = pk2h(x[4], x[5]); a.w = pk2h(x[6], x[7]);
            b.x = pk2h(x[8], x[9]); b.y = pk2h(x[10], x[11]); b.z = pk2h(x[12], x[13]); b.w = pk2h(x[14], x[15]);
            *(u32x4*)o = a; *(u32x4*)(o + 512) = b; }
    }
}

namespace attn_body {
using bf16=_Float16;
using h16x8v=__attribute__((ext_vector_type(8)))_Float16;
using bf16x8=__attribute__((ext_vector_type(8)))short;
using s16x4=__attribute__((ext_vector_type(4)))short;
using f32x16=__attribute__((ext_vector_type(16)))float;
using u32x4=__attribute__((ext_vector_type(4)))unsigned;
constexpr int BATCH=32,NHEAD=16,SEQ=2048,D=64,DM=NHEAD*D;
constexpr int NW=8,QBLK=32,QB=QBLK*NW,KVBLK=64,NQB=SEQ/QB;
constexpr int ATTN_PITCH=DM, ATTN_UNIT_ROWS=QB;
__device__ __forceinline__ int crow(int r,int hi){return (r&3)+8*(r>>2)+4*hi;}
#define SBAR() __builtin_amdgcn_sched_barrier(0)
#define MF16(a,b,c,x,y,z) __builtin_amdgcn_mfma_f32_32x32x16_f16(__builtin_bit_cast(h16x8v,(a)),__builtin_bit_cast(h16x8v,(b)),(c),0,0,0)
__device__ __forceinline__ void cmask(f32x16&p0,f32x16&p1,int jb,int qrel,int hi){
  const float NEG=-INFINITY; int kb=64*jb+4*hi;
  #pragma unroll
  for(int r=0;r<16;++r){int kv=kb+(r&3)+8*(r>>2); if(kv>qrel)p0[r]=NEG; if(kv+32>qrel)p1[r]=NEG;}
}

constexpr int NSLOT=3, SLOTB=8192;
constexpr int LDS_K=0, LDS_V=NSLOT*SLOTB, LDS_WS=2*NSLOT*SLOTB, LDS_OST=LDS_WS+NW*64*4, LDS_BYTES=LDS_OST+NW*4096;
constexpr int LDS_KM=LDS_BYTES, LDS_BT=LDS_KM+2048, NBT=640, LDS_SEL=LDS_BT+4*NBT*4, LDS_TOTAL=LDS_SEL+NW*2048;
constexpr float C2=0.125f*1.4426950408889634f;
__device__ __forceinline__ void glds16(const void*gsrc,unsigned lds_dst){unsigned keep;
  asm volatile("s_mov_b32 %0, m0\n\ts_mov_b32 m0, %2\n\ts_nop 0\n\tglobal_load_lds_dwordx4 %1, off\n\ts_mov_b32 m0, %0":"=&s"(keep):"v"(gsrc),"s"(lds_dst):"memory");}
__device__ __forceinline__ float max3f(float a,float b,float c){float r;asm("v_max3_f32 %0, %1, %2, %3":"=v"(r):"v"(a),"v"(b),"v"(c));return r;}
__device__ __forceinline__ float max2f(float a,float b){float r;asm("v_max_f32_e32 %0, %1, %2":"=v"(r):"v"(a),"v"(b));return r;}
__device__ __forceinline__ float fadd_s(float a,float b){float r;asm("v_add_f32_e32 %0, %1, %2":"=v"(r):"v"(a),"v"(b));return r;}
__device__ __forceinline__ float fsub_s(float a,float b){float r;asm("v_sub_f32_e32 %0, %1, %2":"=v"(r):"v"(a),"v"(b));return r;}
typedef float f32x2_t __attribute__((ext_vector_type(2))); typedef _Float16 bf16x2_t __attribute__((ext_vector_type(2)));
__device__ __forceinline__ unsigned cvtpk_s(float lo,float hi){f32x2_t v={lo,hi};bf16x2_t b=__builtin_convertvector(v,bf16x2_t);return __builtin_bit_cast(unsigned,b);}
#define WAIT_BAR(N) asm volatile("s_waitcnt vmcnt(" #N ") lgkmcnt(0)\n\ts_barrier":::"memory")

__device__ __forceinline__ void qkt(f32x16&p0,f32x16&p1,const char*Kslot,const bf16x8*qr,const f32x16&negm,int r32,int hi){
  const char*kb=Kslot+hi*1024+r32*16;
  #pragma unroll
  for(int d0=0;d0<4;++d0){
    const bf16x8 b0=*reinterpret_cast<const bf16x8*>(kb+d0*2048);
    const bf16x8 b1=*reinterpret_cast<const bf16x8*>(kb+d0*2048+512);
    if(d0==0){p0=MF16(b0,qr[0],negm,0,0,0);p1=MF16(b1,qr[0],negm,0,0,0);}
    else{p0=MF16(b0,qr[d0],p0,0,0,0);p1=MF16(b1,qr[d0],p1,0,0,0);}}
}
typedef __attribute__((address_space(3))) const char* lds_cptr;
typedef short v4i16_t __attribute__((ext_vector_type(4)));
typedef float f32x4 __attribute__((ext_vector_type(4)));
__device__ __forceinline__ void kload8(bf16x8*kf,lds_cptr kp){
  kf[0]=*(const __attribute__((address_space(3))) bf16x8*)(kp);      kf[1]=*(const __attribute__((address_space(3))) bf16x8*)(kp+512);
  kf[2]=*(const __attribute__((address_space(3))) bf16x8*)(kp+2048); kf[3]=*(const __attribute__((address_space(3))) bf16x8*)(kp+2560);
  kf[4]=*(const __attribute__((address_space(3))) bf16x8*)(kp+4096); kf[5]=*(const __attribute__((address_space(3))) bf16x8*)(kp+4608);
  kf[6]=*(const __attribute__((address_space(3))) bf16x8*)(kp+6144); kf[7]=*(const __attribute__((address_space(3))) bf16x8*)(kp+6656);
}
__device__ __forceinline__ void kload2(bf16x8*kf,lds_cptr kp,int j){ kf[2*j]=*(const __attribute__((address_space(3))) bf16x8*)(kp+j*2048); kf[2*j+1]=*(const __attribute__((address_space(3))) bf16x8*)(kp+j*2048+512); }
__device__ __forceinline__ s16x4 vtr(lds_cptr p){ return __builtin_bit_cast(s16x4,__builtin_amdgcn_ds_read_tr16_b64_v4i16((__attribute__((address_space(3))) v4i16_t*)p)); }
__device__ __forceinline__ float rowmax(const f32x16&p0,const f32x16&p1){
  float a=max3f(p0[0],p0[1],p1[0]),b=max3f(p0[2],p0[3],p1[1]);a=max3f(a,p1[2],p1[3]);
  #pragma unroll
  for(int r=4;r<16;r+=4){a=max3f(a,p0[r],p0[r+1]);b=max3f(b,p0[r+2],p0[r+3]);a=max3f(a,p1[r],p1[r+1]);b=max3f(b,p1[r+2],p1[r+3]);}
  const float m=max2f(a,b);
  auto rr=__builtin_amdgcn_permlane32_swap(__float_as_uint(m),__float_as_uint(m),false,false);
  return max2f(__uint_as_float(rr[0]),__uint_as_float(rr[1]));
}
__device__ __forceinline__ void pv(f32x16*o,int vb,bf16x8 pa0,bf16x8 pa1,bf16x8 pa2,bf16x8 pa3){
  #pragma unroll
  for(int d0=0;d0<2;++d0){s16x4 lo[4],hi[4];
    #pragma unroll
    for(int ks=0;ks<4;++ks){
      asm volatile("ds_read_b64_tr_b16 %0,%1 offset:%c2":"=&v"(lo[ks]):"v"(vb),"i"(d0*4096+ks*1024):"memory");
      asm volatile("ds_read_b64_tr_b16 %0,%1 offset:%c2":"=&v"(hi[ks]):"v"(vb),"i"(d0*4096+ks*1024+512):"memory");}
    asm volatile("s_waitcnt lgkmcnt(0)":::"memory");SBAR();
    #define PK(k) (bf16x8){lo[k][0],lo[k][1],lo[k][2],lo[k][3],hi[k][0],hi[k][1],hi[k][2],hi[k][3]}
    o[d0]=MF16(pa0,PK(0),o[d0],0,0,0);
    o[d0]=MF16(pa1,PK(1),o[d0],0,0,0);
    o[d0]=MF16(pa2,PK(2),o[d0],0,0,0);
    o[d0]=MF16(pa3,PK(3),o[d0],0,0,0);
    #undef PK
  }
}

#ifndef ATTN_STORE16
#define ATTN_STORE16(p,v) (*(u32x4*)(p)=(v))
#endif
template<int THRL> __device__ __forceinline__ void attn_unit(int b,int h,int qb,const bf16*Q,const bf16*__restrict__ K,const bf16*__restrict__ V,bf16*O,char*shm,const float*KMg,const float*rel_bias,bool newhead,bf16x8 (&qr)[4],const bf16*Qnext){
  int tid_=mk_tid(); asm volatile("":"+v"(tid_));
  const int tid=tid_,lane=tid&63,r32=lane&31,hi=lane>>5; const int wid=__builtin_amdgcn_readfirstlane(tid>>6);
  const long rowbase=(long)b*SEQ; const int q0=qb*QB;
  typedef __attribute__((address_space(3))) float* lds_fptr;
  const lds_fptr kml=(lds_fptr)(shm+LDS_KM); const lds_fptr btl=(lds_fptr)(shm+LDS_BT);
  if(newhead){
    {
      const bf16*Kn=K+(long)(b*NHEAD+h)*SEQ*D+(long)(tid>>3)*D+(tid&7)*8; const lds_fptr kpart=(lds_fptr)(shm+LDS_TOTAL);
      h16x8v kv_[32];
      #pragma unroll
      for(int i=0;i<32;++i)kv_[i]=*reinterpret_cast<const h16x8v*>(Kn+(long)i*64*D);
      #pragma unroll
      for(int n=0;n<8;++n){ float a_[8];
        #pragma unroll
        for(int e=0;e<8;++e)a_[e]=((float)kv_[4*n][e]+(float)kv_[4*n+1][e])+((float)kv_[4*n+2][e]+(float)kv_[4*n+3][e]);
        #pragma unroll
        for(int e=0;e<8;++e){ a_[e]+=__shfl_xor(a_[e],8); a_[e]+=__shfl_xor(a_[e],16); a_[e]+=__shfl_xor(a_[e],32); }
        if((lane>>3)==0){
          #pragma unroll
          for(int e=0;e<8;++e)kpart[(wid*8+n)*64+(lane&7)*8+e]=a_[e]; } }
      asm volatile("s_waitcnt vmcnt(0) lgkmcnt(0)\n\ts_barrier":::"memory");
      float t_=0.f;
      #pragma unroll
      for(int w8=0;w8<8;++w8)t_+=kpart[w8*512+tid];
      kml[tid]=t_*(1.0f/256.0f); }
    for(int e=tid;e<4*NBT;e+=NW*64){ const int cpy=e/NBT,i=e%NBT,j=i+cpy; float v=-INFINITY;
      const int dist=(NBT-1-j)-256;
      if(j<NBT&&dist>=0){ int bk=dist; if(dist>=16){ bk=16+(int)(logf((float)dist/16.0f)/logf(8.0f)*16.0f); bk=bk<31?bk:31; } v=(rel_bias[bk*NHEAD+h]-rel_bias[31*NHEAD+h])*1.4426950408889634f; }
      btl[e]=v; }
    asm volatile("s_waitcnt vmcnt(0) lgkmcnt(0)\n\ts_barrier":::"memory"); }
  const bf16*Qw=Q+(rowbase+q0+wid*QBLK)*DM+h*D;
  const bf16*Kh=K+(long)(b*NHEAD+h)*SEQ*D,*Vh=V+(long)(b*NHEAD+h)*SEQ*D;
  const unsigned lds0=(unsigned)(uintptr_t)shm;
  float*wsf=(float*)(shm+LDS_WS)+wid*64;
  const bf16*ksrc=Kh+(long)lane*D+wid*8;
  const bf16*vsrc=Vh+(long)(16*(wid&3)+(lane>>2))*D+(wid>>2)*32+(lane&3)*8;
  const unsigned kdst=lds0+LDS_K+wid*1024, vdst=lds0+LDS_V+wid*1024;
  #define TKT(t) ((t)<4 ? NT-4+(t) : NT-1-(t))
  #define DMA_K(t,slot) glds16(ksrc+(long)(TKT(t))*KVBLK*D,(unsigned)__builtin_amdgcn_readfirstlane(kdst+(slot)))
  #define DMA_V(t,slot) glds16(vsrc+(long)(TKT(t))*KVBLK*D,(unsigned)__builtin_amdgcn_readfirstlane(vdst+(slot)))
  const int vb0=(int)(lds0+LDS_V)+((lane>>4)&1)*32+(lane&3)*8+(4*hi+((lane&15)>>2))*64;
  const char*Kbase=shm+LDS_K; bf16x8 kf[8];
  const lds_cptr shm3=(lds_cptr)shm; const lds_cptr kp0=shm3+LDS_K+hi*1024+r32*16; const lds_cptr vp0=shm3+LDS_V+((lane>>4)&1)*32+(lane&3)*8+(4*hi+((lane&15)>>2))*64;
  const int NT=(q0+QB)/KVBLK;
  DMA_K(0,0);DMA_V(0,0);DMA_K(1,SLOTB);
  unsigned sel=0u;
  if(qb>0){ float g[7];
    #pragma unroll
    for(int n=0;n<7;++n){ float a=0.f;
      if(n<qb){
        #pragma unroll
        for(int d0=0;d0<4;++d0){ const h16x8v qv=__builtin_bit_cast(h16x8v,qr[d0]);
          #pragma unroll
          for(int j=0;j<8;++j)a+=(float)qv[j]*kml[n*64+16*d0+8*hi+j]; } }
      { auto rr=__builtin_amdgcn_permlane32_swap(__float_as_uint(a),__float_as_uint(a),false,false); a=__uint_as_float(rr[0])+__uint_as_float(rr[1]); }
      g[n]=(n<qb)?a:-INFINITY; }
    if(qb<=3)sel=(1u<<qb)-1u;
    else{
      #pragma unroll
      for(int n=0;n<7;++n){ int rank=0;
        #pragma unroll
        for(int m=0;m<7;++m)if(m!=n)rank+=((g[m]>g[n])||(g[m]==g[n]&&m<n))?1:0;
        if(n<qb&&rank<3)sel|=1u<<n; } } }
  const bool mixed=qb>3;
  typedef __attribute__((address_space(3))) unsigned* lds_uptr;
  if(mixed){ *(lds_uptr)(shm3+LDS_SEL+wid*2048+hi*1024+r32*16)=sel; }
  float mhat=0.f,l_reg=0.f;f32x16 o[2];o[0]=f32x16{};o[1]=f32x16{};f32x16 negm=f32x16{};asm volatile("":"+v"(negm));
  const int qrel=wid*QBLK+r32;
  #define CMASK(P0,P1,t) do{ const int t_=(t); const int kt_=TKT(t_); \
    if(t_<6){ const int s_=(NBT-1)-(q0+qrel-64*kt_-4*hi+256), c_=s_&3; const __attribute__((address_space(3))) f32x4* tp_=(const __attribute__((address_space(3))) f32x4*)(shm3+LDS_BT+c_*(NBT*4)+(s_-c_)*4); \
      f32x4 b0_[4],b1_[4]; _Pragma("unroll") for(int g=0;g<4;++g){ b0_[g]=tp_[2*g]; b1_[g]=tp_[2*g+8]; } \
      _Pragma("unroll") for(int g=0;g<4;++g) _Pragma("unroll") for(int e=0;e<4;++e){ P0[4*g+e]+=b0_[g][e]; P1[4*g+e]+=b1_[g][e]; } } \
    if(t_>=4&&mixed){ const unsigned sel_=sel; if(((sel_>>(kt_>>2))&1u)==0u){ _Pragma("unroll") for(int r=0;r<16;++r){P0[r]=-INFINITY;P1[r]=-INFINITY;} } } }while(0)
  bool resc=false;
  #define START(P0,P1) do{ const float rm=rowmax(P0,P1); resc=false; \
    { const float dl=rm; mhat=fadd_s(mhat,dl); \
      _Pragma("unroll") for(int r=0;r<16;++r){P0[r]=fsub_s(P0[r],dl);P1[r]=fsub_s(P1[r],dl);} \
      _Pragma("unroll") for(int r=0;r<16;++r)negm[r]=-mhat; asm volatile("":"+v"(negm)); } \
    _Pragma("unroll") for(int r=0;r<16;++r)P0[r]=__builtin_amdgcn_exp2f(P0[r]); }while(0)
  #define RESC() do{ if(resc){ asm volatile("s_waitcnt lgkmcnt(0)":::"memory"); \
      _Pragma("unroll") for(int d_=0;d_<2;++d_) _Pragma("unroll") for(int r=0;r<16;++r)o[d_][r]*=wsf[crow(r,hi)]; } }while(0)
  f32x16 pA0,pA1,pB0,pB1;
  int sl_prev=0,sl_cur=0,sl_next=SLOTB;
  #define ROT() do{sl_prev=sl_cur;sl_cur=sl_next;sl_next=(sl_next==(NSLOT-1)*SLOTB)?0:sl_next+SLOTB;}while(0)
  DMA_K(2,2*SLOTB);
  WAIT_BAR(3);
  qkt(pA0,pA1,Kbase,qr,negm,r32,hi);asm volatile("s_nop 15\n\ts_nop 7":"+v"(pA0),"+v"(pA1));CMASK(pA0,pA1,0);
  START(pA0,pA1);
  _Pragma("unroll") for(int r=0;r<16;++r)pA1[r]=__builtin_amdgcn_exp2f(pA1[r]);
  WAIT_BAR(0);
  DMA_K(3,0);DMA_V(1,SLOTB);
  ROT();
  kload8(kf,kp0+sl_cur);
  WAIT_BAR(2);
  s16x4 vlo[8],vhi[8]; u32x4 pw0,pw1,pw2,pw3;
  #define PKW(P,B) cvtpk_s(P[B],P[B+1])
  #define PAF(k) __builtin_bit_cast(bf16x8,pw##k)
  #define VFR(i) (bf16x8){vlo[i][0],vlo[i][1],vlo[i][2],vlo[i][3],vhi[i][0],vhi[i][1],vhi[i][2],vhi[i][3]}
  #define PIN(x) asm volatile("":"+v"(x))
  #define MX3(a,b,c) __builtin_fmaxf(__builtin_fmaxf((a),(b)),(c))
  #define GAPA(MF,A0,A1,A2,A3,W0,W1,PW) do{ MF; sacc+=A0; sacc+=A1; sacc+=A2; sacc+=A3; PIN(sacc); W0; W1; PIN(PW); SBAR(); }while(0)
  #define EX(v) __builtin_amdgcn_exp2f(v)
  #define GAPB(MF,X,B) do{ MF; X[B]=EX(X[B]); X[B+1]=EX(X[B+1]); X[B+2]=EX(X[B+2]); X[B+3]=EX(X[B+3]); PIN(X); SBAR(); }while(0)
  #define VRD(i) do{ vlo[i]=vtr(vp_+(((i)>>2)*4096+((i)&3)*1024)); vhi[i]=vtr(vp_+(((i)>>2)*4096+((i)&3)*1024+512)); }while(0)
  #define KRD(G,j) do{ if(G){ kload2(kf,kp0+sl_next,j); SBAR(); } }while(0)
  #define STEP(C0,C1,P0,P1,t,GK,GV,GL) do{ SBAR(); \
    const lds_cptr vp_=vp0+sl_prev; \
    VRD(0); SBAR(); float sacc=(P0[0]+P0[1]); \
    GAPA(C0=MF16(kf[0],qr[0],negm,0,0,0), P0[2],P0[3],P0[4],P0[5],     pw0[0]=PKW(P0,0), pw0[1]=PKW(P0,2), pw0); \
    VRD(4); SBAR(); GAPA(C1=MF16(kf[1],qr[0],negm,0,0,0), P0[6],P0[7],P0[8],P0[9],     pw0[2]=PKW(P0,4), pw0[3]=PKW(P0,6), pw0); \
    VRD(1); SBAR(); GAPA(C0=MF16(kf[2],qr[1],C0,0,0,0),   P0[10],P0[11],P0[12],P0[13], pw1[0]=PKW(P0,8), pw1[1]=PKW(P0,10), pw1); \
    VRD(5); SBAR(); GAPA(C1=MF16(kf[3],qr[1],C1,0,0,0),   P0[14],P0[15],P1[0],P1[1],   pw1[2]=PKW(P0,12),pw1[3]=PKW(P0,14), pw1); \
    VRD(2); SBAR(); GAPA(C0=MF16(kf[4],qr[2],C0,0,0,0),   P1[2],P1[3],P1[4],P1[5],     pw2[0]=PKW(P1,0), pw2[1]=PKW(P1,2), pw2); \
    VRD(6); SBAR(); GAPA(C1=MF16(kf[5],qr[2],C1,0,0,0),   P1[6],P1[7],P1[8],P1[9],     pw2[2]=PKW(P1,4), pw2[3]=PKW(P1,6), pw2); \
    VRD(3); SBAR(); GAPA(C0=MF16(kf[6],qr[3],C0,0,0,0),   P1[10],P1[11],P1[12],P1[13], pw3[0]=PKW(P1,8), pw3[1]=PKW(P1,10), pw3); \
    VRD(7); SBAR(); GAPA(C1=MF16(kf[7],qr[3],C1,0,0,0),   P1[14],P1[15],0.f,0.f,       pw3[2]=PKW(P1,12),pw3[3]=PKW(P1,14), pw3); \
    l_reg+=sacc; \
    if(GK){DMA_K((t)+3,sl_cur);} if(GV){DMA_V((t)+1,sl_next);} \
    CMASK(C0,C1,t); \
    { float a=MX3(C0[0],C0[1],C1[0]),b=MX3(C0[2],C0[3],C1[1]); a=MX3(a,C1[2],C1[3]); \
      _Pragma("unroll") for(int r=4;r<16;r+=4){a=MX3(a,C0[r],C0[r+1]);b=MX3(b,C0[r+2],C0[r+3]);a=MX3(a,C1[r],C1[r+1]);b=MX3(b,C1[r+2],C1[r+3]);} \
      float rm=__builtin_fmaxf(a,b); { auto rr=__builtin_amdgcn_permlane32_swap(__float_as_uint(rm),__float_as_uint(rm),false,false); rm=__builtin_fmaxf(__uint_as_float(rr[0]),__uint_as_float(rr[1])); } \
      resc=false; \
      if(__builtin_expect(__any(rm>(float)THRL),0)){ const float dl=__builtin_fmaxf(rm,0.f); mhat+=dl; \
        _Pragma("unroll") for(int r=0;r<16;++r){C0[r]-=dl;C1[r]-=dl;} \
        _Pragma("unroll") for(int r=0;r<16;++r)negm[r]=-mhat; asm volatile("":"+v"(negm)); \
        const float f=__builtin_amdgcn_exp2f(-dl); l_reg*=f; { int r32o_=r32; asm volatile("":"+v"(r32o_)); if(hi==0)wsf[r32o_]=f; }     resc=true; } } \
    SBAR(); \
    GAPB(o[0]=MF16(PAF(0),VFR(0),o[0],0,0,0), C0,0); \
    GAPB(o[1]=MF16(PAF(0),VFR(4),o[1],0,0,0), C0,4); \
    KRD(GL,0); GAPB(o[0]=MF16(PAF(1),VFR(1),o[0],0,0,0), C0,8); \
    KRD(GL,1); GAPB(o[1]=MF16(PAF(1),VFR(5),o[1],0,0,0), C0,12); \
    KRD(GL,2); GAPB(o[0]=MF16(PAF(2),VFR(2),o[0],0,0,0), C1,0); \
    KRD(GL,3); GAPB(o[1]=MF16(PAF(2),VFR(6),o[1],0,0,0), C1,4); \
    GAPB(o[0]=MF16(PAF(3),VFR(3),o[0],0,0,0), C1,8); \
    GAPB(o[1]=MF16(PAF(3),VFR(7),o[1],0,0,0), C1,12); \
    }while(0)
  int t=1;
  #define ENDW(tt) do{ if((tt)+3<NT){WAIT_BAR(2);} else if((tt)+2<NT){WAIT_BAR(1);} else {WAIT_BAR(0);} }while(0)
  for(;t<7&&t+1<NT;t+=2){
    STEP(pB0,pB1,pA0,pA1,t,(t+3<NT),(t+1<NT),(t+1<NT));       ENDW(t);   RESC(); ROT();
    STEP(pA0,pA1,pB0,pB1,t+1,(t+4<NT),(t+2<NT),(t+2<NT));     ENDW(t+1); RESC(); ROT();
  }
  #pragma push_macro("CMASK")
  #undef CMASK
  #define CMASK(P0,P1,t) do{ if(mixed){ const unsigned sel_=sel; if(((sel_>>(TKT(t)>>2))&1u)==0u){ _Pragma("unroll") for(int r=0;r<16;++r){P0[r]=-INFINITY;P1[r]=-INFINITY;} } } }while(0)
  for(;t+5<NT;t+=2){
    STEP(pB0,pB1,pA0,pA1,t,true,true,true);     WAIT_BAR(2); RESC(); ROT();
    STEP(pA0,pA1,pB0,pB1,t+1,true,true,true);   WAIT_BAR(2); RESC(); ROT();
  }
  #pragma pop_macro("CMASK")
  for(;t+1<NT;t+=2){
    STEP(pB0,pB1,pA0,pA1,t,(t+3<NT),(t+1<NT),(t+1<NT));       ENDW(t);   RESC(); ROT();
    STEP(pA0,pA1,pB0,pB1,t+1,(t+4<NT),(t+2<NT),(t+2<NT));     ENDW(t+1); RESC(); ROT();
  }
  STEP(pB0,pB1,pA0,pA1,NT-1,false,false,false); RESC();
  if(Qnext){
    #pragma unroll
    for(int d0=0;d0<4;++d0)qr[d0]=*reinterpret_cast<const bf16x8*>(&Qnext[(long)(wid*QBLK+r32)*DM+d0*16+hi*8]); }
  { float sacc=pB0[0]+pB0[1]; _Pragma("unroll") for(int r=2;r<16;++r)sacc+=pB0[r]; _Pragma("unroll") for(int r=0;r<16;++r)sacc+=pB1[r]; l_reg+=sacc;
    pw0=(u32x4){PKW(pB0,0),PKW(pB0,2),PKW(pB0,4),PKW(pB0,6)};pw1=(u32x4){PKW(pB0,8),PKW(pB0,10),PKW(pB0,12),PKW(pB0,14)};pw2=(u32x4){PKW(pB1,0),PKW(pB1,2),PKW(pB1,4),PKW(pB1,6)};pw3=(u32x4){PKW(pB1,8),PKW(pB1,10),PKW(pB1,12),PKW(pB1,14)};
    SBAR(); pv(o,vb0+sl_cur,PAF(0),PAF(1),PAF(2),PAF(3)); }
  #undef PKW
  #undef PAF
  #undef VFR
  #undef PIN
  #undef MX3
  #undef GAPA
  #undef GAPB
  #undef EX
  #undef VRD
  #undef KRD
  #undef STEP
  #undef ENDW
  {auto rr=__builtin_amdgcn_permlane32_swap(__float_as_uint(l_reg),__float_as_uint(l_reg),false,false);l_reg=__uint_as_float(rr[0])+__uint_as_float(rr[1]);}
  if(hi==0)wsf[32+r32]=l_reg;asm volatile("s_waitcnt lgkmcnt(0)":::"memory");
  float rli[16];
  #pragma unroll
  for(int r=0;r<16;++r)rli[r]=__builtin_amdgcn_rcpf(wsf[32+crow(r,hi)]);
  bf16*Ow=O+(rowbase+q0+wid*QBLK)*DM+h*D;
  { bf16*stg=(bf16*)(shm+LDS_OST)+wid*2048;
    #pragma unroll
    for(int r=0;r<16;++r){const int orow=crow(r,hi);
      #pragma unroll
      for(int d0=0;d0<2;++d0)stg[orow*64+d0*32+r32]=(bf16)(o[d0][r]*rli[r]);}
    asm volatile("s_waitcnt lgkmcnt(0)":::"memory");
    #pragma unroll
    for(int i=0;i<4;++i){const int row=i*8+(lane>>3),ch=lane&7; const u32x4 v=*(const u32x4*)(stg+row*64+ch*8); ATTN_STORE16(Ow+(long)row*DM+ch*8,v);} }
  asm volatile("s_waitcnt lgkmcnt(0)\n\ts_barrier":::"memory");
  #undef DMA_K
  #undef DMA_V
  #undef CMASK
  #undef START
  #undef RESC
  #undef ROT
}
constexpr int ATTN_LDS_BYTES=LDS_TOTAL;
#undef SBAR
#undef WAIT_BAR
}

constexpr int KP = 144, TILE_B = 64 * KP;
constexpr int A_K = 0, A_V = 2 * TILE_B, A_KM = 4 * TILE_B, A_BT = A_KM + 2048, A_FL = A_BT + 1280, NBT = 320;

#define ATT_COMMON_SETUP \
    int tid_ = mk_tid(); asm volatile("" : "+v"(tid_)); \
    const int tid = tid_, lane = tid & 63, w = __builtin_amdgcn_readfirstlane(tid >> 6), r = lane & 31, hh = lane >> 5; \
    const int srow = tid >> 3, sch = tid & 7; \
    const int i16 = lane & 15, q4 = i16 >> 2, p4 = i16 & 3, blk = (lane >> 4) & 1; \
    const int voff = (4 * hh + q4) * KP + (16 * blk + 4 * p4) * 2; \
    const int koff = r * KP + 16 * hh; \
    const h16* Qb = (const h16*)(P.ws + WS_Q); const h16* Kb = (const h16*)(P.ws + WS_K); const h16* Vb = (const h16*)(P.ws + WS_V); h16* Ob = (h16*)(P.ws + WS_O);

#define ATT_QK(s, kbuf, cinit) do { h16x8 kf_[2][4]; \
        _Pragma("unroll") for (int kb = 0; kb < 2; ++kb) _Pragma("unroll") for (int ks = 0; ks < 4; ++ks) kf_[kb][ks] = *(const LAS h16x8*)((kbuf) + koff + kb * 32 * KP + ks * 32); \
        __builtin_amdgcn_sched_barrier(0); \
        _Pragma("unroll") for (int kb = 0; kb < 2; ++kb) _Pragma("unroll") for (int i = 0; i < 16; ++i) s[kb][i] = (cinit); \
        _Pragma("unroll") for (int ks = 0; ks < 4; ++ks) _Pragma("unroll") for (int kb = 0; kb < 2; ++kb) s[kb] = MFMA32(kf_[kb][ks], qf[ks], s[kb]); } while (0)
#define ATT_QK_ACC(s, kbuf) do { h16x8 kf_[2][4]; \
        _Pragma("unroll") for (int kb = 0; kb < 2; ++kb) _Pragma("unroll") for (int ks = 0; ks < 4; ++ks) kf_[kb][ks] = *(const LAS h16x8*)((kbuf) + koff + kb * 32 * KP + ks * 32); \
        __builtin_amdgcn_sched_barrier(0); \
        _Pragma("unroll") for (int ks = 0; ks < 4; ++ks) _Pragma("unroll") for (int kb = 0; kb < 2; ++kb) s[kb] = MFMA32(kf_[kb][ks], qf[ks], s[kb]); } while (0)
#define ATT_LOADV(vf, vbuf) do { _Pragma("unroll") for (int s4 = 0; s4 < 4; ++s4) _Pragma("unroll") for (int db = 0; db < 2; ++db) { const LAS unsigned char* vp = (vbuf) + voff + 16 * s4 * KP + 64 * db; vf[s4][db] = tr8(vp, vp + 8 * KP); } \
        __builtin_amdgcn_sched_barrier(0); } while (0)
#define ATT_PV(o, s, vf) do { _Pragma("unroll") for (int s4 = 0; s4 < 4; ++s4) { const h16x8 pf = pack8(s[s4 >> 1], s4 & 1); \
        _Pragma("unroll") for (int db = 0; db < 2; ++db) o[db] = MFMA32(vf[s4][db], pf, o[db]); } } while (0)

__device__ __forceinline__ void p_attn_moba(const Params& P, unsigned char* lds_generic) {
    int prev_bh = -1;
    const h16* Qg = (const h16*)(P.ws + WS_Q);
#define MOBA_QBASE(L_) (Qg + ((size_t)((((L_) & 255) + 256 * ((L_) >> 11)) >> 4) * SEQ + 256 * (((L_) >> 8) & 7)) * DM + ((((L_) & 255) + 256 * ((L_) >> 11)) & 15) * DH)
    attn_body::bf16x8 qr[4];
    { int tid_ = mk_tid(); asm volatile("" : "+v"(tid_)); const int lane_ = tid_ & 63, wid_ = tid_ >> 6; const h16* q0p = MOBA_QBASE((int)blockIdx.x) + (size_t)(wid_ * 32 + (lane_ & 31)) * DM + (lane_ >> 5) * 8;
#pragma unroll
      for (int d0 = 0; d0 < 4; ++d0) qr[d0] = *reinterpret_cast<const attn_body::bf16x8*>(q0p + d0 * 16); }
    for (int L = blockIdx.x; L < 4096; L += gridDim.x) {
        const int qb = (L >> 8) & 7, bh = (L & 255) + 256 * (L >> 11), b = bh >> 4, h = bh & 15; const int Ln = L + (int)gridDim.x;
        attn_body::attn_unit<8>(b, h, qb, Qg, (const h16*)(P.ws + WS_K), (const h16*)(P.ws + WS_V), (h16*)(P.ws + WS_O), (char*)lds_generic,
                                (const float*)(P.ws + WS_KM) + (size_t)bh * 512, P.rel_bias, bh != prev_bh, qr, Ln < 4096 ? MOBA_QBASE(Ln) : nullptr);
        prev_bh = bh;
    }
}

__device__ __forceinline__ void p_attn_sb(const Params& P, LAS unsigned char* lds) {
    ATT_COMMON_SETUP
    LAS int* flags = (LAS int*)(lds + A_FL);
    h16x8 uf[2], ones;
#pragma unroll
    for (int ks = 0; ks < 2; ++ks)
#pragma unroll
        for (int jj = 0; jj < 8; ++jj) { const int k = 16 * ks + 8 * (jj >> 2) + 4 * hh + (jj & 3); uf[ks][jj] = (k > r) ? (h16)1.0f : (h16)0.0f; }
#pragma unroll
    for (int jj = 0; jj < 8; ++jj) ones[jj] = (h16)1.0f;
    for (int L = blockIdx.x; L < 4096; L += gridDim.x) {
        const int qb = (L >> 8) & 7, bh = (L & 255) + 256 * (L >> 11), b = bh >> 4, h = bh & 15;
        const size_t tokbase = (size_t)b * SEQ;
        const h16* Kg = Kb + (size_t)bh * SEQ * DH; const h16* Vg = Vb + (size_t)bh * SEQ * DH;
        const int t = 256 * qb + 32 * w + r;
        const int nt = 4 * qb + 4;
        __syncthreads();
        if (tid < 16) flags[tid] = 0;
        { const size_t go = (size_t)(64 * (nt - 1) + srow) * DH + sch * 8; const u32x4 k0 = *(const u32x4*)(Kg + go), v0 = *(const u32x4*)(Vg + go);
          *(LAS u32x4*)(lds + A_K + srow * KP + sch * 16) = k0; *(LAS u32x4*)(lds + A_V + srow * KP + sch * 16) = v0; }
        h16x8 qf[4];
        { const h16* qp = Qb + (tokbase + t) * DM + h * DH + 8 * hh;
#pragma unroll
          for (int ks = 0; ks < 4; ++ks) qf[ks] = *(const h16x8*)(qp + 16 * ks); }
        __syncthreads();
        float carry = 0.f; bool wdone = false; f32x16 o[2];
#pragma unroll
        for (int i = 0; i < 16; ++i) { o[0][i] = 0.f; o[1][i] = 0.f; }
        for (int j = 0; j < nt; ++j) {
            const int kt = nt - 1 - j; const bool more = (j + 1 < nt);
            const size_t go = (size_t)(64 * (more ? kt - 1 : kt) + srow) * DH + sch * 8; const u32x4 kreg = *(const u32x4*)(Kg + go), vreg = *(const u32x4*)(Vg + go);
            const LAS unsigned char* kbuf = lds + A_K + (j & 1) * TILE_B; const LAS unsigned char* vbuf = lds + A_V + (j & 1) * TILE_B;
            const int jo = kt - 4 * qb;
            const bool active = !wdone && (jo < 0 || 2 * jo <= w);
            if (active) {
                f32x16 z[2], lk[2];
                const bool diag = (64 * kt + 63 >= 256 * qb + 32 * w);
                const int sb = 64 * kt;
                if (diag) {
#pragma unroll
                    for (int kb = 0; kb < 2; ++kb)
#pragma unroll
                        for (int i = 0; i < 16; ++i) z[kb][i] = (sb + 32 * kb + crow(i, hh) < t) ? 0.f : -1.0e30f;
                } else {
#pragma unroll
                    for (int i = 0; i < 16; ++i) { z[0][i] = 0.f; z[1][i] = 0.f; } }
                ATT_QK_ACC(z, kbuf);
                h16x8 vf[4][2]; ATT_LOADV(vf, vbuf);
#pragma unroll
                for (int kb = 0; kb < 2; ++kb)
#pragma unroll
                    for (int i = 0; i < 16; ++i) { const float zz = z[kb][i]; const float e = ex2(-fabsf(zz)); lk[kb][i] = -(fmaxf(zz, 0.f) + lg2(1.0f + e)); }
                const h16x8 x00 = pack8(lk[0], 0), x01 = pack8(lk[0], 1), x10 = pack8(lk[1], 0), x11 = pack8(lk[1], 1);
                const float lk00 = lk[0][0], lb00 = z[0][0] + lk00;
#pragma unroll
                for (int i = 0; i < 16; ++i) { z[0][i] += lk[0][i]; z[1][i] += lk[1][i]; }
                z[0][0] = 0.f;
                f32x16 y0 = MFMA32(uf[0], x00, z[0]), y1 = MFMA32(uf[0], x10, z[1]);
                y0 = MFMA32(uf[1], x01, y0); y1 = MFMA32(uf[1], x11, y1); y0 = MFMA32(ones, x10, y0); y0 = MFMA32(ones, x11, y0);
                float tot = y0[0] + lk00;
                { auto rr_ = __builtin_amdgcn_permlane32_swap(__float_as_uint(tot), __float_as_uint(tot), false, false); tot = __uint_as_float(rr_[0]); }
                y0[0] += lb00;
#pragma unroll
                for (int i = 0; i < 16; ++i) { z[0][i] = ex2(y0[i] + carry); z[1][i] = ex2(y1[i] + carry); }
                carry += tot;
                ATT_PV(o, z, vf);
                wdone = (__ballot(carry < -151.0f) == ~0ull);
            }
            if (wdone && lane == 0) flags[(j & 1) * 8 + w] = 1;
            if (more) { *(LAS u32x4*)(lds + A_K + ((j + 1) & 1) * TILE_B + srow * KP + sch * 16) = kreg; *(LAS u32x4*)(lds + A_V + ((j + 1) & 1) * TILE_B + srow * KP + sch * 16) = vreg; }
            __syncthreads();
            const u32x4 fa_ = *(const LAS u32x4*)(flags + (j & 1) * 8), fb_ = *(const LAS u32x4*)(flags + (j & 1) * 8 + 4);
            if ((fa_.x + fa_.y + fa_.z + fa_.w) + (fb_.x + fb_.y + fb_.z + fb_.w) == 8u) break;
        }
        h16* op = Ob + (tokbase + t) * DM + h * DH + 4 * hh;
#pragma unroll
        for (int db = 0; db < 2; ++db)
#pragma unroll
            for (int gq = 0; gq < 4; ++gq) { u32x2 wv; wv.x = pk2h(o[db][4 * gq], o[db][4 * gq + 1]); wv.y = pk2h(o[db][4 * gq + 2], o[db][4 * gq + 3]); *(u32x2*)(op + 32 * db + 8 * gq) = wv; }
    }
}

__global__ void __launch_bounds__(NT) fwd_megakernel(Params P) {
    extern __shared__ __attribute__((aligned(16))) unsigned char lds_raw[];
    LAS unsigned char* lds = (LAS unsigned char*)lds_raw;
    cg::grid_group grid = cg::this_grid();
    { const unsigned hw = (unsigned)__builtin_amdgcn_s_getreg((5 << 11) | 4) & 63u; ((LAS int*)(uintptr_t)MK_WTAB)[hw] = (int)(threadIdx.x >> 6); }
    __syncthreads();
    const int lo = P.ph_lo, hi = P.ph_hi, G = gridDim.x, c = blockIdx.x;
#define RUN(k) (lo <= (k) && (k) < hi)
#define SEAM(k) do { if (RUN(k) && hi - lo > 1) xcd_barrier(bar); } while (0)
    volatile unsigned* st = (volatile unsigned*)(P.ws + WS_BARST) + 4 * blockIdx.x;
    XcdBarrier bar; bar.bar = (unsigned*)(P.ws + WS_BAR); bar.x = 0; bar.st = nullptr;
    if (hi - lo > 1) bar = xcd_barrier_post((unsigned*)(P.ws + WS_BAR), st);
    if (hi < 0) grid.sync();
    h16* Xh = (h16*)(P.ws + WS_X16); h16* Y1 = (h16*)(P.ws + WS_YA); h16* Y2 = (h16*)(P.ws + WS_YB); h16* Qh = (h16*)(P.ws + WS_Q); h16* Oh = (h16*)(P.ws + WS_O); h16* Uh = (h16*)(P.ws + WS_U);
    pg8::f32x2_t* ST1 = (pg8::f32x2_t*)(P.ws + WS_ST1); pg8::f32x2_t* ST2 = (pg8::f32x2_t*)(P.ws + WS_ST2); const float* CS = (const float*)(P.ws + WS_CS); const float* BW = CS + NCS;
    const LAS unsigned char* tbl = lds + ST_OFF;
    if (RUN(0)) p_prologue(P, lds);
    SEAM(0);
#pragma unroll 1
    for (int l = 0; l < DEPTH; ++l) {
        const int pb = 1 + 8 * l; unsigned char* wl = P.ws + WS_W + (size_t)l * W_LAYER_B;
        const h16* Wqkv = (const h16*)wl; const h16* Wo = (const h16*)(wl + W_QKV_B); const h16* Wup = (const h16*)(wl + W_QKV_B + W_O_B); const h16* Wdn = (const h16*)(wl + W_QKV_B + W_O_B + W_UP_B);
        if (RUN(pb + 0)) {
            pg8::StaticOrder S; S.init(M_TOK, 3 * DM, G, c);
            if (l == 0) { pg8::Gemm g{Xh, Wqkv, M_TOK, 3 * DM, DM}; pg8::Epi<0, false> E{Qh, DM, DM, (size_t)(WS_K - WS_Q) / 2, QSCALE, nullptr, 0.f, nullptr, nullptr};
                pg8::gemm_phase<pg8::Epi<0, false>, pg8::StaticOrder, true, true>(lds, g, S, E); }
            else { p_fill_tables(lds, (const float*)ST2, S, CS + 8192, BW + 8192);
                pg8::Gemm g{Y2, Wqkv, M_TOK, 3 * DM, DM}; pg8::Epi<0, true> E{Qh, DM, DM, (size_t)(WS_K - WS_Q) / 2, QSCALE, nullptr, 0.f, tbl, nullptr};
                pg8::gemm_phase<pg8::Epi<0, true>, pg8::StaticOrder, true, true>(lds, g, S, E); } }
        SEAM(pb + 0);
        if (RUN(pb + 2)) { if (l == 0) { p_cs_finalize(P); p_attn_moba(P, lds_raw); } else p_attn_sb(P, lds); }
        SEAM(pb + 2);
        if (RUN(pb + 3)) {
            pg8::Gemm g{Oh, Wo, M_TOK, DM, DM}; pg8::StaticOrder S; S.init(M_TOK, DM, G, c); S.rev = 1;
            if (l == 0) { pg8::Epi<2, false> E{Y1, DM, 0, 0, 1.f, Xh, ALPHA, nullptr, ST1};
                pg8::gemm_phase<pg8::Epi<2, false>, pg8::StaticOrder, true, true>(lds, g, S, E); }
            else { p_fill_tables(lds, (const float*)ST2, S, P.ln_ffn_g + (l - 1) * DM, P.ln_ffn_b + (l - 1) * DM);
                pg8::Epi<2, true> E{Y1, DM, 0, 0, 1.f, Y2, ALPHA, tbl, ST1};
                pg8::gemm_phase<pg8::Epi<2, true>, pg8::StaticOrder, true, true>(lds, g, S, E); } }
        SEAM(pb + 3);
        if (RUN(pb + 5)) {
            pg8::Gemm g{Y1, Wup, M_TOK, FF, DM}; pg8::StaticOrder S; S.init(M_TOK, FF, G, c);
            p_fill_tables(lds, (const float*)ST1, S, CS + l * 4096, BW + l * 4096);
            pg8::Epi<1, true> E{Uh, FF, 0, 0, 1.f, nullptr, 0.f, tbl, nullptr};
            pg8::gemm_phase<pg8::Epi<1, true>, pg8::StaticOrder, true, true>(lds, g, S, E); }
        SEAM(pb + 5);
        if (RUN(pb + 6)) {
            pg8::Gemm g{Uh, Wdn, M_TOK, DM, FF}; pg8::StaticOrder S; S.init(M_TOK, DM, G, c); S.rev = 1;
            p_fill_tables(lds, (const float*)ST1, S, P.ln_mix_g + l * DM, P.ln_mix_b + l * DM);
            pg8::Epi<2, true> E{Y2, DM, 0, 0, 1.f, Y1, ALPHA, tbl, ST2};
            pg8::gemm_phase<pg8::Epi<2, true>, pg8::StaticOrder, true, true>(lds, g, S, E); }
        if (l + 1 < DEPTH) SEAM(pb + 6);
    }
    if (RUN(NPHASE - 1)) { if (RUN(NPHASE - 2)) xcd_barrier(bar); p_ln<true>(Y2, nullptr, P.out, P.ln_ffn_g + (DEPTH - 1) * DM, P.ln_ffn_b + (DEPTH - 1) * DM, (const float*)ST2); }
#undef RUN
#undef SEAM
}

extern "C" void kernel_launch(void* const* d_in, const int* in_sizes, int n_in, void* d_out, int out_size, void* d_ws, size_t ws_size, hipStream_t stream) {
    static int grid = 0;
    if (grid == 0) {
        if (n_in != 10 || in_sizes[0] != M_TOK * DM || out_size != M_TOK * DM || ws_size < WS_END) { fprintf(stderr, "kernel_launch: unexpected shapes / workspace (%d inputs, x %d, out %d, ws %zu < %zu)\n", n_in, n_in > 0 ? in_sizes[0] : -1, out_size, ws_size, (size_t)WS_END); grid = -1; return; }
        int dev = 0, cus = 0, per_cu = 0;
        (void)hipGetDevice(&dev); (void)hipDeviceGetAttribute(&cus, hipDeviceAttributeMultiprocessorCount, dev);
        if (hipFuncSetAttribute((const void*)fwd_megakernel, hipFuncAttributeMaxDynamicSharedMemorySize, LDS_BYTES) != hipSuccess) { fprintf(stderr, "kernel_launch: hipFuncSetAttribute failed\n"); grid = -1; return; }
        if (hipOccupancyMaxActiveBlocksPerMultiprocessor(&per_cu, (const void*)fwd_megakernel, NT, LDS_BYTES) != hipSuccess || per_cu < 1) { fprintf(stderr, "kernel_launch: occupancy query says %d blocks per CU\n", per_cu); per_cu = 1; }
        (void)hipGetLastError();
        grid = cus > 0 ? cus : 256;
    }
    if (grid < 0) return;
    Params p{};
    p.x = (const float*)d_in[0]; p.rel_bias = (const float*)d_in[1]; p.w_qkv = (const float*)d_in[2]; p.w_o = (const float*)d_in[3]; p.ln_mix_g = (const float*)d_in[4]; p.ln_mix_b = (const float*)d_in[5];
    p.w_up = (const float*)d_in[6]; p.w_down = (const float*)d_in[7]; p.ln_ffn_g = (const float*)d_in[8]; p.ln_ffn_b = (const float*)d_in[9]; p.out = (float*)d_out; p.ws = (unsigned char*)d_ws;
#if MK_LAUNCHES == 1
    p.ph_lo = 0; p.ph_hi = NPHASE;
    if (hipMemsetAsync((char*)d_ws + WS_BAR, 0, CTL_BYTES, stream) != hipSuccess) { fprintf(stderr, "kernel_launch: hipMemsetAsync of the barrier words failed\n"); return; }
    void* args[] = {&p};
    const hipError_t e = hipLaunchCooperativeKernel((const void*)fwd_megakernel, dim3(grid), dim3(NT), args, LDS_BYTES, stream);
    if (e != hipSuccess) fprintf(stderr, "kernel_launch: cooperative launch failed: %s (grid %d)\n", hipGetErrorString(e), grid);
#else
    for (int ph = 0; ph < NPHASE; ++ph) { if (ph == 2 || ph == 10 || ph == 5 || ph == 8 || ph == 13) continue;
        p.ph_lo = ph; p.ph_hi = ph + 1; hipLaunchKernelGGL(fwd_megakernel, dim3(grid), dim3(NT), LDS_BYTES, stream, p); }
#endif
}
```

```cpp
#include <hip/hip_runtime.h>
#include <hip/hip_cooperative_groups.h>
#include <cstdio>
#include <cstdint>
namespace cg = cooperative_groups;
constexpr unsigned MK_WTAB = 131072u + 20480u;
__device__ __forceinline__ int mk_tid() {
    const unsigned hw = (unsigned)__builtin_amdgcn_s_getreg((5 << 11) | 4) & 63u;
    const int wave = ((const __attribute__((address_space(3))) int*)(uintptr_t)MK_WTAB)[hw];
    int lane; asm volatile("v_mbcnt_lo_u32_b32 %0, -1, 0\n\tv_mbcnt_hi_u32_b32 %0, -1, %0" : "=v"(lane));
    return __builtin_amdgcn_readfirstlane(wave) * 64 + lane;
}
namespace pg8 {
#define PG8_LAS __attribute__((address_space(3)))
typedef _Float16 bf16_t;
typedef _Float16 bf16x8 __attribute__((ext_vector_type(8)));
typedef float f32x4 __attribute__((ext_vector_type(4)));
typedef unsigned u32x4 __attribute__((ext_vector_type(4)));
constexpr int BM = 256, BK = 64, HALF = 128, HTB = HALF * BK * 2  , STAGE_BYTES = 8 * HTB, NXCD = 8, WGM = 8;

__host__ __device__ __forceinline__ int lds_byte(int r, int c) { const int st = (r >> 4) * 2 + (c >> 5), rr = r & 15, cc = c & 31, ob = rr * 64 + cc * 2; return st * 1024 + (ob ^ (((ob >> 9) & 1) << 5)); }
__host__ __device__ __forceinline__ void stage_rc(int b, int& R, int& C) { const int st = b / 1024, sb = b % 1024, swz = sb ^ (((sb >> 9) & 1) << 5); R = (st >> 1) * 16 + swz / 64; C = (st & 1) * 32 + (swz % 64) / 2; }
__host__ __device__ __forceinline__ int perm32(int rho) { const int n = rho >> 4, i = rho & 15; return 8 * (i >> 2) + 4 * n + (i & 3); }

struct Unit { int pm, pn; };
struct Gemm { const bf16_t* A; const bf16_t* Bt; int M, N, K; };

struct StaticOrder {
    int nM, nN, nwg, G, c, rev;
    __host__ __device__ void init(int M, int N, int G_, int c_) { nM = M / BM; nN = N / BM; nwg = nM * nN; G = G_; c = c_; rev = 0; }
    __host__ __device__ bool next(int i, Unit& u) const {
        const long L = (long)i * G + c; if (L >= nwg) return false;
        int wgid = (int)L; { const int q = nwg / NXCD, r = nwg % NXCD, xcd = wgid % NXCD, off = wgid / NXCD; wgid = (xcd < r ? xcd * (q + 1) : r * (q + 1) + (xcd - r) * q) + off; }
        const int nig = WGM * nN, gid = wgid / nig, fm = gid * WGM, gsz = (nM - fm) < WGM ? (nM - fm) : WGM;
        u.pm = fm + ((wgid % nig) % gsz); u.pn = (wgid % nig) / gsz; if (rev) u.pm = nM - 1 - u.pm; return true;
    }
    __device__ __forceinline__ void a_ready(const Unit&) const {}
    __device__ __forceinline__ void done(const Unit&) const {}
};


typedef _Float16 h16x2_t __attribute__((ext_vector_type(2)));
__device__ __forceinline__ unsigned pk2h(float lo, float hi) { h16x2_t v = {(_Float16)lo, (_Float16)hi}; return __builtin_bit_cast(unsigned, v); }
typedef float f32x2_t __attribute__((ext_vector_type(2)));
template <int MODE, bool FOLD> struct Epi {
    static constexpr bool PERM = true, AFTER_DRAIN = false;
    bf16_t* O; int ldc; int split_cols; size_t split_stride; float scale0; const bf16_t* R; float alpha;
    const PG8_LAS unsigned char* tb; f32x2_t* part;
    __device__ __forceinline__ void operator()(const f32x4 (&acc)[2][2][4][2], const Unit& u, int ui, int wr, int wc, int fr, int fq) const {
        const int row0 = u.pm * BM + wr * 64 + fr; int colt = u.pn * BM; bf16_t* base = O;
        float sc = 1.f; bool hm = false;
        if (MODE == 0 && split_cols) { const int t = colt / split_cols; base += (size_t)t * split_stride; colt -= t * split_cols; if (t == 0) sc = scale0; else hm = true; }
        const int col0 = colt + wc * 32 + 8 * fq;
        f32x4 cv[2][2], bv[2][2]; int pslot = 0;
        if (FOLD) { const PG8_LAS int* sl = (const PG8_LAS int*)(tb + 16384); pslot = sl[ui] * 256; const int cslot = sl[16 + ui] * 256 + wc * 32 + 8 * fq;
            const PG8_LAS float* csl = (const PG8_LAS float*)(tb + 8192); const PG8_LAS float* bwl = (const PG8_LAS float*)(tb + 12288);
#pragma unroll
            for (int bj = 0; bj < 2; ++bj)
#pragma unroll
                for (int n = 0; n < 2; ++n) { cv[bj][n] = *(const PG8_LAS f32x4*)(csl + cslot + bj * HALF + 4 * n); bv[bj][n] = *(const PG8_LAS f32x4*)(bwl + cslot + bj * HALF + 4 * n); } }
#pragma unroll
        for (int ai = 0; ai < 2; ++ai) {
        bf16x8 rr[4][2];
        if (MODE == 2) {
#pragma unroll
            for (int m = 0; m < 4; ++m)
#pragma unroll
                for (int bj = 0; bj < 2; ++bj) rr[m][bj] = *(const bf16x8*)(R + (size_t)(row0 + ai * HALF + m * 16) * ldc + col0 + bj * HALF);
            __builtin_amdgcn_sched_barrier(0); }
#pragma unroll
            for (int m = 0; m < 4; ++m) { const int row = row0 + ai * HALF + m * 16; const size_t off = (size_t)row * ldc + col0;
                float mu = 0.f, rs = 1.f; if (FOLD) { const f32x2_t ms = ((const PG8_LAS f32x2_t*)tb)[pslot + ai * HALF + wr * 64 + m * 16 + fr]; mu = ms.x; rs = ms.y; }
                float ssum = 0.f, ssq = 0.f;
#pragma unroll
                for (int bj = 0; bj < 2; ++bj) { f32x4 v0 = acc[ai][bj][m][0], v1 = acc[ai][bj][m][1];
                    if (FOLD && MODE != 2) { v0 = (v0 - mu * cv[bj][0]) * rs + bv[bj][0]; v1 = (v1 - mu * cv[bj][1]) * rs + bv[bj][1]; }
                    if (MODE == 0) { v0 = v0 * sc; v1 = v1 * sc; }
                    if (MODE == 1) { v0 = __builtin_elementwise_max(v0, (f32x4){0.f, 0.f, 0.f, 0.f}); v1 = __builtin_elementwise_max(v1, (f32x4){0.f, 0.f, 0.f, 0.f}); v0 = v0 * v0; v1 = v1 * v1; }
                    if (MODE == 2) { const bf16x8 r = rr[m][bj];
                        f32x4 h0 = (f32x4){(float)r[0], (float)r[1], (float)r[2], (float)r[3]}, h1 = (f32x4){(float)r[4], (float)r[5], (float)r[6], (float)r[7]};
                        if (FOLD) { h0 = (h0 - mu) * rs * cv[bj][0] + bv[bj][0]; h1 = (h1 - mu) * rs * cv[bj][1] + bv[bj][1]; }
                        v0 = v0 + alpha * h0; v1 = v1 + alpha * h1;
                        ssum += (v0[0] + v0[1]) + (v0[2] + v0[3]) + (v1[0] + v1[1]) + (v1[2] + v1[3]);
                        ssq += (v0[0] * v0[0] + v0[1] * v0[1]) + (v0[2] * v0[2] + v0[3] * v0[3]) + (v1[0] * v1[0] + v1[1] * v1[1]) + (v1[2] * v1[2] + v1[3] * v1[3]); }
                    u32x4 w; w.x = pk2h(v0[0], v0[1]); w.y = pk2h(v0[2], v0[3]); w.z = pk2h(v1[0], v1[1]); w.w = pk2h(v1[2], v1[3]);
                    if (MODE == 0 && hm) { const int cc = col0 + bj * HALF; *(u32x4*)(base + ((size_t)(row >> 11) * 16 + (cc >> 6)) * 131072 + (size_t)(row & 2047) * 64 + (cc & 63)) = w; }
                    else *(u32x4*)(base + off + bj * HALF) = w; }
                if (MODE == 2) { ssum += __shfl_xor(ssum, 16); ssq += __shfl_xor(ssq, 16); ssum += __shfl_xor(ssum, 32); ssq += __shfl_xor(ssq, 32);
                    if (fq == 0) part[(size_t)(row0 + ai * HALF + m * 16) * 16 + u.pn * 4 + wc] = (f32x2_t){ssum, ssq}; } }
        }
    }
};

template <class Epi, class Sched, bool ALIGN_EPI = false, bool SP2 = false>
__device__ __forceinline__ void gemm_phase(PG8_LAS unsigned char* lds, const Gemm g, const Sched& S, const Epi& E) {
    int tid_ = mk_tid(); asm volatile("" : "+v"(tid_));
    const int tid = tid_, wid = __builtin_amdgcn_readfirstlane(tid >> 6), lane = tid & 63, wr = wid >> 2, wc = wid & 3, fr = lane & 15, fq = lane >> 4;
    const int K = g.K, nt = K / BK;
    unsigned voffA[2], voffB[2];
#pragma unroll
    for (int i = 0; i < 2; ++i) { int R, C; stage_rc(tid * 16 + i * 8192, R, C); const int Rb = Epi::PERM ? ((R & ~31) + perm32(R & 31)) : R;
        voffA[i] = (unsigned)(R * K + C) * 2u; voffB[i] = (unsigned)(Rb * K + C) * 2u; }
    const size_t kstep = (size_t)(BK * 2);
    const size_t hstep = (size_t)HALF * K * 2;
    const size_t tstep = 2 * hstep;
    const unsigned ldsw = (unsigned)wid * 1024u;
    const int aoff = lds_byte(wr * 64 + fr, fq * 8), boff = lds_byte(wc * 32 + fr, fq * 8);
#define PG8_SA(b, h) (((b) * 2 + (h)) * HTB)
#define PG8_SB(b, h) ((4 + (b) * 2 + (h)) * HTB)
#define PG8_STAGE(bufoff, gbase, voff) do { _Pragma("unroll") for (int _i = 0; _i < 2; ++_i) \
        __builtin_amdgcn_global_load_lds((const unsigned*)((const char*)(gbase) + (voff)[_i]), (PG8_LAS unsigned*)(lds + (bufoff) + ldsw + _i * 8192), 16, 0, 0); } while (0)
#define PG8_LDA(dst, b, h) do { _Pragma("unroll") for (int m = 0; m < 4; ++m) _Pragma("unroll") for (int k = 0; k < 2; ++k) dst[m][k] = *(const PG8_LAS bf16x8*)(lds + PG8_SA(b, h) + aoff + m * 2048 + k * 1024); } while (0)
#define PG8_LDB(dst, b, h) do { _Pragma("unroll") for (int n = 0; n < 2; ++n) _Pragma("unroll") for (int k = 0; k < 2; ++k) dst[n][k] = *(const PG8_LAS bf16x8*)(lds + PG8_SB(b, h) + boff + n * 2048 + k * 1024); } while (0)
#define PG8_MMA(ai, bj, At, Bt) do { __builtin_amdgcn_s_setprio(1); _Pragma("unroll") for (int m = 0; m < 4; ++m) _Pragma("unroll") for (int n = 0; n < 2; ++n) _Pragma("unroll") for (int k = 0; k < 2; ++k) \
        acc[ai][bj][m][n] = __builtin_amdgcn_mfma_f32_16x16x32_f16(Bt[n][k], At[m][k], acc[ai][bj][m][n], 0, 0, 0); __builtin_amdgcn_s_setprio(0); } while (0)
#define PG8_WAIT_V(n) asm volatile("s_waitcnt vmcnt(" #n ")" ::: "memory")
#define PG8_WAIT_L(n) asm volatile("s_waitcnt lgkmcnt(" #n ")" ::: "memory")
#define PG8_BAR __builtin_amdgcn_s_barrier()
#define PG8_SCHED __builtin_amdgcn_sched_barrier(0)
    Unit cur, nxt; int ui = 0;
    if (!S.next(0, cur)) return;
    f32x4 acc[2][2][4][2];
#pragma unroll
    for (int a = 0; a < 2; ++a)
#pragma unroll
        for (int b = 0; b < 2; ++b)
#pragma unroll
            for (int m = 0; m < 4; ++m)
#pragma unroll
                for (int n = 0; n < 2; ++n) acc[a][b][m][n] = (f32x4){0.f, 0.f, 0.f, 0.f};
    bf16x8 At[4][2], B0[2][2], B1[2][2];
    const char* cA = (const char*)g.A + (size_t)cur.pm * tstep; const char* cB = (const char*)g.Bt + (size_t)cur.pn * tstep;
    S.a_ready(cur);
    if constexpr (SP2) {
        PG8_STAGE(PG8_SB(0, 0), cB, voffB); PG8_STAGE(PG8_SB(0, 1), cB + hstep, voffB); PG8_STAGE(PG8_SA(0, 0), cA, voffA); PG8_STAGE(PG8_SA(0, 1), cA + hstep, voffA);
        if (wr == 1) PG8_BAR;
        PG8_WAIT_V(2); PG8_BAR;
        PG8_STAGE(PG8_SB(1, 0), cB + kstep, voffB); PG8_STAGE(PG8_SA(1, 0), cA + kstep, voffA); PG8_STAGE(PG8_SB(1, 1), cB + hstep + kstep, voffB);
        PG8_WAIT_V(6); PG8_BAR;
    } else {
        PG8_STAGE(PG8_SB(0, 0), cB, voffB); PG8_STAGE(PG8_SA(0, 0), cA, voffA); PG8_STAGE(PG8_SB(0, 1), cB + hstep, voffB); PG8_STAGE(PG8_SA(0, 1), cA + hstep, voffA);
        if (wr == 1) PG8_BAR;
        PG8_WAIT_V(4); PG8_BAR;
        PG8_STAGE(PG8_SB(1, 0), cB + kstep, voffB); PG8_STAGE(PG8_SA(1, 0), cA + kstep, voffA); PG8_STAGE(PG8_SB(1, 1), cB + hstep + kstep, voffB);
        PG8_WAIT_V(6); PG8_BAR;
    }
    for (;;) {
        const bool has_next = S.next(ui + 1, nxt);
        const char* nA = has_next ? (const char*)g.A + (size_t)nxt.pm * tstep : cA; const char* nB = has_next ? (const char*)g.Bt + (size_t)nxt.pn * tstep : cB;
        for (int t = 0; t < nt; t += 2) {
            const bool last = (t == nt - 2);
            const char* a1 = cA + (size_t)(t + 1) * kstep;
            const char* a2 = last ? nA : cA + (size_t)(t + 2) * kstep; const char* b2 = last ? nB : cB + (size_t)(t + 2) * kstep;
            const char* a3 = a2 + kstep; const char* b3 = b2 + kstep;
            if (last && has_next) S.a_ready(nxt);
            if constexpr (SP2) {
            PG8_LDB(B0, 0, 0); PG8_LDB(B1, 0, 1); PG8_SCHED; PG8_LDA(At, 0, 0); PG8_STAGE(PG8_SA(1, 1), a1 + hstep, voffA);
            PG8_WAIT_V(8); PG8_WAIT_L(0); PG8_BAR; PG8_MMA(0, 0, At, B0); PG8_MMA(0, 1, At, B1); PG8_BAR; PG8_SCHED;
            PG8_LDA(At, 0, 1); PG8_STAGE(PG8_SB(0, 0), b2, voffB); PG8_STAGE(PG8_SB(0, 1), b2 + hstep, voffB); PG8_STAGE(PG8_SA(0, 0), a2, voffA);
            PG8_WAIT_V(8); PG8_WAIT_L(0); PG8_BAR; PG8_MMA(1, 0, At, B0); PG8_MMA(1, 1, At, B1); PG8_BAR; PG8_SCHED;
            PG8_LDB(B0, 1, 0); PG8_LDB(B1, 1, 1); PG8_SCHED; PG8_LDA(At, 1, 0); PG8_STAGE(PG8_SA(0, 1), a2 + hstep, voffA);
            PG8_WAIT_V(8); PG8_WAIT_L(0); PG8_BAR; PG8_MMA(0, 0, At, B0); PG8_MMA(0, 1, At, B1); PG8_BAR; PG8_SCHED;
            PG8_LDA(At, 1, 1); PG8_STAGE(PG8_SB(1, 0), b3, voffB); PG8_STAGE(PG8_SB(1, 1), b3 + hstep, voffB); PG8_STAGE(PG8_SA(1, 0), a3, voffA);
            PG8_WAIT_V(8); PG8_WAIT_L(0); PG8_BAR; PG8_MMA(1, 0, At, B0); PG8_MMA(1, 1, At, B1); PG8_BAR; PG8_SCHED;
            } else {
            PG8_LDB(B0, 0, 0); PG8_SCHED; PG8_LDA(At, 0, 0); PG8_STAGE(PG8_SA(1, 1), a1 + hstep, voffA);
            PG8_WAIT_L(8); PG8_BAR; PG8_WAIT_L(0); PG8_MMA(0, 0, At, B0); PG8_BAR; PG8_SCHED;
            PG8_LDB(B1, 0, 1); PG8_STAGE(PG8_SB(0, 0), b2, voffB);
            PG8_BAR; PG8_WAIT_L(0); PG8_MMA(0, 1, At, B1); PG8_BAR;
            PG8_LDA(At, 0, 1); PG8_STAGE(PG8_SA(0, 0), a2, voffA);
            PG8_BAR; PG8_WAIT_L(0); PG8_MMA(1, 0, At, B0); PG8_BAR; PG8_SCHED;
            PG8_STAGE(PG8_SB(0, 1), b2 + hstep, voffB);
            PG8_WAIT_V(6); PG8_BAR; PG8_MMA(1, 1, At, B1); PG8_BAR;
            PG8_LDB(B0, 1, 0); PG8_SCHED; PG8_LDA(At, 1, 0); PG8_STAGE(PG8_SA(0, 1), a2 + hstep, voffA);
            PG8_WAIT_L(8); PG8_BAR; PG8_WAIT_L(0); PG8_MMA(0, 0, At, B0); PG8_BAR; PG8_SCHED;
            PG8_LDB(B1, 1, 1); PG8_STAGE(PG8_SB(1, 0), b3, voffB);
            PG8_BAR; PG8_WAIT_L(0); PG8_MMA(0, 1, At, B1); PG8_BAR;
            PG8_LDA(At, 1, 1); PG8_STAGE(PG8_SA(1, 0), a3, voffA);
            PG8_BAR; PG8_WAIT_L(0); PG8_MMA(1, 0, At, B0); PG8_BAR; PG8_SCHED;
            PG8_STAGE(PG8_SB(1, 1), b3 + hstep, voffB);
            PG8_WAIT_V(6); PG8_BAR; PG8_MMA(1, 1, At, B1); PG8_BAR;
            }
        }
        if constexpr (ALIGN_EPI) { if (wr == 0) PG8_BAR; }
        if constexpr (!Epi::AFTER_DRAIN) { E(acc, cur, ui, wr, wc, fr, fq); S.done(cur); }
        if (!has_next) break;
#pragma unroll
        for (int a = 0; a < 2; ++a)
#pragma unroll
            for (int b = 0; b < 2; ++b)
#pragma unroll
                for (int m = 0; m < 4; ++m)
#pragma unroll
                    for (int n = 0; n < 2; ++n) acc[a][b][m][n] = (f32x4){0.f, 0.f, 0.f, 0.f};
        cur = nxt; cA = nA; cB = nB; ++ui;
        if constexpr (ALIGN_EPI) { if (wr == 1) PG8_BAR; }
    }
    PG8_WAIT_V(0);
    if constexpr (!ALIGN_EPI) { if (wr == 0) PG8_BAR; }
    PG8_BAR;
    if constexpr (Epi::AFTER_DRAIN) { E.fused(acc, cur, wr, wc, fr, fq, lds, wid, lane); S.done(cur); }
#undef PG8_SA
#undef PG8_SB
#undef PG8_STAGE
#undef PG8_LDA
#undef PG8_LDB
#undef PG8_MMA
#undef PG8_WAIT_V
#undef PG8_WAIT_L
#undef PG8_BAR
#undef PG8_SCHED
}
}

#define LAS __attribute__((address_space(3)))
typedef _Float16 h16;
typedef _Float16 h16x8 __attribute__((ext_vector_type(8)));
typedef _Float16 h16x4 __attribute__((ext_vector_type(4)));
typedef _Float16 h16x2 __attribute__((ext_vector_type(2)));
typedef __fp16 fp16x4v __attribute__((__vector_size__(4 * sizeof(__fp16))));
typedef float f32x4 __attribute__((ext_vector_type(4)));
typedef float f32x16 __attribute__((ext_vector_type(16)));
typedef unsigned u32x4 __attribute__((ext_vector_type(4)));
typedef unsigned u32x2 __attribute__((ext_vector_type(2)));

#ifndef REP_MOBA
#define REP_MOBA 1
#endif
#ifndef REP_PRO
#define REP_PRO 1
#endif
#ifndef REP_QKV
#define REP_QKV 1
#endif
#ifndef REP_WO
#define REP_WO 1
#endif
#ifndef REP_UP
#define REP_UP 1
#endif
#ifndef REP_DN
#define REP_DN 1
#endif
#ifndef REP_LN
#define REP_LN 1
#endif
#ifndef REP_SB
#define REP_SB 1
#endif
#ifndef MK_LAUNCHES
#define MK_LAUNCHES 1
#endif
constexpr int NT = 512, M_TOK = 65536, DM = 1024, SEQ = 2048, NH = 16, DH = 64, FF = 4096, NBLK = 8, DEPTH = 2, NPHASE = 17;
constexpr int ST_OFF = pg8::STAGE_BYTES, LDS_BYTES = pg8::STAGE_BYTES + 16 * 256 * 8;
constexpr float LN_EPS = 1e-5f, ALPHA = 1.41421356237309515f  , LOG2E = 1.44269504088896341f, QSCALE = 0.125f * LOG2E;
constexpr float NEG_INF = -__builtin_inff();
constexpr size_t ACT_B = (size_t)M_TOK * DM * 2;
constexpr size_t W_QKV_B = (size_t)3 * DM * DM * 2, W_O_B = (size_t)DM * DM * 2, W_UP_B = (size_t)FF * DM * 2, W_DN_B = (size_t)FF * DM * 2, W_LAYER_B = W_QKV_B + W_O_B + W_UP_B + W_DN_B;
constexpr int NCS = 4096 + 4096 + 3072;
constexpr size_t WS_BAR = 0  , WS_BARST = 16384  , CTL_BYTES = 16384 + 8192  ,
                 WS_W = 32768, WS_CS = WS_W + DEPTH * W_LAYER_B  , WS_CSP = WS_CS + 131072  , WS_ST1 = WS_CSP + (size_t)2 * 1048576,
                 WS_ST2 = WS_ST1 + (size_t)M_TOK * 128  , WS_X16 = WS_ST2 + (size_t)M_TOK * 128, WS_YA = WS_X16 + ACT_B, WS_YB = WS_YA + ACT_B, WS_KM = WS_YB + ACT_B,
                 WS_Q = WS_KM + (size_t)4096 * 64 * 4, WS_K = WS_Q + ACT_B, WS_V = WS_K + ACT_B, WS_O = WS_V + ACT_B,
                 WS_U = WS_Q  , WS_END = WS_Q + 4 * ACT_B;

struct Params { const float *x, *rel_bias, *w_qkv, *w_o, *ln_mix_g, *ln_mix_b, *w_up, *w_down, *ln_ffn_g, *ln_ffn_b; float* out; unsigned char* ws; int ph_lo, ph_hi; };

__device__ __forceinline__ unsigned pk2h(float lo, float hi) { h16x2 v = {(h16)lo, (h16)hi}; return __builtin_bit_cast(unsigned, v); }
__device__ __forceinline__ float ex2(float x) { return __builtin_amdgcn_exp2f(x); }
__device__ __forceinline__ float lg2(float x) { return __builtin_amdgcn_logf(x); }
__device__ __forceinline__ int crow(int i, int hh) { return (i & 3) + 8 * (i >> 2) + 4 * hh; }
#define MFMA32(a, b, c) __builtin_amdgcn_mfma_f32_32x32x16_f16((a), (b), (c), 0, 0, 0)
__device__ __forceinline__ h16x8 pack8(const f32x16& x, const int s) {
    h16x8 r; r[0] = (h16)x[8 * s + 0]; r[1] = (h16)x[8 * s + 1]; r[2] = (h16)x[8 * s + 2]; r[3] = (h16)x[8 * s + 3]; r[4] = (h16)x[8 * s + 4]; r[5] = (h16)x[8 * s + 5]; r[6] = (h16)x[8 * s + 6]; r[7] = (h16)x[8 * s + 7]; return r; }
__device__ __forceinline__ h16x8 tr8(const LAS unsigned char* p_lo, const LAS unsigned char* p_hi) {
    const h16x4 lo = __builtin_bit_cast(h16x4, __builtin_amdgcn_ds_read_tr16_b64_v4f16((LAS fp16x4v*)p_lo));
    const h16x4 hi = __builtin_bit_cast(h16x4, __builtin_amdgcn_ds_read_tr16_b64_v4f16((LAS fp16x4v*)p_hi));
    return __builtin_shufflevector(lo, hi, 0, 1, 2, 3, 4, 5, 6, 7); }

#define XB_TMO      128
#define XB_XCNT(j)  (256  + 64 * (j))
#define XB_XSUB(j)  (1280 + 64 * (j))
#define XB_XGEN(j)  (2304 + 64 * (j))
#define XB_TOP      3328
#define XB_TOPGEN   3392
#define XCD_BAR_WORDS 3456
#define XB_SPIN_CAP (1u << 18)

__device__ __forceinline__ unsigned xb_ld(unsigned* p)              { return __hip_atomic_load(p, __ATOMIC_RELAXED, __HIP_MEMORY_SCOPE_AGENT); }
__device__ __forceinline__ unsigned xb_add(unsigned* p, unsigned v) { return __hip_atomic_fetch_add(p, v, __ATOMIC_RELAXED, __HIP_MEMORY_SCOPE_AGENT); }
__device__ __forceinline__ unsigned xb_xcc_id() { return (unsigned)__builtin_amdgcn_s_getreg((3 << 11) | 20) & 0xFu; }
#define XB_SPIN(cond, bar) do { unsigned _sp = 0; while (cond) { __builtin_amdgcn_s_sleep(1); \
    if ((++_sp & 255u) == 0u) { if (xb_ld(&(bar)[XB_TMO])) break; if (_sp > XB_SPIN_CAP) { atomicAdd(&(bar)[XB_TMO], 1u); break; } } } } while (0)

struct XcdBarrier {
    unsigned* bar; unsigned x;
    volatile unsigned* st;
};

__device__ __forceinline__ XcdBarrier xcd_barrier_post(unsigned* bar, volatile unsigned* st) {
    XcdBarrier b; b.bar = bar; b.x = xb_xcc_id(); b.st = st;
    if (mk_tid() == 0) (void)xb_add(&bar[XB_XCNT(b.x)], 1u);
    return b;
}
__device__ __forceinline__ void xcd_barrier_complete(unsigned* bar, unsigned x, unsigned& nloc, unsigned& nx) {
    const unsigned G = gridDim.x * gridDim.y * gridDim.z;
    unsigned sum, cnt, mine, sp = 0u;
    for (;;) {
        sum = 0u; cnt = 0u; mine = 0u;
#pragma unroll
        for (unsigned j = 0; j < 16; ++j) { const unsigned c = xb_ld(&bar[XB_XCNT(j)]); sum += c; cnt += (c > 0u) ? 1u : 0u; mine = (j == x) ? c : mine; }
        if (sum == G) break;
        __builtin_amdgcn_s_sleep(1);
        if ((++sp & 255u) == 0u) { if (xb_ld(&bar[XB_TMO])) break; if (sp > XB_SPIN_CAP) { atomicAdd(&bar[XB_TMO], 1u); break; } }
    }
    nloc = mine > 0u ? mine : 1u; nx = cnt > 0u ? cnt : 1u;
}

__device__ __forceinline__ void xcd_barrier(const XcdBarrier& b) {
    asm volatile("s_waitcnt vmcnt(0)" ::: "memory");
    __syncthreads();
    if (mk_tid() == 0) {
        unsigned* bar = b.bar;
        __builtin_amdgcn_s_waitcnt(0);
        unsigned nloc = b.st[0], nx = b.st[1];
        if (nloc == 0u) { xcd_barrier_complete(bar, b.x, nloc, nx); b.st[0] = nloc; b.st[1] = nx; }
        const unsigned old = xb_add(&bar[XB_XSUB(b.x)], 1u);
        const unsigned gen = old / nloc;
        if (old + 1u == (gen + 1u) * nloc) {
            __builtin_amdgcn_fence(__ATOMIC_RELEASE, "agent");
            asm volatile("s_waitcnt vmcnt(0)" ::: "memory");
            const unsigned og = xb_add(&bar[XB_TOP], 1u);
            const unsigned tg = og / nx;
            if (og + 1u == (tg + 1u) * nx) xb_add(&bar[XB_TOPGEN], 1u);
            else XB_SPIN(xb_ld(&bar[XB_TOPGEN]) == tg, bar);
            __builtin_amdgcn_fence(__ATOMIC_ACQUIRE, "agent");
            xb_add(&bar[XB_XGEN(b.x)], 1u);
            asm volatile("s_waitcnt vmcnt(0)" ::: "memory");
        } else {
            XB_SPIN(xb_ld(&bar[XB_XGEN(b.x)]) == gen, bar);
            __builtin_amdgcn_fence(__ATOMIC_ACQUIRE, "agent");
            asm volatile("s_waitcnt vmcnt(0)" ::: "memory");
        }
    }
    __syncthreads();
}

__device__ __forceinline__ void p_prologue(const Params& P, LAS unsigned char* lds) {
    int tid_ = mk_tid(); asm volatile("" : "+v"(tid_)); const int tid = tid_, G = gridDim.x, c = blockIdx.x;
    { h16* Hh = (h16*)(P.ws + WS_X16); const size_t nvec = (size_t)M_TOK * DM / 8;
      for (size_t v = (size_t)c * NT + tid; v < nvec; v += (size_t)G * NT) {
          const f32x4 a = __builtin_nontemporal_load((const f32x4*)P.x + 2 * v), b = __builtin_nontemporal_load((const f32x4*)P.x + 2 * v + 1);
          u32x4 w; w.x = pk2h(a[0], a[1]); w.y = pk2h(a[2], a[3]); w.z = pk2h(b[0], b[1]); w.w = pk2h(b[2], b[3]); ((u32x4*)Hh)[v] = w; } }
    LAS float* tile = (LAS float*)lds;
    float* csp = (float*)(P.ws + WS_CSP);
    for (int t = c; t < DEPTH * 3072; t += G) {
        const int l = t / 3072, r = t % 3072; const float* src; h16* dst; int K, N, tl; unsigned char* wl = P.ws + WS_W + (size_t)l * W_LAYER_B;
        const float* gv = nullptr; const float* bv = nullptr; int csoff = 0;
        if (r < 768)       { src = P.w_qkv  + (size_t)l * DM * 3 * DM; dst = (h16*)wl;                               K = DM; N = 3 * DM; tl = r; if (l > 0) { gv = P.ln_ffn_g + (l - 1) * DM; bv = P.ln_ffn_b + (l - 1) * DM; csoff = 8192; } }
        else if (r < 1024) { src = P.w_o    + (size_t)l * DM * DM;     dst = (h16*)(wl + W_QKV_B);                   K = DM; N = DM;     tl = r - 768; }
        else if (r < 2048) { src = P.w_up   + (size_t)l * DM * FF;     dst = (h16*)(wl + W_QKV_B + W_O_B);           K = DM; N = FF;     tl = r - 1024; gv = P.ln_mix_g + l * DM; bv = P.ln_mix_b + l * DM; csoff = l * 4096; }
        else               { src = P.w_down + (size_t)l * FF * DM;     dst = (h16*)(wl + W_QKV_B + W_O_B + W_UP_B);  K = FF; N = DM;     tl = r - 2048; }
        const int ntn = N / 64, k0 = (tl / ntn) * 64, n0 = (tl % ntn) * 64;
        { const int n = tid & 63, kb = tid >> 6;
#pragma unroll
          for (int i = 0; i < 8; ++i) { const int k = kb + 8 * i; tile[k * 65 + n] = __builtin_nontemporal_load(src + (size_t)(k0 + k) * N + n0 + n); } }
        __syncthreads();
        { const int k2 = (tid & 31) * 2, nb = tid >> 5; const float g0 = gv ? gv[k0 + k2] : 1.f, g1 = gv ? gv[k0 + k2 + 1] : 1.f;
#pragma unroll
          for (int i = 0; i < 4; ++i) { const int n = nb + 16 * i; const h16x2 v = {(h16)(tile[k2 * 65 + n] * g0), (h16)(tile[(k2 + 1) * 65 + n] * g1)}; *(h16x2*)(dst + (size_t)(n0 + n) * K + k0 + k2) = v; } }
        if (gv && tid < 64) { float sa = 0.f, sb = 0.f;
            for (int k = 0; k < 64; ++k) { const float wv = tile[k * 65 + tid]; sa += (float)(h16)(wv * gv[k0 + k]); sb += wv * bv[k0 + k]; }
            csp[(size_t)((k0 >> 6) * 2 + 0) * NCS + csoff + n0 + tid] = sa; csp[(size_t)((k0 >> 6) * 2 + 1) * NCS + csoff + n0 + tid] = sb; }
        __syncthreads();
    }
}

__device__ __forceinline__ void p_cs_finalize(const Params& P) {
    const float* csp = (const float*)(P.ws + WS_CSP); float* cs = (float*)(P.ws + WS_CS);
    int tid_ = mk_tid(); asm volatile("" : "+v"(tid_));
    for (int i = blockIdx.x * 88 + tid_; tid_ < 88 && i < 2 * NCS; i += gridDim.x * 88) {     const int v = i / NCS, cidx = i % NCS; float a = 0.f;
        float pv_[16];
#pragma unroll
        for (int kt = 0; kt < 16; ++kt) pv_[kt] = csp[(size_t)(kt * 2 + v) * NCS + cidx];
#pragma unroll
        for (int kt = 0; kt < 16; ++kt) a += pv_[kt];
        cs[i] = a; }
}

template <class Sched> __device__ __forceinline__ void p_fill_tables(LAS unsigned char* lds, const float* part, const Sched& S, const float* cvec, const float* bvec) {
    int tid_ = mk_tid(); asm volatile("" : "+v"(tid_)); const int tid = tid_;
    LAS unsigned char* tb = lds + ST_OFF; LAS pg8::f32x2_t* st = (LAS pg8::f32x2_t*)tb; LAS float* csl = (LAS float*)(tb + 8192); LAS float* bwl = (LAS float*)(tb + 12288); LAS int* sl = (LAS int*)(tb + 16384);
    if (tid < 16) { pg8::Unit u; const bool ok = S.next(tid, u); sl[48 + tid] = ok ? u.pm : -1; sl[64 + tid] = ok ? u.pn : -1; }
    __syncthreads();
    int fpm = 0, fpn = 0;
    if (tid < 16) { const int pm = sl[48 + tid], pn = sl[64 + tid]; fpm = tid; fpn = tid;
        for (int j = tid - 1; j >= 0; --j) { if (sl[48 + j] == pm) fpm = j; if (sl[64 + j] == pn) fpn = j; }
        sl[80 + tid] = (fpm == tid && pm >= 0) ? 1 : 0; sl[96 + tid] = (fpn == tid && pn >= 0) ? 1 : 0; }
    __syncthreads();
    if (tid < 16) { int ps = 0, cs_ = 0;
        for (int j = 0; j < fpm; ++j) ps += sl[80 + j];
        for (int j = 0; j < fpn; ++j) cs_ += sl[96 + j];
        ps = ps < 3 ? ps : 3; cs_ = cs_ < 3 ? cs_ : 3;
        sl[tid] = ps; sl[16 + tid] = cs_;
        if (fpm == tid && sl[48 + tid] >= 0) sl[32 + ps] = sl[48 + tid];
        if (fpn == tid && sl[64 + tid] >= 0) sl[36 + cs_] = sl[64 + tid];
        if (tid == 0) { int a = 0, b = 0; for (int j = 0; j < 16; ++j) { a += sl[80 + j]; b += sl[96 + j]; } sl[40] = a < 4 ? a : 4; sl[41] = b < 4 ? b : 4; } }
    __syncthreads();
    const int npm = sl[40], npn = sl[41];
    f32x4 pr[2][8]; float cvl[4];
#pragma unroll
    for (int jj = 0; jj < 2; ++jj) { const int j = (tid >> 8) + 2 * jj; const int pm = sl[32 + (j < npm ? j : 0)];
        const f32x4* pp = (const f32x4*)(part + (size_t)(pm * 256 + (tid & 255)) * 32);
#pragma unroll
        for (int x = 0; x < 8; ++x) pr[jj][x] = pp[x]; }
#pragma unroll
    for (int j = 0; j < 4; ++j) { const int pn = sl[36 + (j < npn ? j : 0)]; cvl[j] = (tid < 256) ? cvec[pn * 256 + tid] : bvec[pn * 256 + tid - 256]; }
#pragma unroll
    for (int jj = 0; jj < 2; ++jj) { const int j = (tid >> 8) + 2 * jj; if (j < npm) { float sa = 0.f, sq = 0.f;
#pragma unroll
            for (int x = 0; x < 8; ++x) { sa += pr[jj][x][0] + pr[jj][x][2]; sq += pr[jj][x][1] + pr[jj][x][3]; }
            const float mean = sa * (1.0f / 1024.0f), var = sq * (1.0f / 1024.0f) - mean * mean;
            st[j * 256 + (tid & 255)] = (pg8::f32x2_t){mean, 1.0f / sqrtf(var + LN_EPS)}; } }
#pragma unroll
    for (int j = 0; j < 4; ++j) if (j < npn) { if (tid < 256) csl[j * 256 + tid] = cvl[j]; else bwl[j * 256 + tid - 256] = cvl[j]; }
    __syncthreads();
}

__device__ __forceinline__ void p_kmean(const Params& P) {
    const h16* Kb = (const h16*)(P.ws + WS_K); float* KM = (float*)(P.ws + WS_KM);
    int tid_ = mk_tid(); asm volatile("" : "+v"(tid_)); const int lane = tid_ & 63, w = tid_ >> 6, sub = lane & 7, rr = lane >> 3;
    for (int it = blockIdx.x * 8 + w; it < 4096; it += gridDim.x * 8) {
        const int bh = it >> 3, n = it & 7, b = bh >> 4, h = bh & 15;
        const h16* p = Kb + ((size_t)bh * SEQ + n * 256 + rr) * DH + sub * 8;
        float a[8];
#pragma unroll
        for (int e = 0; e < 8; ++e) a[e] = 0.f;
#pragma unroll 8
        for (int i = 0; i < 32; ++i) { const h16x8 v = *(const h16x8*)(p + (size_t)i * 8 * DH);
#pragma unroll
            for (int e = 0; e < 8; ++e) a[e] += (float)v[e]; }
#pragma unroll
        for (int e = 0; e < 8; ++e) { a[e] += __shfl_xor(a[e], 8); a[e] += __shfl_xor(a[e], 16); a[e] += __shfl_xor(a[e], 32); a[e] *= (1.0f / 256.0f); }
        if (rr == 0) { float* o = KM + (size_t)it * 64 + sub * 8; *(f32x4*)o = (f32x4){a[0], a[1], a[2], a[3]}; *(f32x4*)(o + 4) = (f32x4){a[4], a[5], a[6], a[7]}; }
    }
}

template <bool FINAL> __device__ __forceinline__ void p_ln(const h16* Y, h16* Ho, float* Fo, const float* g, const float* bt, const float* part) {
    int tid_ = mk_tid(); asm volatile("" : "+v"(tid_)); const int lane = tid_ & 63, w = __builtin_amdgcn_readfirstlane(tid_ >> 6);
    float gg[16], bb[16];
#pragma unroll
    for (int e = 0; e < 8; ++e) { gg[e] = g[8 * lane + e]; gg[8 + e] = g[512 + 8 * lane + e]; bb[e] = bt[8 * lane + e]; bb[8 + e] = bt[512 + 8 * lane + e]; }
    for (int row = blockIdx.x * 8 + w; row < M_TOK; row += gridDim.x * 8) {
        const h16x8 v0 = *(const h16x8*)(Y + (size_t)row * DM + 8 * lane), v1 = *(const h16x8*)(Y + (size_t)row * DM + 512 + 8 * lane);
        const f32x4* pp = (const f32x4*)(part + (size_t)row * 32); float sa = 0.f, sq = 0.f;
#pragma unroll
        for (int k = 0; k < 8; ++k) { const f32x4 v = pp[k]; sa += v[0] + v[2]; sq += v[1] + v[3]; }
        const float mean = sa * (1.0f / 1024.0f), var = sq * (1.0f / 1024.0f) - mean * mean, rstd = 1.0f / sqrtf(var + LN_EPS);
        float x[16];
#pragma unroll
        for (int e = 0; e < 8; ++e) { x[e] = (float)v0[e]; x[8 + e] = (float)v1[e]; }
#pragma unroll
        for (int e = 0; e < 16; ++e) x[e] = (x[e] - mean) * rstd * gg[e] + bb[e];
        if (FINAL) { float* o = Fo + (size_t)row * DM + 8 * lane;
            *(f32x4*)o = (f32x4){x[0], x[1], x[2], x[3]}; *(f32x4*)(o + 4) = (f32x4){x[4], x[5], x[6], x[7]};
            *(f32x4*)(o + 512) = (f32x4){x[8], x[9], x[10], x[11]}; *(f32x4*)(o + 516) = (f32x4){x[12], x[13], x[14], x[15]}; }
        else { h16* o = Ho + (size_t)row * DM + 8 * lane; u32x4 a, b;
            a.x = pk2h(x[0], x[1]); a.y = pk2h(x[2], x[3]); a.z = pk2h(x[4], x[5]); a.w = pk2h(x[6], x[7]);
            b.x = pk2h(x[8], x[9]); b.y = pk2h(x[10], x[11]); b.z = pk2h(x[12], x[13]); b.w = pk2h(x[14], x[15]);
            *(u32x4*)o = a; *(u32x4*)(o + 512) = b; }
    }
}

namespace attn_body {
using bf16=_Float16;
using h16x8v=__attribute__((ext_vector_type(8)))_Float16;
using bf16x8=__attribute__((ext_vector_type(8)))short;
using s16x4=__attribute__((ext_vector_type(4)))short;
using f32x16=__attribute__((ext_vector_type(16)))float;
using u32x4=__attribute__((ext_vector_type(4)))unsigned;
constexpr int BATCH=32,NHEAD=16,SEQ=2048,D=64,DM=NHEAD*D;
constexpr int NW=8,QBLK=32,QB=QBLK*NW,KVBLK=64,NQB=SEQ/QB;
constexpr int ATTN_PITCH=DM, ATTN_UNIT_ROWS=QB;
__device__ __forceinline__ int crow(int r,int hi){return (r&3)+8*(r>>2)+4*hi;}
#define SBAR() __builtin_amdgcn_sched_barrier(0)
#define MF16(a,b,c,x,y,z) __builtin_amdgcn_mfma_f32_32x32x16_f16(__builtin_bit_cast(h16x8v,(a)),__builtin_bit_cast(h16x8v,(b)),(c),0,0,0)
__device__ __forceinline__ void cmask(f32x16&p0,f32x16&p1,int jb,int qrel,int hi){
  const float NEG=-INFINITY; int kb=64*jb+4*hi;
  #pragma unroll
  for(int r=0;r<16;++r){int kv=kb+(r&3)+8*(r>>2); if(kv>qrel)p0[r]=NEG; if(kv+32>qrel)p1[r]=NEG;}
}

constexpr int NSLOT=3, SLOTB=8192;
constexpr int LDS_K=0, LDS_V=NSLOT*SLOTB, LDS_WS=2*NSLOT*SLOTB, LDS_OST=LDS_WS+NW*64*4, LDS_BYTES=LDS_OST+NW*4096;
constexpr int LDS_KM=LDS_BYTES, LDS_BT=LDS_KM+2048, NBT=640, LDS_SEL=LDS_BT+4*NBT*4, LDS_TOTAL=LDS_SEL+NW*2048;
constexpr float C2=0.125f*1.4426950408889634f;
__device__ __forceinline__ void glds16(const void*gsrc,unsigned lds_dst){unsigned keep;
  asm volatile("s_mov_b32 %0, m0\n\ts_mov_b32 m0, %2\n\ts_nop 0\n\tglobal_load_lds_dwordx4 %1, off\n\ts_mov_b32 m0, %0":"=&s"(keep):"v"(gsrc),"s"(lds_dst):"memory");}
__device__ __forceinline__ float max3f(float a,float b,float c){float r;asm("v_max3_f32 %0, %1, %2, %3":"=v"(r):"v"(a),"v"(b),"v"(c));return r;}
__device__ __forceinline__ float max2f(float a,float b){float r;asm("v_max_f32_e32 %0, %1, %2":"=v"(r):"v"(a),"v"(b));return r;}
__device__ __forceinline__ float fadd_s(float a,float b){float r;asm("v_add_f32_e32 %0, %1, %2":"=v"(r):"v"(a),"v"(b));return r;}
__device__ __forceinline__ float fsub_s(float a,float b){float r;asm("v_sub_f32_e32 %0, %1, %2":"=v"(r):"v"(a),"v"(b));return r;}
typedef float f32x2_t __attribute__((ext_vector_type(2))); typedef _Float16 bf16x2_t __attribute__((ext_vector_type(2)));
__device__ __forceinline__ unsigned cvtpk_s(float lo,float hi){f32x2_t v={lo,hi};bf16x2_t b=__builtin_convertvector(v,bf16x2_t);return __builtin_bit_cast(unsigned,b);}
#define WAIT_BAR(N) asm volatile("s_waitcnt vmcnt(" #N ") lgkmcnt(0)\n\ts_barrier":::"memory")

__device__ __forceinline__ void qkt(f32x16&p0,f32x16&p1,const char*Kslot,const bf16x8*qr,const f32x16&negm,int r32,int hi){
  const char*kb=Kslot+hi*1024+r32*16;
  #pragma unroll
  for(int d0=0;d0<4;++d0){
    const bf16x8 b0=*reinterpret_cast<const bf16x8*>(kb+d0*2048);
    const bf16x8 b1=*reinterpret_cast<const bf16x8*>(kb+d0*2048+512);
    if(d0==0){p0=MF16(b0,qr[0],negm,0,0,0);p1=MF16(b1,qr[0],negm,0,0,0);}
    else{p0=MF16(b0,qr[d0],p0,0,0,0);p1=MF16(b1,qr[d0],p1,0,0,0);}}
}
typedef __attribute__((address_space(3))) const char* lds_cptr;
typedef short v4i16_t __attribute__((ext_vector_type(4)));
typedef float f32x4 __attribute__((ext_vector_type(4)));
__device__ __forceinline__ void kload8(bf16x8*kf,lds_cptr kp){
  kf[0]=*(const __attribute__((address_space(3))) bf16x8*)(kp);      kf[1]=*(const __attribute__((address_space(3))) bf16x8*)(kp+512);
  kf[2]=*(const __attribute__((address_space(3))) bf16x8*)(kp+2048); kf[3]=*(const __attribute__((address_space(3))) bf16x8*)(kp+2560);
  kf[4]=*(const __attribute__((address_space(3))) bf16x8*)(kp+4096); kf[5]=*(const __attribute__((address_space(3))) bf16x8*)(kp+4608);
  kf[6]=*(const __attribute__((address_space(3))) bf16x8*)(kp+6144); kf[7]=*(const __attribute__((address_space(3))) bf16x8*)(kp+6656);
}
__device__ __forceinline__ void kload2(bf16x8*kf,lds_cptr kp,int j){ kf[2*j]=*(const __attribute__((address_space(3))) bf16x8*)(kp+j*2048); kf[2*j+1]=*(const __attribute__((address_space(3))) bf16x8*)(kp+j*2048+512); }
__device__ __forceinline__ s16x4 vtr(lds_cptr p){ return __builtin_bit_cast(s16x4,__builtin_amdgcn_ds_read_tr16_b64_v4i16((__attribute__((address_space(3))) v4i16_t*)p)); }
__device__ __forceinline__ float rowmax(const f32x16&p0,const f32x16&p1){
  float a=max3f(p0[0],p0[1],p1[0]),b=max3f(p0[2],p0[3],p1[1]);a=max3f(a,p1[2],p1[3]);
  #pragma unroll
  for(int r=4;r<16;r+=4){a=max3f(a,p0[r],p0[r+1]);b=max3f(b,p0[r+2],p0[r+3]);a=max3f(a,p1[r],p1[r+1]);b=max3f(b,p1[r+2],p1[r+3]);}
  const float m=max2f(a,b);
  auto rr=__builtin_amdgcn_permlane32_swap(__float_as_uint(m),__float_as_uint(m),false,false);
  return max2f(__uint_as_float(rr[0]),__uint_as_float(rr[1]));
}
__device__ __forceinline__ void pv(f32x16*o,int vb,bf16x8 pa0,bf16x8 pa1,bf16x8 pa2,bf16x8 pa3){
  #pragma unroll
  for(int d0=0;d0<2;++d0){s16x4 lo[4],hi[4];
    #pragma unroll
    for(int ks=0;ks<4;++ks){
      asm volatile("ds_read_b64_tr_b16 %0,%1 offset:%c2":"=&v"(lo[ks]):"v"(vb),"i"(d0*4096+ks*1024):"memory");
      asm volatile("ds_read_b64_tr_b16 %0,%1 offset:%c2":"=&v"(hi[ks]):"v"(vb),"i"(d0*4096+ks*1024+512):"memory");}
    asm volatile("s_waitcnt lgkmcnt(0)":::"memory");SBAR();
    #define PK(k) (bf16x8){lo[k][0],lo[k][1],lo[k][2],lo[k][3],hi[k][0],hi[k][1],hi[k][2],hi[k][3]}
    o[d0]=MF16(pa0,PK(0),o[d0],0,0,0);
    o[d0]=MF16(pa1,PK(1),o[d0],0,0,0);
    o[d0]=MF16(pa2,PK(2),o[d0],0,0,0);
    o[d0]=MF16(pa3,PK(3),o[d0],0,0,0);
    #undef PK
  }
}

#ifndef ATTN_STORE16
#define ATTN_STORE16(p,v) (*(u32x4*)(p)=(v))
#endif
template<int THRL> __device__ __forceinline__ void attn_unit(int b,int h,int qb,const bf16*Q,const bf16*__restrict__ K,const bf16*__restrict__ V,bf16*O,char*shm,const float*KMg,const float*rel_bias,bool newhead,bf16x8 (&qr)[4],const bf16*Qnext){
  int tid_=mk_tid(); asm volatile("":"+v"(tid_));
  const int tid=tid_,lane=tid&63,r32=lane&31,hi=lane>>5; const int wid=__builtin_amdgcn_readfirstlane(tid>>6);
  const long rowbase=(long)b*SEQ; const int q0=qb*QB;
  typedef __attribute__((address_space(3))) float* lds_fptr;
  const lds_fptr kml=(lds_fptr)(shm+LDS_KM); const lds_fptr btl=(lds_fptr)(shm+LDS_BT);
  if(newhead){
    {
      const bf16*Kn=K+(long)(b*NHEAD+h)*SEQ*D+(long)(tid>>3)*D+(tid&7)*8; const lds_fptr kpart=(lds_fptr)(shm+LDS_TOTAL);
      h16x8v kv_[32];
      #pragma unroll
      for(int i=0;i<32;++i)kv_[i]=*reinterpret_cast<const h16x8v*>(Kn+(long)i*64*D);
      #pragma unroll
      for(int n=0;n<8;++n){ float a_[8];
        #pragma unroll
        for(int e=0;e<8;++e)a_[e]=((float)kv_[4*n][e]+(float)kv_[4*n+1][e])+((float)kv_[4*n+2][e]+(float)kv_[4*n+3][e]);
        #pragma unroll
        for(int e=0;e<8;++e){ a_[e]+=__shfl_xor(a_[e],8); a_[e]+=__shfl_xor(a_[e],16); a_[e]+=__shfl_xor(a_[e],32); }
        if((lane>>3)==0){
          #pragma unroll
          for(int e=0;e<8;++e)kpart[(wid*8+n)*64+(lane&7)*8+e]=a_[e]; } }
      asm volatile("s_waitcnt vmcnt(0) lgkmcnt(0)\n\ts_barrier":::"memory");
      float t_=0.f;
      #pragma unroll
      for(int w8=0;w8<8;++w8)t_+=kpart[w8*512+tid];
      kml[tid]=t_*(1.0f/256.0f); }
    for(int e=tid;e<4*NBT;e+=NW*64){ const int cpy=e/NBT,i=e%NBT,j=i+cpy; float v=-INFINITY;
      const int dist=(NBT-1-j)-256;
      if(j<NBT&&dist>=0){ int bk=dist; if(dist>=16){ bk=16+(int)(logf((float)dist/16.0f)/logf(8.0f)*16.0f); bk=bk<31?bk:31; } v=(rel_bias[bk*NHEAD+h]-rel_bias[31*NHEAD+h])*1.4426950408889634f; }
      btl[e]=v; }
    asm volatile("s_waitcnt vmcnt(0) lgkmcnt(0)\n\ts_barrier":::"memory"); }
  const bf16*Qw=Q+(rowbase+q0+wid*QBLK)*DM+h*D;
  const bf16*Kh=K+(long)(b*NHEAD+h)*SEQ*D,*Vh=V+(long)(b*NHEAD+h)*SEQ*D;
  const unsigned lds0=(unsigned)(uintptr_t)shm;
  float*wsf=(float*)(shm+LDS_WS)+wid*64;
  const bf16*ksrc=Kh+(long)lane*D+wid*8;
  const bf16*vsrc=Vh+(long)(16*(wid&3)+(lane>>2))*D+(wid>>2)*32+(lane&3)*8;
  const unsigned kdst=lds0+LDS_K+wid*1024, vdst=lds0+LDS_V+wid*1024;
  #define TKT(t) ((t)<4 ? NT-4+(t) : NT-1-(t))
  #define DMA_K(t,slot) glds16(ksrc+(long)(TKT(t))*KVBLK*D,(unsigned)__builtin_amdgcn_readfirstlane(kdst+(slot)))
  #define DMA_V(t,slot) glds16(vsrc+(long)(TKT(t))*KVBLK*D,(unsigned)__builtin_amdgcn_readfirstlane(vdst+(slot)))
  const int vb0=(int)(lds0+LDS_V)+((lane>>4)&1)*32+(lane&3)*8+(4*hi+((lane&15)>>2))*64;
  const char*Kbase=shm+LDS_K; bf16x8 kf[8];
  const lds_cptr shm3=(lds_cptr)shm; const lds_cptr kp0=shm3+LDS_K+hi*1024+r32*16; const lds_cptr vp0=shm3+LDS_V+((lane>>4)&1)*32+(lane&3)*8+(4*hi+((lane&15)>>2))*64;
  const int NT=(q0+QB)/KVBLK;
  DMA_K(0,0);DMA_V(0,0);DMA_K(1,SLOTB);
  unsigned sel=0u;
  if(qb>0){ float g[7];
    #pragma unroll
    for(int n=0;n<7;++n){ float a=0.f;
      if(n<qb){
        #pragma unroll
        for(int d0=0;d0<4;++d0){ const h16x8v qv=__builtin_bit_cast(h16x8v,qr[d0]);
          #pragma unroll
          for(int j=0;j<8;++j)a+=(float)qv[j]*kml[n*64+16*d0+8*hi+j]; } }
      { auto rr=__builtin_amdgcn_permlane32_swap(__float_as_uint(a),__float_as_uint(a),false,false); a=__uint_as_float(rr[0])+__uint_as_float(rr[1]); }
      g[n]=(n<qb)?a:-INFINITY; }
    if(qb<=3)sel=(1u<<qb)-1u;
    else{
      #pragma unroll
      for(int n=0;n<7;++n){ int rank=0;
        #pragma unroll
        for(int m=0;m<7;++m)if(m!=n)rank+=((g[m]>g[n])||(g[m]==g[n]&&m<n))?1:0;
        if(n<qb&&rank<3)sel|=1u<<n; } } }
  const bool mixed=qb>3;
  typedef __attribute__((address_space(3))) unsigned* lds_uptr;
  if(mixed){ *(lds_uptr)(shm3+LDS_SEL+wid*2048+hi*1024+r32*16)=sel; }
  float mhat=0.f,l_reg=0.f;f32x16 o[2];o[0]=f32x16{};o[1]=f32x16{};f32x16 negm=f32x16{};asm volatile("":"+v"(negm));
  const int qrel=wid*QBLK+r32;
  #define CMASK(P0,P1,t) do{ const int t_=(t); const int kt_=TKT(t_); \
    if(t_<6){ const int s_=(NBT-1)-(q0+qrel-64*kt_-4*hi+256), c_=s_&3; const __attribute__((address_space(3))) f32x4* tp_=(const __attribute__((address_space(3))) f32x4*)(shm3+LDS_BT+c_*(NBT*4)+(s_-c_)*4); \
      f32x4 b0_[4],b1_[4]; _Pragma("unroll") for(int g=0;g<4;++g){ b0_[g]=tp_[2*g]; b1_[g]=tp_[2*g+8]; } \
      _Pragma("unroll") for(int g=0;g<4;++g) _Pragma("unroll") for(int e=0;e<4;++e){ P0[4*g+e]+=b0_[g][e]; P1[4*g+e]+=b1_[g][e]; } } \
    if(t_>=4&&mixed){ const unsigned sel_=sel; if(((sel_>>(kt_>>2))&1u)==0u){ _Pragma("unroll") for(int r=0;r<16;++r){P0[r]=-INFINITY;P1[r]=-INFINITY;} } } }while(0)
  bool resc=false;
  #define START(P0,P1) do{ const float rm=rowmax(P0,P1); resc=false; \
    { const float dl=rm; mhat=fadd_s(mhat,dl); \
      _Pragma("unroll") for(int r=0;r<16;++r){P0[r]=fsub_s(P0[r],dl);P1[r]=fsub_s(P1[r],dl);} \
      _Pragma("unroll") for(int r=0;r<16;++r)negm[r]=-mhat; asm volatile("":"+v"(negm)); } \
    _Pragma("unroll") for(int r=0;r<16;++r)P0[r]=__builtin_amdgcn_exp2f(P0[r]); }while(0)
  #define RESC() do{ if(resc){ asm volatile("s_waitcnt lgkmcnt(0)":::"memory"); \
      _Pragma("unroll") for(int d_=0;d_<2;++d_) _Pragma("unroll") for(int r=0;r<16;++r)o[d_][r]*=wsf[crow(r,hi)]; } }while(0)
  f32x16 pA0,pA1,pB0,pB1;
  int sl_prev=0,sl_cur=0,sl_next=SLOTB;
  #define ROT() do{sl_prev=sl_cur;sl_cur=sl_next;sl_next=(sl_next==(NSLOT-1)*SLOTB)?0:sl_next+SLOTB;}while(0)
  DMA_K(2,2*SLOTB);
  WAIT_BAR(3);
  qkt(pA0,pA1,Kbase,qr,negm,r32,hi);asm volatile("s_nop 15\n\ts_nop 7":"+v"(pA0),"+v"(pA1));CMASK(pA0,pA1,0);
  START(pA0,pA1);
  _Pragma("unroll") for(int r=0;r<16;++r)pA1[r]=__builtin_amdgcn_exp2f(pA1[r]);
  WAIT_BAR(0);
  DMA_K(3,0);DMA_V(1,SLOTB);
  ROT();
  kload8(kf,kp0+sl_cur);
  WAIT_BAR(2);
  s16x4 vlo[8],vhi[8]; u32x4 pw0,pw1,pw2,pw3;
  #define PKW(P,B) cvtpk_s(P[B],P[B+1])
  #define PAF(k) __builtin_bit_cast(bf16x8,pw##k)
  #define VFR(i) (bf16x8){vlo[i][0],vlo[i][1],vlo[i][2],vlo[i][3],vhi[i][0],vhi[i][1],vhi[i][2],vhi[i][3]}
  #define PIN(x) asm volatile("":"+v"(x))
  #define MX3(a,b,c) __builtin_fmaxf(__builtin_fmaxf((a),(b)),(c))
  #define GAPA(MF,A0,A1,A2,A3,W0,W1,PW) do{ MF; sacc+=A0; sacc+=A1; sacc+=A2; sacc+=A3; PIN(sacc); W0; W1; PIN(PW); SBAR(); }while(0)
  #define EX(v) __builtin_amdgcn_exp2f(v)
  #define GAPB(MF,X,B) do{ MF; X[B]=EX(X[B]); X[B+1]=EX(X[B+1]); X[B+2]=EX(X[B+2]); X[B+3]=EX(X[B+3]); PIN(X); SBAR(); }while(0)
  #define VRD(i) do{ vlo[i]=vtr(vp_+(((i)>>2)*4096+((i)&3)*1024)); vhi[i]=vtr(vp_+(((i)>>2)*4096+((i)&3)*1024+512)); }while(0)
  #define KRD(G,j) do{ if(G){ kload2(kf,kp0+sl_next,j); SBAR(); } }while(0)
  #define STEP(C0,C1,P0,P1,t,GK,GV,GL) do{ SBAR(); \
    const lds_cptr vp_=vp0+sl_prev; \
    VRD(0); SBAR(); float sacc=(P0[0]+P0[1]); \
    GAPA(C0=MF16(kf[0],qr[0],negm,0,0,0), P0[2],P0[3],P0[4],P0[5],     pw0[0]=PKW(P0,0), pw0[1]=PKW(P0,2), pw0); \
    VRD(4); SBAR(); GAPA(C1=MF16(kf[1],qr[0],negm,0,0,0), P0[6],P0[7],P0[8],P0[9],     pw0[2]=PKW(P0,4), pw0[3]=PKW(P0,6), pw0); \
    VRD(1); SBAR(); GAPA(C0=MF16(kf[2],qr[1],C0,0,0,0),   P0[10],P0[11],P0[12],P0[13], pw1[0]=PKW(P0,8), pw1[1]=PKW(P0,10), pw1); \
    VRD(5); SBAR(); GAPA(C1=MF16(kf[3],qr[1],C1,0,0,0),   P0[14],P0[15],P1[0],P1[1],   pw1[2]=PKW(P0,12),pw1[3]=PKW(P0,14), pw1); \
    VRD(2); SBAR(); GAPA(C0=MF16(kf[4],qr[2],C0,0,0,0),   P1[2],P1[3],P1[4],P1[5],     pw2[0]=PKW(P1,0), pw2[1]=PKW(P1,2), pw2); \
    VRD(6); SBAR(); GAPA(C1=MF16(kf[5],qr[2],C1,0,0,0),   P1[6],P1[7],P1[8],P1[9],     pw2[2]=PKW(P1,4), pw2[3]=PKW(P1,6), pw2); \
    VRD(3); SBAR(); GAPA(C0=MF16(kf[6],qr[3],C0,0,0,0),   P1[10],P1[11],P1[12],P1[13], pw3[0]=PKW(P1,8), pw3[1]=PKW(P1,10), pw3); \
    VRD(7); SBAR(); GAPA(C1=MF16(kf[7],qr[3],C1,0,0,0),   P1[14],P1[15],0.f,0.f,       pw3[2]=PKW(P1,12),pw3[3]=PKW(P1,14), pw3); \
    l_reg+=sacc; \
    if(GK){DMA_K((t)+3,sl_cur);} if(GV){DMA_V((t)+1,sl_next);} \
    CMASK(C0,C1,t); \
    { float a=MX3(C0[0],C0[1],C1[0]),b=MX3(C0[2],C0[3],C1[1]); a=MX3(a,C1[2],C1[3]); \
      _Pragma("unroll") for(int r=4;r<16;r+=4){a=MX3(a,C0[r],C0[r+1]);b=MX3(b,C0[r+2],C0[r+3]);a=MX3(a,C1[r],C1[r+1]);b=MX3(b,C1[r+2],C1[r+3]);} \
      float rm=__builtin_fmaxf(a,b); { auto rr=__builtin_amdgcn_permlane32_swap(__float_as_uint(rm),__float_as_uint(rm),false,false); rm=__builtin_fmaxf(__uint_as_float(rr[0]),__uint_as_float(rr[1])); } \
      resc=false; \
      if(__builtin_expect(__any(rm>(float)THRL),0)){ const float dl=__builtin_fmaxf(rm,0.f); mhat+=dl; \
        _Pragma("unroll") for(int r=0;r<16;++r){C0[r]-=dl;C1[r]-=dl;} \
        _Pragma("unroll") for(int r=0;r<16;++r)negm[r]=-mhat; asm volatile("":"+v"(negm)); \
        const float f=__builtin_amdgcn_exp2f(-dl); l_reg*=f; { int r32o_=r32; asm volatile("":"+v"(r32o_)); if(hi==0)wsf[r32o_]=f; }     resc=true; } } \
    SBAR(); \
    GAPB(o[0]=MF16(PAF(0),VFR(0),o[0],0,0,0), C0,0); \
    GAPB(o[1]=MF16(PAF(0),VFR(4),o[1],0,0,0), C0,4); \
    KRD(GL,0); GAPB(o[0]=MF16(PAF(1),VFR(1),o[0],0,0,0), C0,8); \
    KRD(GL,1); GAPB(o[1]=MF16(PAF(1),VFR(5),o[1],0,0,0), C0,12); \
    KRD(GL,2); GAPB(o[0]=MF16(PAF(2),VFR(2),o[0],0,0,0), C1,0); \
    KRD(GL,3); GAPB(o[1]=MF16(PAF(2),VFR(6),o[1],0,0,0), C1,4); \
    GAPB(o[0]=MF16(PAF(3),VFR(3),o[0],0,0,0), C1,8); \
    GAPB(o[1]=MF16(PAF(3),VFR(7),o[1],0,0,0), C1,12); \
    }while(0)
  int t=1;
  #define ENDW(tt) do{ if((tt)+3<NT){WAIT_BAR(2);} else if((tt)+2<NT){WAIT_BAR(1);} else {WAIT_BAR(0);} }while(0)
  for(;t<7&&t+1<NT;t+=2){
    STEP(pB0,pB1,pA0,pA1,t,(t+3<NT),(t+1<NT),(t+1<NT));       ENDW(t);   RESC(); ROT();
    STEP(pA0,pA1,pB0,pB1,t+1,(t+4<NT),(t+2<NT),(t+2<NT));     ENDW(t+1); RESC(); ROT();
  }
  #pragma push_macro("CMASK")
  #undef CMASK
  #define CMASK(P0,P1,t) do{ if(mixed){ const unsigned sel_=sel; if(((sel_>>(TKT(t)>>2))&1u)==0u){ _Pragma("unroll") for(int r=0;r<16;++r){P0[r]=-INFINITY;P1[r]=-INFINITY;} } } }while(0)
  for(;t+5<NT;t+=2){
    STEP(pB0,pB1,pA0,pA1,t,true,true,true);     WAIT_BAR(2); RESC(); ROT();
    STEP(pA0,pA1,pB0,pB1,t+1,true,true,true);   WAIT_BAR(2); RESC(); ROT();
  }
  #pragma pop_macro("CMASK")
  for(;t+1<NT;t+=2){
    STEP(pB0,pB1,pA0,pA1,t,(t+3<NT),(t+1<NT),(t+1<NT));       ENDW(t);   RESC(); ROT();
    STEP(pA0,pA1,pB0,pB1,t+1,(t+4<NT),(t+2<NT),(t+2<NT));     ENDW(t+1); RESC(); ROT();
  }
  STEP(pB0,pB1,pA0,pA1,NT-1,false,false,false); RESC();
  if(Qnext){
    #pragma unroll
    for(int d0=0;d0<4;++d0)qr[d0]=*reinterpret_cast<const bf16x8*>(&Qnext[(long)(wid*QBLK+r32)*DM+d0*16+hi*8]); }
  { float sacc=pB0[0]+pB0[1]; _Pragma("unroll") for(int r=2;r<16;++r)sacc+=pB0[r]; _Pragma("unroll") for(int r=0;r<16;++r)sacc+=pB1[r]; l_reg+=sacc;
    pw0=(u32x4){PKW(pB0,0),PKW(pB0,2),PKW(pB0,4),PKW(pB0,6)};pw1=(u32x4){PKW(pB0,8),PKW(pB0,10),PKW(pB0,12),PKW(pB0,14)};pw2=(u32x4){PKW(pB1,0),PKW(pB1,2),PKW(pB1,4),PKW(pB1,6)};pw3=(u32x4){PKW(pB1,8),PKW(pB1,10),PKW(pB1,12),PKW(pB1,14)};
    SBAR(); pv(o,vb0+sl_cur,PAF(0),PAF(1),PAF(2),PAF(3)); }
  #undef PKW
  #undef PAF
  #undef VFR
  #undef PIN
  #undef MX3
  #undef GAPA
  #undef GAPB
  #undef EX
  #undef VRD
  #undef KRD
  #undef STEP
  #undef ENDW
  {auto rr=__builtin_amdgcn_permlane32_swap(__float_as_uint(l_reg),__float_as_uint(l_reg),false,false);l_reg=__uint_as_float(rr[0])+__uint_as_float(rr[1]);}
  if(hi==0)wsf[32+r32]=l_reg;asm volatile("s_waitcnt lgkmcnt(0)":::"memory");
  float rli[16];
  #pragma unroll
  for(int r=0;r<16;++r)rli[r]=__builtin_amdgcn_rcpf(wsf[32+crow(r,hi)]);
  bf16*Ow=O+(rowbase+q0+wid*QBLK)*DM+h*D;
  { bf16*stg=(bf16*)(shm+LDS_OST)+wid*2048;
    #pragma unroll
    for(int r=0;r<16;++r){const int orow=crow(r,hi);
      #pragma unroll
      for(int d0=0;d0<2;++d0)stg[orow*64+d0*32+r32]=(bf16)(o[d0][r]*rli[r]);}
    asm volatile("s_waitcnt lgkmcnt(0)":::"memory");
    #pragma unroll
    for(int i=0;i<4;++i){const int row=i*8+(lane>>3),ch=lane&7; const u32x4 v=*(const u32x4*)(stg+row*64+ch*8); ATTN_STORE16(Ow+(long)row*DM+ch*8,v);} }
  asm volatile("s_waitcnt lgkmcnt(0)\n\ts_barrier":::"memory");
  #undef DMA_K
  #undef DMA_V
  #undef CMASK
  #undef START
  #undef RESC
  #undef ROT
}
constexpr int ATTN_LDS_BYTES=LDS_TOTAL;
#undef SBAR
#undef WAIT_BAR
}

__device__ __forceinline__ int unit_bh(int L) { const int cidx = L & 255, grp = cidx >> 4; return (4 * (grp >> 1) + (grp & 1) + ((L >> 11) ? 0 : 2)) * 16 + (cidx & 15); }
constexpr int KP = 144, TILE_B = 64 * KP;
constexpr int A_K = 0, A_V = 2 * TILE_B, A_KM = 4 * TILE_B, A_BT = A_KM + 2048, A_FL = A_BT + 1280, NBT = 320;

#define ATT_COMMON_SETUP \
    int tid_ = mk_tid(); asm volatile("" : "+v"(tid_)); \
    const int tid = tid_, lane = tid & 63, w = __builtin_amdgcn_readfirstlane(tid >> 6), r = lane & 31, hh = lane >> 5; \
    const int srow = tid >> 3, sch = tid & 7; \
    const int i16 = lane & 15, q4 = i16 >> 2, p4 = i16 & 3, blk = (lane >> 4) & 1; \
    const int voff = (4 * hh + q4) * KP + (16 * blk + 4 * p4) * 2; \
    const int koff = r * KP + 16 * hh; \
    const h16* Qb = (const h16*)(P.ws + WS_Q); const h16* Kb = (const h16*)(P.ws + WS_K); const h16* Vb = (const h16*)(P.ws + WS_V); h16* Ob = (h16*)(P.ws + WS_O);

#define ATT_QK(s, kbuf, cinit) do { h16x8 kf_[2][4]; \
        _Pragma("unroll") for (int kb = 0; kb < 2; ++kb) _Pragma("unroll") for (int ks = 0; ks < 4; ++ks) kf_[kb][ks] = *(const LAS h16x8*)((kbuf) + koff + kb * 32 * KP + ks * 32); \
        __builtin_amdgcn_sched_barrier(0); \
        _Pragma("unroll") for (int kb = 0; kb < 2; ++kb) _Pragma("unroll") for (int i = 0; i < 16; ++i) s[kb][i] = (cinit); \
        _Pragma("unroll") for (int ks = 0; ks < 4; ++ks) _Pragma("unroll") for (int kb = 0; kb < 2; ++kb) s[kb] = MFMA32(kf_[kb][ks], qf[ks], s[kb]); } while (0)
#define ATT_QK_ACC(s, kbuf) do { h16x8 kf_[2][4]; \
        _Pragma("unroll") for (int kb = 0; kb < 2; ++kb) _Pragma("unroll") for (int ks = 0; ks < 4; ++ks) kf_[kb][ks] = *(const LAS h16x8*)((kbuf) + koff + kb * 32 * KP + ks * 32); \
        __builtin_amdgcn_sched_barrier(0); \
        _Pragma("unroll") for (int ks = 0; ks < 4; ++ks) _Pragma("unroll") for (int kb = 0; kb < 2; ++kb) s[kb] = MFMA32(kf_[kb][ks], qf[ks], s[kb]); } while (0)
#define ATT_LOADV(vf, vbuf) do { _Pragma("unroll") for (int s4 = 0; s4 < 4; ++s4) _Pragma("unroll") for (int db = 0; db < 2; ++db) { const LAS unsigned char* vp = (vbuf) + voff + 16 * s4 * KP + 64 * db; vf[s4][db] = tr8(vp, vp + 8 * KP); } \
        __builtin_amdgcn_sched_barrier(0); } while (0)
#define ATT_PV(o, s, vf) do { _Pragma("unroll") for (int s4 = 0; s4 < 4; ++s4) { const h16x8 pf = pack8(s[s4 >> 1], s4 & 1); \
        _Pragma("unroll") for (int db = 0; db < 2; ++db) o[db] = MFMA32(vf[s4][db], pf, o[db]); } } while (0)

__device__ __forceinline__ void p_attn_moba(const Params& P, unsigned char* lds_generic) {
    int prev_bh = -1;
    const h16* Qg = (const h16*)(P.ws + WS_Q);
#define MOBA_QBASE(L_) (Qg + ((size_t)(unit_bh(L_) >> 4) * SEQ + 256 * (((L_) >> 8) & 7)) * DM + (unit_bh(L_) & 15) * DH)
    attn_body::bf16x8 qr[4];
    { int tid_ = mk_tid(); asm volatile("" : "+v"(tid_)); const int lane_ = tid_ & 63, wid_ = tid_ >> 6; const h16* q0p = MOBA_QBASE((int)blockIdx.x) + (size_t)(wid_ * 32 + (lane_ & 31)) * DM + (lane_ >> 5) * 8;
#pragma unroll
      for (int d0 = 0; d0 < 4; ++d0) qr[d0] = *reinterpret_cast<const attn_body::bf16x8*>(q0p + d0 * 16); }
    for (int L = blockIdx.x; L < 4096; L += gridDim.x) {
        const int qb = (L >> 8) & 7, bh = unit_bh(L), b = bh >> 4, h = bh & 15; const int Ln = L + (int)gridDim.x;
        attn_body::attn_unit<8>(b, h, qb, Qg, (const h16*)(P.ws + WS_K), (const h16*)(P.ws + WS_V), (h16*)(P.ws + WS_O), (char*)lds_generic,
                                (const float*)(P.ws + WS_KM) + (size_t)bh * 512, P.rel_bias, bh != prev_bh, qr, Ln < 4096 ? MOBA_QBASE(Ln) : nullptr);
        prev_bh = bh;
    }
}

__device__ __forceinline__ void p_attn_sb(const Params& P, LAS unsigned char* lds) {
    ATT_COMMON_SETUP
    LAS int* flags = (LAS int*)(lds + A_FL);
    h16x8 uf[2], ones;
#pragma unroll
    for (int ks = 0; ks < 2; ++ks)
#pragma unroll
        for (int jj = 0; jj < 8; ++jj) { const int k = 16 * ks + 8 * (jj >> 2) + 4 * hh + (jj & 3); uf[ks][jj] = (k > r) ? (h16)1.0f : (h16)0.0f; }
#pragma unroll
    for (int jj = 0; jj < 8; ++jj) ones[jj] = (h16)1.0f;
    for (int L = blockIdx.x; L < 4096; L += gridDim.x) {
        const int qb = (L >> 8) & 7, bh = unit_bh(L), b = bh >> 4, h = bh & 15;
        const size_t tokbase = (size_t)b * SEQ;
        const h16* Kg = Kb + (size_t)bh * SEQ * DH; const h16* Vg = Vb + (size_t)bh * SEQ * DH;
        const int t = 256 * qb + 32 * w + r;
        const int nt = 4 * qb + 4;
        __syncthreads();
        if (tid < 16) flags[tid] = 0;
        { const size_t go = (size_t)(64 * (nt - 1) + srow) * DH + sch * 8; const u32x4 k0 = *(const u32x4*)(Kg + go), v0 = *(const u32x4*)(Vg + go);
          *(LAS u32x4*)(lds + A_K + srow * KP + sch * 16) = k0; *(LAS u32x4*)(lds + A_V + srow * KP + sch * 16) = v0; }
        h16x8 qf[4];
        { const h16* qp = Qb + (tokbase + t) * DM + h * DH + 8 * hh;
#pragma unroll
          for (int ks = 0; ks < 4; ++ks) qf[ks] = *(const h16x8*)(qp + 16 * ks); }
        __syncthreads();
        float carry = 0.f; bool wdone = false; f32x16 o[2];
#pragma unroll
        for (int i = 0; i < 16; ++i) { o[0][i] = 0.f; o[1][i] = 0.f; }
        for (int j = 0; j < nt; ++j) {
            const int kt = nt - 1 - j; const bool more = (j + 1 < nt);
            const size_t go = (size_t)(64 * (more ? kt - 1 : kt) + srow) * DH + sch * 8; const u32x4 kreg = *(const u32x4*)(Kg + go), vreg = *(const u32x4*)(Vg + go);
            const LAS unsigned char* kbuf = lds + A_K + (j & 1) * TILE_B; const LAS unsigned char* vbuf = lds + A_V + (j & 1) * TILE_B;
            const int jo = kt - 4 * qb;
            const bool active = !wdone && (jo < 0 || 2 * jo <= w);
            if (active) {
                f32x16 z[2], lk[2];
                const bool diag = (64 * kt + 63 >= 256 * qb + 32 * w);
                const int sb = 64 * kt;
                if (diag) {
#pragma unroll
                    for (int kb = 0; kb < 2; ++kb)
#pragma unroll
                        for (int i = 0; i < 16; ++i) z[kb][i] = (sb + 32 * kb + crow(i, hh) < t) ? 0.f : -1.0e30f;
                } else {
#pragma unroll
                    for (int i = 0; i < 16; ++i) { z[0][i] = 0.f; z[1][i] = 0.f; } }
                ATT_QK_ACC(z, kbuf);
                h16x8 vf[4][2]; ATT_LOADV(vf, vbuf);
#pragma unroll
                for (int kb = 0; kb < 2; ++kb)
#pragma unroll
                    for (int i = 0; i < 16; ++i) { const float zz = z[kb][i]; const float e = ex2(-fabsf(zz)); lk[kb][i] = -(fmaxf(zz, 0.f) + lg2(1.0f + e)); }
                const h16x8 x00 = pack8(lk[0], 0), x01 = pack8(lk[0], 1), x10 = pack8(lk[1], 0), x11 = pack8(lk[1], 1);
                const float lk00 = lk[0][0], lb00 = z[0][0] + lk00;
#pragma unroll
                for (int i = 0; i < 16; ++i) { z[0][i] += lk[0][i]; z[1][i] += lk[1][i]; }
                z[0][0] = 0.f;
                f32x16 y0 = MFMA32(uf[0], x00, z[0]), y1 = MFMA32(uf[0], x10, z[1]);
                y0 = MFMA32(uf[1], x01, y0); y1 = MFMA32(uf[1], x11, y1); y0 = MFMA32(ones, x10, y0); y0 = MFMA32(ones, x11, y0);
                float tot = y0[0] + lk00;
                { auto rr_ = __builtin_amdgcn_permlane32_swap(__float_as_uint(tot), __float_as_uint(tot), false, false); tot = __uint_as_float(rr_[0]); }
                y0[0] += lb00;
#pragma unroll
                for (int i = 0; i < 16; ++i) { z[0][i] = ex2(y0[i] + carry); z[1][i] = ex2(y1[i] + carry); }
                carry += tot;
                ATT_PV(o, z, vf);
                wdone = (__ballot(carry < -151.0f) == ~0ull);
            }
            if (wdone && lane == 0) flags[(j & 1) * 8 + w] = 1;
            if (more) { *(LAS u32x4*)(lds + A_K + ((j + 1) & 1) * TILE_B + srow * KP + sch * 16) = kreg; *(LAS u32x4*)(lds + A_V + ((j + 1) & 1) * TILE_B + srow * KP + sch * 16) = vreg; }
            __syncthreads();
            const u32x4 fa_ = *(const LAS u32x4*)(flags + (j & 1) * 8), fb_ = *(const LAS u32x4*)(flags + (j & 1) * 8 + 4);
            if ((fa_.x + fa_.y + fa_.z + fa_.w) + (fb_.x + fb_.y + fb_.z + fb_.w) == 8u) break;
        }
        h16* op = Ob + (tokbase + t) * DM + h * DH + 4 * hh;
#pragma unroll
        for (int db = 0; db < 2; ++db)
#pragma unroll
            for (int gq = 0; gq < 4; ++gq) { u32x2 wv; wv.x = pk2h(o[db][4 * gq], o[db][4 * gq + 1]); wv.y = pk2h(o[db][4 * gq + 2], o[db][4 * gq + 3]); *(u32x2*)(op + 32 * db + 8 * gq) = wv; }
    }
}

__global__ void __launch_bounds__(NT) fwd_megakernel(Params P) {
    extern __shared__ __attribute__((aligned(16))) unsigned char lds_raw[];
    LAS unsigned char* lds = (LAS unsigned char*)lds_raw;
    cg::grid_group grid = cg::this_grid();
    { const unsigned hw = (unsigned)__builtin_amdgcn_s_getreg((5 << 11) | 4) & 63u; ((LAS int*)(uintptr_t)MK_WTAB)[hw] = (int)(threadIdx.x >> 6); }
    __syncthreads();
    const int lo = P.ph_lo, hi = P.ph_hi, G = gridDim.x, c = blockIdx.x;
#define RUN(k) (lo <= (k) && (k) < hi)
#define SEAM(k) do { if (RUN(k) && hi - lo > 1) xcd_barrier(bar); } while (0)
    volatile unsigned* st = (volatile unsigned*)(P.ws + WS_BARST) + 4 * blockIdx.x;
    XcdBarrier bar; bar.bar = (unsigned*)(P.ws + WS_BAR); bar.x = 0; bar.st = nullptr;
    if (hi - lo > 1) bar = xcd_barrier_post((unsigned*)(P.ws + WS_BAR), st);
    if (hi < 0) grid.sync();
    h16* Xh = (h16*)(P.ws + WS_X16); h16* Y1 = (h16*)(P.ws + WS_YA); h16* Y2 = (h16*)(P.ws + WS_YB); h16* Qh = (h16*)(P.ws + WS_Q); h16* Oh = (h16*)(P.ws + WS_O); h16* Uh = (h16*)(P.ws + WS_U);
    pg8::f32x2_t* ST1 = (pg8::f32x2_t*)(P.ws + WS_ST1); pg8::f32x2_t* ST2 = (pg8::f32x2_t*)(P.ws + WS_ST2); const float* CS = (const float*)(P.ws + WS_CS); const float* BW = CS + NCS;
    const LAS unsigned char* tbl = lds + ST_OFF;
    if (RUN(0)) p_prologue(P, lds);
    SEAM(0);
#pragma unroll 1
    for (int l = 0; l < DEPTH; ++l) {
        const int pb = 1 + 8 * l; unsigned char* wl = P.ws + WS_W + (size_t)l * W_LAYER_B;
        const h16* Wqkv = (const h16*)wl; const h16* Wo = (const h16*)(wl + W_QKV_B); const h16* Wup = (const h16*)(wl + W_QKV_B + W_O_B); const h16* Wdn = (const h16*)(wl + W_QKV_B + W_O_B + W_UP_B);
        if (RUN(pb + 0)) {
            pg8::StaticOrder S; S.init(M_TOK, 3 * DM, G, c);
            if (l == 0) { pg8::Gemm g{Xh, Wqkv, M_TOK, 3 * DM, DM}; pg8::Epi<0, false> E{Qh, DM, DM, (size_t)(WS_K - WS_Q) / 2, QSCALE, nullptr, 0.f, nullptr, nullptr};
                pg8::gemm_phase<pg8::Epi<0, false>, pg8::StaticOrder, true, true>(lds, g, S, E); }
            else { p_fill_tables(lds, (const float*)ST2, S, CS + 8192, BW + 8192);
                pg8::Gemm g{Y2, Wqkv, M_TOK, 3 * DM, DM}; pg8::Epi<0, true> E{Qh, DM, DM, (size_t)(WS_K - WS_Q) / 2, QSCALE, nullptr, 0.f, tbl, nullptr};
                pg8::gemm_phase<pg8::Epi<0, true>, pg8::StaticOrder, true, true>(lds, g, S, E); } }
        SEAM(pb + 0);
        if (RUN(pb + 2)) { if (l == 0) { p_cs_finalize(P); p_attn_moba(P, lds_raw); } else p_attn_sb(P, lds); }
        SEAM(pb + 2);
        if (RUN(pb + 3)) {
            pg8::Gemm g{Oh, Wo, M_TOK, DM, DM}; pg8::StaticOrder S; S.init(M_TOK, DM, G, c); S.rev = 1;
            if (l == 0) { pg8::Epi<2, false> E{Y1, DM, 0, 0, 1.f, Xh, ALPHA, nullptr, ST1};
                pg8::gemm_phase<pg8::Epi<2, false>, pg8::StaticOrder, true, true>(lds, g, S, E); }
            else { p_fill_tables(lds, (const float*)ST2, S, P.ln_ffn_g + (l - 1) * DM, P.ln_ffn_b + (l - 1) * DM);
                pg8::Epi<2, true> E{Y1, DM, 0, 0, 1.f, Y2, ALPHA, tbl, ST1};
                pg8::gemm_phase<pg8::Epi<2, true>, pg8::StaticOrder, true, true>(lds, g, S, E); } }
        SEAM(pb + 3);
        if (RUN(pb + 5)) {
            pg8::Gemm g{Y1, Wup, M_TOK, FF, DM}; pg8::StaticOrder S; S.init(M_TOK, FF, G, c);
            p_fill_tables(lds, (const float*)ST1, S, CS + l * 4096, BW + l * 4096);
            pg8::Epi<1, true> E{Uh, FF, 0, 0, 1.f, nullptr, 0.f, tbl, nullptr};
            pg8::gemm_phase<pg8::Epi<1, true>, pg8::StaticOrder, true, true>(lds, g, S, E); }
        SEAM(pb + 5);
        if (RUN(pb + 6)) {
            pg8::Gemm g{Uh, Wdn, M_TOK, DM, FF}; pg8::StaticOrder S; S.init(M_TOK, DM, G, c); S.rev = 1;
            p_fill_tables(lds, (const float*)ST1, S, P.ln_mix_g + l * DM, P.ln_mix_b + l * DM);
            pg8::Epi<2, true> E{Y2, DM, 0, 0, 1.f, Y1, ALPHA, tbl, ST2};
            pg8::gemm_phase<pg8::Epi<2, true>, pg8::StaticOrder, true, true>(lds, g, S, E); }
        if (l + 1 < DEPTH) SEAM(pb + 6);
    }
    if (RUN(NPHASE - 1)) { if (RUN(NPHASE - 2)) xcd_barrier(bar); p_ln<true>(Y2, nullptr, P.out, P.ln_ffn_g + (DEPTH - 1) * DM, P.ln_ffn_b + (DEPTH - 1) * DM, (const float*)ST2); }
#undef RUN
#undef SEAM
}

extern "C" void kernel_launch(void* const* d_in, const int* in_sizes, int n_in, void* d_out, int out_size, void* d_ws, size_t ws_size, hipStream_t stream) {
    static int grid = 0;
    if (grid == 0) {
        if (n_in != 10 || in_sizes[0] != M_TOK * DM || out_size != M_TOK * DM || ws_size < WS_END) { fprintf(stderr, "kernel_launch: unexpected shapes / workspace (%d inputs, x %d, out %d, ws %zu < %zu)\n", n_in, n_in > 0 ? in_sizes[0] : -1, out_size, ws_size, (size_t)WS_END); grid = -1; return; }
        int dev = 0, cus = 0, per_cu = 0;
        (void)hipGetDevice(&dev); (void)hipDeviceGetAttribute(&cus, hipDeviceAttributeMultiprocessorCount, dev);
        if (hipFuncSetAttribute((const void*)fwd_megakernel, hipFuncAttributeMaxDynamicSharedMemorySize, LDS_BYTES) != hipSuccess) { fprintf(stderr, "kernel_launch: hipFuncSetAttribute failed\n"); grid = -1; return; }
        if (hipOccupancyMaxActiveBlocksPerMultiprocessor(&per_cu, (const void*)fwd_megakernel, NT, LDS_BYTES) != hipSuccess || per_cu < 1) { fprintf(stderr, "kernel_launch: occupancy query says %d blocks per CU\n", per_cu); per_cu = 1; }
        (void)hipGetLastError();
        grid = cus > 0 ? cus : 256;
    }
    if (grid < 0) return;
    Params p{};
    p.x = (const float*)d_in[0]; p.rel_bias = (const float*)d_in[1]; p.w_qkv = (const float*)d_in[2]; p.w_o = (const float*)d_in[3]; p.ln_mix_g = (const float*)d_in[4]; p.ln_mix_b = (const float*)d_in[5];
    p.w_up = (const float*)d_in[6]; p.w_down = (const float*)d_in[7]; p.ln_ffn_g = (const float*)d_in[8]; p.ln_ffn_b = (const float*)d_in[9]; p.out = (float*)d_out; p.ws = (unsigned char*)d_ws;
#if MK_LAUNCHES == 1
    p.ph_lo = 0; p.ph_hi = NPHASE;
    if (hipMemsetAsync((char*)d_ws + WS_BAR, 0, CTL_BYTES, stream) != hipSuccess) { fprintf(stderr, "kernel_launch: hipMemsetAsync of the barrier words failed\n"); return; }
    void* args[] = {&p};
    const hipError_t e = hipLaunchCooperativeKernel((const void*)fwd_megakernel, dim3(grid), dim3(NT), args, LDS_BYTES, stream);
    if (e != hipSuccess) fprintf(stderr, "kernel_launch: cooperative launch failed: %s (grid %d)\n", hipGetErrorString(e), grid);
#else
    for (int ph = 0; ph < NPHASE; ++ph) { if (ph == 2 || ph == 10 || ph == 5 || ph == 8 || ph == 13) continue;
        p.ph_lo = ph; p.ph_hi = ph + 1; hipLaunchKernelGGL(fwd_megakernel, dim3(grid), dim3(NT), LDS_BYTES, stream, p); }
#endif
}
```
